# Optimizing an MI355X kernel written in HIP

```python
import jax, jax.numpy as jnp
from jax import lax
import numpy as np

D_MODEL = 1024
BATCH = 1
SEQ = 16384
DEPTH = 4

CHUNK = 64
SC_WIDTH = D_MODEL // 2
SC_KERNEL = 3
GLA_HEADS = 4
GLA_DK = D_MODEL // 2 // GLA_HEADS
GLA_DV = D_MODEL // GLA_HEADS
GLA_RANK = 16
GLA_GATE_NORM = 16.0
CF_KERNEL = 31
MLP_HIDDEN = 4 * D_MODEL
EPS = 1e-6

GLA_KEY = GLA_HEADS * GLA_DK
GLA_VAL = GLA_HEADS * GLA_DV
AB_SPLIT = (SC_WIDTH, SC_WIDTH, SC_WIDTH, GLA_KEY, GLA_KEY, GLA_VAL, GLA_VAL, GLA_RANK)
AB_IN = sum(AB_SPLIT)
AB_MIX = SC_WIDTH + GLA_VAL

kernel_name = "hybrid_shortconv_gla_conformer_trunk"


def rms_norm(x, g):
    xf = x.astype(jnp.float32)
    y = xf * lax.rsqrt(jnp.mean(jnp.square(xf), axis=-1, keepdims=True) + EPS)
    return (y * g.astype(jnp.float32)).astype(x.dtype)


def layer_norm(x, g, b):
    xf = x.astype(jnp.float32)
    mu = jnp.mean(xf, axis=-1, keepdims=True)
    xc = xf - mu
    y = xc * lax.rsqrt(jnp.mean(jnp.square(xc), axis=-1, keepdims=True) + EPS)
    return (y * g.astype(jnp.float32) + b.astype(jnp.float32)).astype(x.dtype)


def causal_depthwise_conv(x, w):
    K, C = w.shape
    return lax.conv_general_dilated(
        x, w[:, None, :].astype(x.dtype), window_strides=(1,), padding=[(K - 1, 0)],
        dimension_numbers=('NWC', 'WIO', 'NWC'), feature_group_count=C)


def split_cols(z, sizes):
    idx, acc = [], 0
    for s in sizes[:-1]:
        acc += s
        idx.append(acc)
    return jnp.split(z, idx, axis=-1)


def gla_chunked(q, k, v, gk, g_out, norm_g):
    B, T, _ = q.shape
    N = T // CHUNK
    out_dtype = v.dtype

    def heads(t, d):
        return t.reshape(B, N, CHUNK, GLA_HEADS, d).transpose(1, 0, 3, 2, 4).astype(jnp.float32)

    qh = heads(q, GLA_DK) * (GLA_DK ** -0.5)
    kh = heads(k, GLA_DK)
    vh = heads(v, GLA_DV)
    gh = heads(jax.nn.log_sigmoid(gk.astype(jnp.float32)) / GLA_GATE_NORM, GLA_DK)
    causal = jnp.tril(jnp.ones((CHUNK, CHUNK), dtype=bool))[None, None, :, :, None]

    def body(S, inp):
        qc, kc, vc, gc = inp
        b = jnp.cumsum(gc, axis=2)
        b_last = b[:, :, -1, :]
        o_inter = jnp.einsum('bhik,bhkv->bhiv', qc * jnp.exp(b), S)
        diff = b[:, :, :, None, :] - b[:, :, None, :, :]
        decay = jnp.where(causal, jnp.exp(jnp.minimum(diff, 0.0)), 0.0)
        attn = jnp.einsum('bhik,bhijk,bhjk->bhij', qc, decay, kc)
        o = o_inter + jnp.einsum('bhij,bhjv->bhiv', attn, vc)
        S_new = S * jnp.exp(b_last)[..., None] + jnp.einsum(
            'bhjk,bhjv->bhkv', kc * jnp.exp(b_last[:, :, None, :] - b), vc)
        return S_new, o

    S0 = jnp.zeros((B, GLA_HEADS, GLA_DK, GLA_DV), jnp.float32)
    _, o = lax.scan(body, S0, (qh, kh, vh, gh))
    o = o.transpose(1, 0, 3, 2, 4).reshape(B, T, GLA_HEADS, GLA_DV)
    o = rms_norm(o, norm_g) * jax.nn.silu(g_out.astype(jnp.float32).reshape(B, T, GLA_HEADS, GLA_DV))
    return o.reshape(B, T, GLA_VAL).astype(out_dtype)


def shortconv_gla_mixer(h, w_in, w_gk2, b_gk2, w_sc, gla_norm_g, w_out):
    z = h @ w_in
    sc_x, sc_b, sc_c, q, k, v, g_out, gk_lr = split_cols(z, AB_SPLIT)
    y_a = sc_b * causal_depthwise_conv(sc_c * sc_x, w_sc)
    gk = gk_lr @ w_gk2 + b_gk2
    y_b = gla_chunked(q, k, v, gk, g_out, gla_norm_g)
    return jnp.concatenate([y_a, y_b], axis=-1) @ w_out


def conformer_conv(h, w_pw1, b_pw1, w_dw, b_dw, ln_g, ln_b, w_pw2, b_pw2):
    u = h @ w_pw1 + b_pw1
    u1, u2 = jnp.split(u, 2, axis=-1)
    u = u1 * jax.nn.sigmoid(u2)
    d = causal_depthwise_conv(u, w_dw) + b_dw
    d = jax.nn.silu(layer_norm(d, ln_g, ln_b))
    return d @ w_pw2 + b_pw2


def setup_inputs(seed: int = 0) -> dict:
    key = jax.random.key(seed)
    ks = iter(jax.random.split(key, 32))
    ne = (DEPTH + 1) // 2
    no = DEPTH // 2
    D = D_MODEL

    def nrm(shape, scale):
        return jax.random.normal(next(ks), shape, jnp.float32) * scale

    def gain(shape):
        return 1.0 + nrm(shape, 0.02)

    return {
        "x": nrm((BATCH, SEQ, D), 1.0),
        "norm_mix_pre": gain((DEPTH, D)),
        "norm_mix_post": gain((DEPTH, D)),
        "norm_mlp_pre": gain((DEPTH, D)),
        "norm_mlp_post": gain((DEPTH, D)),
        "ab_w_in": nrm((ne, D, AB_IN), D ** -0.5),
        "gla_w_gk2": nrm((ne, GLA_RANK, GLA_KEY), GLA_RANK ** -0.5),
        "gla_b_gk2": nrm((ne, GLA_KEY), 0.01),
        "sc_w_conv": nrm((ne, SC_KERNEL, SC_WIDTH), SC_KERNEL ** -0.5),
        "gla_norm_g": gain((ne, GLA_DV)),
        "ab_w_out": nrm((ne, AB_MIX, D), AB_MIX ** -0.5),
        "cf_w_pw1": nrm((no, D, 2 * D), D ** -0.5),
        "cf_b_pw1": nrm((no, 2 * D), 0.01),
        "cf_w_dw": nrm((no, CF_KERNEL, D), CF_KERNEL ** -0.5),
        "cf_b_dw": nrm((no, D), 0.01),
        "cf_ln_g": gain((no, D)),
        "cf_ln_b": nrm((no, D), 0.01),
        "cf_w_pw2": nrm((no, D, D), D ** -0.5),
        "cf_b_pw2": nrm((no, D), 0.01),
        "mlp_w1": nrm((DEPTH, D, MLP_HIDDEN), D ** -0.5),
        "mlp_w2": nrm((DEPTH, MLP_HIDDEN, D), MLP_HIDDEN ** -0.5),
    }


def reference(x, norm_mix_pre, norm_mix_post, norm_mlp_pre, norm_mlp_post,
              ab_w_in, gla_w_gk2, gla_b_gk2, sc_w_conv, gla_norm_g, ab_w_out,
              cf_w_pw1, cf_b_pw1, cf_w_dw, cf_b_dw, cf_ln_g, cf_ln_b, cf_w_pw2, cf_b_pw2,
              mlp_w1, mlp_w2):
    for layer in range(DEPTH):
        i = layer // 2
        h = rms_norm(x, norm_mix_pre[layer])
        if layer % 2 == 0:
            y = shortconv_gla_mixer(h, ab_w_in[i], gla_w_gk2[i], gla_b_gk2[i],
                                    sc_w_conv[i], gla_norm_g[i], ab_w_out[i])
        else:
            y = conformer_conv(h, cf_w_pw1[i], cf_b_pw1[i], cf_w_dw[i], cf_b_dw[i],
                               cf_ln_g[i], cf_ln_b[i], cf_w_pw2[i], cf_b_pw2[i])
        x = x + rms_norm(y, norm_mix_post[layer])
        h = rms_norm(x, norm_mlp_pre[layer])
        y = jnp.square(jax.nn.relu(h @ mlp_w1[layer])) @ mlp_w2[layer]
        x = x + rms_norm(y, norm_mlp_post[layer])
    return x
```

```cpp
#include <hip/hip_runtime.h>
#include <cstdio>
#include <cstdint>
namespace pg8 {
#define PG8_LAS __attribute__((address_space(3)))
typedef unsigned short bf16_t;
typedef short bf16x8 __attribute__((ext_vector_type(8)));
typedef float f32x4 __attribute__((ext_vector_type(4)));
typedef unsigned u32x4 __attribute__((ext_vector_type(4)));
constexpr int BM = 256, BK = 64, HALF = 128, HTB = HALF * BK * 2  , STAGE_BYTES = 8 * HTB, NXCD = 8, WGM = 8;

__host__ __device__ __forceinline__ int lds_byte(int r, int c) { const int st = (r >> 4) * 2 + (c >> 5), rr = r & 15, cc = c & 31, ob = rr * 64 + cc * 2; return st * 1024 + (ob ^ (((ob >> 9) & 1) << 5)); }
__host__ __device__ __forceinline__ void stage_rc(int b, int& R, int& C) { const int st = b / 1024, sb = b % 1024, swz = sb ^ (((sb >> 9) & 1) << 5); R = (st >> 1) * 16 + swz / 64; C = (st & 1) * 32 + (swz % 64) / 2; }
__host__ __device__ __forceinline__ int perm32(int rho) { const int n = rho >> 4, i = rho & 15; return 8 * (i >> 2) + 4 * n + (i & 3); }

struct Unit { int pm, pn; };
struct Gemm { const bf16_t* A; const bf16_t* Bt; int M, N, K; };

struct StaticOrder {
    int nM, nN, nwg, G, c;
    __host__ __device__ void init(int M, int N, int G_, int c_) { nM = M / BM; nN = N / BM; nwg = nM * nN; G = G_; c = c_; }
    __host__ __device__ bool next(int i, Unit& u) const {
        const long L = (long)i * G + c; if (L >= nwg) return false;
        int wgid = (int)L; { const int q = nwg / NXCD, r = nwg % NXCD, xcd = wgid % NXCD, off = wgid / NXCD; wgid = (xcd < r ? xcd * (q + 1) : r * (q + 1) + (xcd - r) * q) + off; }
        const int nig = WGM * nN, gid = wgid / nig, fm = gid * WGM, gsz = (nM - fm) < WGM ? (nM - fm) : WGM;
        u.pm = fm + ((wgid % nig) % gsz); u.pn = (wgid % nig) / gsz; return true;
    }
    __device__ __forceinline__ void a_ready(const Unit&) const {}
    __device__ __forceinline__ void done(const Unit&) const {}
};
__device__ __forceinline__ unsigned cvt_pk_bf16(float lo, float hi) { unsigned r; asm volatile("v_cvt_pk_bf16_f32 %0, %1, %2" : "=v"(r) : "v"(lo), "v"(hi)); return r; }
typedef float f32x2 __attribute__((ext_vector_type(2)));
}
namespace pg8 {
struct EpiZ {
    static constexpr bool PERM = true, AFTER_DRAIN = false;
    bf16_t* Z; float* GK;
    __device__ __forceinline__ void operator()(const f32x4 (&acc)[2][2][4][2], const Unit& u, int wr, int wc, int fr, int fq) const {
        const int row0 = u.pm * BM + wr * 64 + fr;
        if (u.pn < 18) {
            const int col0 = u.pn * BM + wc * 32 + 8 * fq;
#pragma unroll
            for (int ai = 0; ai < 2; ++ai)
#pragma unroll
                for (int m = 0; m < 4; ++m) { bf16_t* rowp = Z + (size_t)(row0 + ai * HALF + m * 16) * 4608 + col0;
#pragma unroll
                    for (int bj = 0; bj < 2; ++bj) { const f32x4 v0 = acc[ai][bj][m][0], v1 = acc[ai][bj][m][1];
                        u32x4 w; w.x = cvt_pk_bf16(v0[0], v0[1]); w.y = cvt_pk_bf16(v0[2], v0[3]); w.z = cvt_pk_bf16(v1[0], v1[1]); w.w = cvt_pk_bf16(v1[2], v1[3]);
                        *(u32x4*)(rowp + bj * HALF) = w; } }
        } else if (wc == 0 && fq < 2) {
#pragma unroll
            for (int ai = 0; ai < 2; ++ai)
#pragma unroll
                for (int m = 0; m < 4; ++m) { float* rp = GK + (size_t)(row0 + ai * HALF + m * 16) * 16 + 8 * fq;
                    *(f32x4*)rp = acc[ai][0][m][0]; *(f32x4*)(rp + 4) = acc[ai][0][m][1]; }
        }
    }
};
template <bool HAS_BIAS> struct EpiF32 {
    static constexpr bool PERM = false, AFTER_DRAIN = false;
    float* C; int ldc; const float* bias;
    __device__ __forceinline__ void operator()(const f32x4 (&acc)[2][2][4][2], const Unit& u, int wr, int wc, int fr, int fq) const {
        const int row0 = u.pm * BM + wr * 64 + fr, col0 = u.pn * BM + wc * 32 + 4 * fq;
        f32x4 bv[2][2];
#pragma unroll
        for (int bj = 0; bj < 2; ++bj)
#pragma unroll
            for (int n = 0; n < 2; ++n) bv[bj][n] = HAS_BIAS ? *(const f32x4*)(bias + col0 + bj * HALF + n * 16) : (f32x4){0.f, 0.f, 0.f, 0.f};
#pragma unroll
        for (int ai = 0; ai < 2; ++ai)
#pragma unroll
            for (int m = 0; m < 4; ++m) { float* rowp = C + (size_t)(row0 + ai * HALF + m * 16) * ldc + col0;
#pragma unroll
                for (int bj = 0; bj < 2; ++bj)
#pragma unroll
                    for (int n = 0; n < 2; ++n) *(f32x4*)(rowp + bj * HALF + n * 16) = acc[ai][bj][m][n] + bv[bj][n]; }
    }
};
struct EpiRelu2 {
    static constexpr bool PERM = true, AFTER_DRAIN = false;
    bf16_t* O; int ldc;
    __device__ __forceinline__ void operator()(const f32x4 (&acc)[2][2][4][2], const Unit& u, int wr, int wc, int fr, int fq) const {
        const int row0 = u.pm * BM + wr * 64 + fr, col0 = u.pn * BM + wc * 32 + 8 * fq;
#pragma unroll
        for (int ai = 0; ai < 2; ++ai)
#pragma unroll
            for (int m = 0; m < 4; ++m) { bf16_t* rowp = O + (size_t)(row0 + ai * HALF + m * 16) * ldc + col0;
#pragma unroll
                for (int bj = 0; bj < 2; ++bj) { f32x4 v0 = acc[ai][bj][m][0], v1 = acc[ai][bj][m][1];
#pragma unroll
                    for (int j = 0; j < 4; ++j) { const float a = fmaxf(v0[j], 0.f), b = fmaxf(v1[j], 0.f); v0[j] = a * a; v1[j] = b * b; }
                    u32x4 w; w.x = cvt_pk_bf16(v0[0], v0[1]); w.y = cvt_pk_bf16(v0[2], v0[3]); w.z = cvt_pk_bf16(v1[0], v1[1]); w.w = cvt_pk_bf16(v1[2], v1[3]);
                    *(u32x4*)(rowp + bj * HALF) = w; } }
    }
};
struct EpiGLU {
    static constexpr bool PERM = true, AFTER_DRAIN = false;
    bf16_t* U; const float* bias;
    __device__ __forceinline__ void operator()(const f32x4 (&acc)[2][2][4][2], const Unit& u, int wr, int wc, int fr, int fq) const {
        const int row0 = u.pm * BM + wr * 64 + fr, col0 = u.pn * HALF + wc * 32 + 8 * fq;
        f32x4 b1[2], b2[2];
#pragma unroll
        for (int n = 0; n < 2; ++n) { b1[n] = *(const f32x4*)(bias + col0 + 4 * n); b2[n] = *(const f32x4*)(bias + 1024 + col0 + 4 * n); }
#pragma unroll
        for (int ai = 0; ai < 2; ++ai)
#pragma unroll
            for (int m = 0; m < 4; ++m) { bf16_t* rowp = U + (size_t)(row0 + ai * HALF + m * 16) * 1024 + col0;
                f32x4 o[2];
#pragma unroll
                for (int n = 0; n < 2; ++n) { const f32x4 a = acc[ai][0][m][n] + b1[n], g = acc[ai][1][m][n] + b2[n];
#pragma unroll
                    for (int j = 0; j < 4; ++j) o[n][j] = a[j] * __builtin_amdgcn_rcpf(1.f + __expf(-g[j])); }
                u32x4 w; w.x = cvt_pk_bf16(o[0][0], o[0][1]); w.y = cvt_pk_bf16(o[0][2], o[0][3]); w.z = cvt_pk_bf16(o[1][0], o[1][1]); w.w = cvt_pk_bf16(o[1][2], o[1][3]);
                *(u32x4*)rowp = w; }
    }
};
}
namespace pg8 {
template <class Epi, class Sched, bool ALIGN_EPI = false, bool SP2 = false>
__device__ __forceinline__ void gemm_phase(PG8_LAS unsigned char* lds, const Gemm g, const Sched& S, const Epi& E) {
    int tid = threadIdx.x; asm volatile("" : "+v"(tid)); const int wid = __builtin_amdgcn_readfirstlane(tid >> 6), lane = tid & 63, wr = wid >> 2, wc = wid & 3, fr = lane & 15, fq = lane >> 4;
    const int K = g.K, nt = K / BK;
    unsigned voffA[2], voffB[2];
#pragma unroll
    for (int i = 0; i < 2; ++i) { int R, C; stage_rc(tid * 16 + i * 8192, R, C); const int Rb = Epi::PERM ? ((R & ~31) + perm32(R & 31)) : R;
        voffA[i] = (unsigned)(R * K + C) * 2u; voffB[i] = (unsigned)(Rb * K + C) * 2u; }
    const size_t kstep = (size_t)(BK * 2);
    const size_t hstep = (size_t)HALF * K * 2;
    const size_t tstep = 2 * hstep;
    const unsigned ldsw = (unsigned)wid * 1024u;
    const int aoff = lds_byte(wr * 64 + fr, fq * 8), boff = lds_byte(wc * 32 + fr, fq * 8);
#define PG8_SA(b, h) (((b) * 2 + (h)) * HTB)
#define PG8_SB(b, h) ((4 + (b) * 2 + (h)) * HTB)
#define PG8_STAGE(bufoff, gbase, voff) do { _Pragma("unroll") for (int _i = 0; _i < 2; ++_i) \
        __builtin_amdgcn_global_load_lds((const unsigned*)((const char*)(gbase) + (voff)[_i]), (PG8_LAS unsigned*)(lds + (bufoff) + ldsw + _i * 8192), 16, 0, 0); } while (0)
#define PG8_LDA(dst, b, h) do { _Pragma("unroll") for (int m = 0; m < 4; ++m) _Pragma("unroll") for (int k = 0; k < 2; ++k) dst[m][k] = *(const PG8_LAS bf16x8*)(lds + PG8_SA(b, h) + aoff + m * 2048 + k * 1024); } while (0)
#define PG8_LDB(dst, b, h) do { _Pragma("unroll") for (int n = 0; n < 2; ++n) _Pragma("unroll") for (int k = 0; k < 2; ++k) dst[n][k] = *(const PG8_LAS bf16x8*)(lds + PG8_SB(b, h) + boff + n * 2048 + k * 1024); } while (0)
#define PG8_MMA(ai, bj, At, Bt) do { __builtin_amdgcn_s_setprio(1); _Pragma("unroll") for (int m = 0; m < 4; ++m) _Pragma("unroll") for (int n = 0; n < 2; ++n) _Pragma("unroll") for (int k = 0; k < 2; ++k) \
        acc[ai][bj][m][n] = __builtin_amdgcn_mfma_f32_16x16x32_bf16(Bt[n][k], At[m][k], acc[ai][bj][m][n], 0, 0, 0); __builtin_amdgcn_s_setprio(0); } while (0)
#define PG8_WAIT_V(n) asm volatile("s_waitcnt vmcnt(" #n ")" ::: "memory")
#define PG8_WAIT_L(n) asm volatile("s_waitcnt lgkmcnt(" #n ")" ::: "memory")
#define PG8_BAR __builtin_amdgcn_s_barrier()
#define PG8_SCHED __builtin_amdgcn_sched_barrier(0)
    Unit cur, nxt; int ui = 0;
    if (!S.next(0, cur)) return;
    f32x4 acc[2][2][4][2];
#pragma unroll
    for (int a = 0; a < 2; ++a)
#pragma unroll
        for (int b = 0; b < 2; ++b)
#pragma unroll
            for (int m = 0; m < 4; ++m)
#pragma unroll
                for (int n = 0; n < 2; ++n) acc[a][b][m][n] = (f32x4){0.f, 0.f, 0.f, 0.f};
    bf16x8 At[4][2], B0[2][2], B1[2][2];
    const char* cA = (const char*)g.A + (size_t)cur.pm * tstep; const char* cB = (const char*)g.Bt + (size_t)cur.pn * tstep;
    S.a_ready(cur);
    if constexpr (SP2) {
        PG8_STAGE(PG8_SB(0, 0), cB, voffB); PG8_STAGE(PG8_SB(0, 1), cB + hstep, voffB); PG8_STAGE(PG8_SA(0, 0), cA, voffA); PG8_STAGE(PG8_SA(0, 1), cA + hstep, voffA);
        if (wr == 1) PG8_BAR;
        PG8_WAIT_V(2); PG8_BAR;
        PG8_STAGE(PG8_SB(1, 0), cB + kstep, voffB); PG8_STAGE(PG8_SA(1, 0), cA + kstep, voffA); PG8_STAGE(PG8_SB(1, 1), cB + hstep + kstep, voffB);
        PG8_WAIT_V(6); PG8_BAR;
    } else {
        PG8_STAGE(PG8_SB(0, 0), cB, voffB); PG8_STAGE(PG8_SA(0, 0), cA, voffA); PG8_STAGE(PG8_SB(0, 1), cB + hstep, voffB); PG8_STAGE(PG8_SA(0, 1), cA + hstep, voffA);
        if (wr == 1) PG8_BAR;
        PG8_WAIT_V(4); PG8_BAR;
        PG8_STAGE(PG8_SB(1, 0), cB + kstep, voffB); PG8_STAGE(PG8_SA(1, 0), cA + kstep, voffA); PG8_STAGE(PG8_SB(1, 1), cB + hstep + kstep, voffB);
        PG8_WAIT_V(6); PG8_BAR;
    }
    for (;;) {
        const bool has_next = S.next(ui + 1, nxt);
        const char* nA = has_next ? (const char*)g.A + (size_t)nxt.pm * tstep : cA; const char* nB = has_next ? (const char*)g.Bt + (size_t)nxt.pn * tstep : cB;
        for (int t = 0; t < nt; t += 2) {
            const bool last = (t == nt - 2);
            const char* a1 = cA + (size_t)(t + 1) * kstep;
            const char* a2 = last ? nA : cA + (size_t)(t + 2) * kstep; const char* b2 = last ? nB : cB + (size_t)(t + 2) * kstep;
            const char* a3 = a2 + kstep; const char* b3 = b2 + kstep;
            if (last && has_next) S.a_ready(nxt);
            if constexpr (SP2) {
            PG8_LDB(B0, 0, 0); PG8_LDB(B1, 0, 1); PG8_SCHED; PG8_LDA(At, 0, 0); PG8_STAGE(PG8_SA(1, 1), a1 + hstep, voffA);
            PG8_WAIT_V(8); PG8_WAIT_L(0); PG8_BAR; PG8_MMA(0, 0, At, B0); PG8_MMA(0, 1, At, B1); PG8_BAR; PG8_SCHED;
            PG8_LDA(At, 0, 1); PG8_STAGE(PG8_SB(0, 0), b2, voffB); PG8_STAGE(PG8_SB(0, 1), b2 + hstep, voffB); PG8_STAGE(PG8_SA(0, 0), a2, voffA);
            PG8_WAIT_V(8); PG8_WAIT_L(0); PG8_BAR; PG8_MMA(1, 0, At, B0); PG8_MMA(1, 1, At, B1); PG8_BAR; PG8_SCHED;
            PG8_LDB(B0, 1, 0); PG8_LDB(B1, 1, 1); PG8_SCHED; PG8_LDA(At, 1, 0); PG8_STAGE(PG8_SA(0, 1), a2 + hstep, voffA);
            PG8_WAIT_V(8); PG8_WAIT_L(0); PG8_BAR; PG8_MMA(0, 0, At, B0); PG8_MMA(0, 1, At, B1); PG8_BAR; PG8_SCHED;
            PG8_LDA(At, 1, 1); PG8_STAGE(PG8_SB(1, 0), b3, voffB); PG8_STAGE(PG8_SB(1, 1), b3 + hstep, voffB); PG8_STAGE(PG8_SA(1, 0), a3, voffA);
            PG8_WAIT_V(8); PG8_WAIT_L(0); PG8_BAR; PG8_MMA(1, 0, At, B0); PG8_MMA(1, 1, At, B1); PG8_BAR; PG8_SCHED;
            } else {
            PG8_LDB(B0, 0, 0); PG8_SCHED; PG8_LDA(At, 0, 0); PG8_STAGE(PG8_SA(1, 1), a1 + hstep, voffA);
            PG8_WAIT_L(8); PG8_BAR; PG8_WAIT_L(0); PG8_MMA(0, 0, At, B0); PG8_BAR; PG8_SCHED;
            PG8_LDB(B1, 0, 1); PG8_STAGE(PG8_SB(0, 0), b2, voffB);
            PG8_BAR; PG8_WAIT_L(0); PG8_MMA(0, 1, At, B1); PG8_BAR;
            PG8_LDA(At, 0, 1); PG8_STAGE(PG8_SA(0, 0), a2, voffA);
            PG8_BAR; PG8_WAIT_L(0); PG8_MMA(1, 0, At, B0); PG8_BAR; PG8_SCHED;
            PG8_STAGE(PG8_SB(0, 1), b2 + hstep, voffB);
            PG8_WAIT_V(6); PG8_BAR; PG8_MMA(1, 1, At, B1); PG8_BAR;
            PG8_LDB(B0, 1, 0); PG8_SCHED; PG8_LDA(At, 1, 0); PG8_STAGE(PG8_SA(0, 1), a2 + hstep, voffA);
            PG8_WAIT_L(8); PG8_BAR; PG8_WAIT_L(0); PG8_MMA(0, 0, At, B0); PG8_BAR; PG8_SCHED;
            PG8_LDB(B1, 1, 1); PG8_STAGE(PG8_SB(1, 0), b3, voffB);
            PG8_BAR; PG8_WAIT_L(0); PG8_MMA(0, 1, At, B1); PG8_BAR;
            PG8_LDA(At, 1, 1); PG8_STAGE(PG8_SA(1, 0), a3, voffA);
            PG8_BAR; PG8_WAIT_L(0); PG8_MMA(1, 0, At, B0); PG8_BAR; PG8_SCHED;
            PG8_STAGE(PG8_SB(1, 1), b3 + hstep, voffB);
            PG8_WAIT_V(6); PG8_BAR; PG8_MMA(1, 1, At, B1); PG8_BAR;
            }
        }
        if constexpr (ALIGN_EPI) { if (wr == 0) PG8_BAR; }
        if constexpr (!Epi::AFTER_DRAIN) { E(acc, cur, wr, wc, fr, fq); S.done(cur); }
        if (!has_next) break;
#pragma unroll
        for (int a = 0; a < 2; ++a)
#pragma unroll
            for (int b = 0; b < 2; ++b)
#pragma unroll
                for (int m = 0; m < 4; ++m)
#pragma unroll
                    for (int n = 0; n < 2; ++n) acc[a][b][m][n] = (f32x4){0.f, 0.f, 0.f, 0.f};
        cur = nxt; cA = nA; cB = nB; ++ui;
        if constexpr (ALIGN_EPI) { if (wr == 1) PG8_BAR; }
    }
    PG8_WAIT_V(0);
    if constexpr (!ALIGN_EPI) { if (wr == 0) PG8_BAR; }
    PG8_BAR;
    if constexpr (Epi::AFTER_DRAIN) { E.fused(acc, cur, wr, wc, fr, fq, lds, wid, lane); S.done(cur); }
#undef PG8_SA
#undef PG8_SB
#undef PG8_STAGE
#undef PG8_LDA
#undef PG8_LDB
#undef PG8_MMA
#undef PG8_WAIT_V
#undef PG8_WAIT_L
#undef PG8_BAR
#undef PG8_SCHED
}
}
#include <hip/hip_cooperative_groups.h>
namespace cg = cooperative_groups;
#define LAS __attribute__((address_space(3)))
typedef unsigned short bf16;
typedef float f32x4 __attribute__((ext_vector_type(4)));
typedef float f32x2 __attribute__((ext_vector_type(2)));
typedef short bf16x8 __attribute__((ext_vector_type(8)));
typedef unsigned u32x4 __attribute__((ext_vector_type(4)));
typedef unsigned u32x2 __attribute__((ext_vector_type(2)));

constexpr int T = 16384, D = 1024, DEPTH = 4, FF = 4096;
constexpr int ZLD = 4608, ZN = 4864, ABIN = 4624, MIXLD = 1536;
constexpr int ZSX = 0, ZSB = 512, ZSC = 1024, ZQ = 1536, ZK = 2048, ZV = 2560, ZG = 3584;
constexpr float EPS = 1e-6f;
constexpr int NWAVES = 8, NTHR = 512;
constexpr int LDS_BYTES = 147456;
constexpr size_t MiB = 1u << 20;
constexpr size_t WS_DEC = 0;
constexpr size_t WS_W = 1 * MiB;
constexpr size_t WS_H = 30 * MiB;
constexpr size_t WS_BIG = 62 * MiB;
constexpr size_t WS_GK = 254 * MiB;
constexpr size_t WS_END = 255 * MiB;
constexpr size_t WO_MIX1 = 0;
constexpr size_t WO_MIX2_E = (size_t)ZN * D;
constexpr size_t WO_MIX2_O = (size_t)2048 * D;
constexpr size_t WO_W1 = (size_t)ZN * D + (size_t)D * MIXLD;
constexpr size_t WO_W2 = WO_W1 + (size_t)FF * D;
static_assert(WS_W + (WO_W2 + (size_t)FF * D) * 2 <= WS_H, "weights fit");

__device__ __forceinline__ int tid_l() { int t = threadIdx.x; asm volatile("" : "+v"(t)); return t; }
__device__ __forceinline__ float bf2f(unsigned b) { return __uint_as_float(b << 16); }
__device__ __forceinline__ unsigned pkbf(float lo, float hi) { return pg8::cvt_pk_bf16(lo, hi); }
__device__ __forceinline__ float wave_sum(float v) {
#pragma unroll
    for (int o = 1; o < 64; o <<= 1) v += __shfl_xor(v, o);
    return v;
}

template <int MODE>
__device__ __forceinline__ void transpose_item(const float* W, int K, int N, bf16* WT, LAS float* scr, int item, int lane) {
    const int nblk = (N + 31) / 32, kb = item / nblk, nb = item % nblk, k0 = 64 * kb, n0 = 32 * nb;
    const bool ok = (n0 + (lane & 31)) < N;
#pragma unroll 8
    for (int i = 0; i < 32; ++i) { const int kk = 2 * i + (lane >> 5); scr[kk * 33 + (lane & 31)] = ok ? W[(size_t)(k0 + kk) * N + n0 + (lane & 31)] : 0.f; }
    asm volatile("s_waitcnt lgkmcnt(0)" ::: "memory");
    int d0 = n0;
    if (MODE == 1) { const int half = n0 >> 10, c0 = n0 & 1023; d0 = ((c0 >> 7) << 8) + (half << 7) + (c0 & 127); }
    const int c = lane & 7;
#pragma unroll
    for (int j = 0; j < 4; ++j) { const int n = (lane >> 3) + 8 * j; const LAS float* s = scr + (8 * c) * 33 + n;
        u32x4 o; o.x = pkbf(s[0 * 33], s[1 * 33]); o.y = pkbf(s[2 * 33], s[3 * 33]); o.z = pkbf(s[4 * 33], s[5 * 33]); o.w = pkbf(s[6 * 33], s[7 * 33]);
        *(u32x4*)(WT + (size_t)(d0 + n) * K + k0 + 8 * c) = o; }
    asm volatile("s_waitcnt lgkmcnt(0)" ::: "memory");
}

struct Args { const float* in[21]; float* out; unsigned char* ws; int ph_lo, ph_hi; };
__device__ __forceinline__ const float* inp(int i) { const __attribute__((address_space(4))) char* kp = (const __attribute__((address_space(4))) char*)__builtin_amdgcn_kernarg_segment_ptr(); asm volatile("" : "+s"(kp)); return *(const float* const __attribute__((address_space(4)))*)(kp + 8 * i); }

__device__ __forceinline__ void convert_layer(unsigned char* wsp, int l, LAS unsigned char* lds, int gw, int NGW, int wave, int lane) {
    LAS float* scr = (LAS float*)(lds + wave * 8704);
    bf16* Wb = (bf16*)(wsp + WS_W);
    const int i2 = l >> 1;
    const float* w1 = inp(19) + (size_t)l * D * FF; const float* w2 = inp(20) + (size_t)l * FF * D;
    constexpr int I_W1 = (D / 64) * (FF / 32), I_W2 = (FF / 64) * (D / 32);
    if ((l & 1) == 0) {
        const float* win = inp(5) + (size_t)i2 * D * ABIN; const float* wout = inp(10) + (size_t)i2 * MIXLD * D;
        constexpr int I_IN = (D / 64) * ((ABIN + 31) / 32), I_OUT = (MIXLD / 64) * (D / 32);
        constexpr int NIT = I_IN + I_OUT + I_W1 + I_W2;
        for (int it = gw; it < NIT; it += NGW) { int r = it;
            if (r < I_IN) { transpose_item<0>(win, D, ABIN, Wb + WO_MIX1, scr, r, lane); continue; } r -= I_IN;
            if (r < I_OUT) { transpose_item<0>(wout, MIXLD, D, Wb + WO_MIX2_E, scr, r, lane); continue; } r -= I_OUT;
            if (r < I_W1) { transpose_item<0>(w1, D, FF, Wb + WO_W1, scr, r, lane); continue; } r -= I_W1;
            transpose_item<0>(w2, FF, D, Wb + WO_W2, scr, r, lane); }
        u32x4* pz = (u32x4*)(Wb + WO_MIX1 + (size_t)4640 * D); const int nz = (ZN - 4640) * D / 8;
        for (int i = gw * 64 + lane; i < nz; i += NGW * 64) pz[i] = (u32x4){0u, 0u, 0u, 0u};
    } else {
        const float* pw1 = inp(11) + (size_t)i2 * D * 2048; const float* pw2 = inp(17) + (size_t)i2 * D * D;
        constexpr int I_P1 = (D / 64) * (2048 / 32), I_P2 = (D / 64) * (D / 32);
        constexpr int NIT = I_P1 + I_P2 + I_W1 + I_W2;
        for (int it = gw; it < NIT; it += NGW) { int r = it;
            if (r < I_P1) { transpose_item<1>(pw1, D, 2048, Wb + WO_MIX1, scr, r, lane); continue; } r -= I_P1;
            if (r < I_P2) { transpose_item<0>(pw2, D, D, Wb + WO_MIX2_O, scr, r, lane); continue; } r -= I_P2;
            if (r < I_W1) { transpose_item<0>(w1, D, FF, Wb + WO_W1, scr, r, lane); continue; } r -= I_W1;
            transpose_item<0>(w2, FF, D, Wb + WO_W2, scr, r, lane); }
    }
}

template <bool HAS_Y, bool HAS_XD, bool HAS_PRE>
__device__ __forceinline__ void norm_rows(const float* y, const float* xs, float* xd, const float* gpost, const float* gpre, bf16* h, int gw, int NGW, int lane) {
    for (int row = gw; row < T; row += NGW) {
        const f32x4* xr = (const f32x4*)(xs + (size_t)row * D) + lane;
        f32x4 xv[4];
#pragma unroll
        for (int j = 0; j < 4; ++j) xv[j] = xr[64 * j];
        if (HAS_Y) {
            const f32x4* yr = (const f32x4*)(y + (size_t)row * D) + lane; f32x4 yv[4]; float s = 0.f;
#pragma unroll
            for (int j = 0; j < 4; ++j) { yv[j] = yr[64 * j]; s += (yv[j].x * yv[j].x + yv[j].y * yv[j].y) + (yv[j].z * yv[j].z + yv[j].w * yv[j].w); }
            const float r = 1.f / sqrtf(wave_sum(s) * (1.f / D) + EPS);
#pragma unroll
            for (int j = 0; j < 4; ++j) { const f32x4 g = ((const f32x4*)gpost)[64 * j + lane]; xv[j] = xv[j] + yv[j] * r * g; }
        }
        if (HAS_XD) { f32x4* xo = (f32x4*)(xd + (size_t)row * D) + lane;
#pragma unroll
            for (int j = 0; j < 4; ++j) xo[64 * j] = xv[j]; }
        if (HAS_PRE) {
            float s = 0.f;
#pragma unroll
            for (int j = 0; j < 4; ++j) s += (xv[j].x * xv[j].x + xv[j].y * xv[j].y) + (xv[j].z * xv[j].z + xv[j].w * xv[j].w);
            const float r = 1.f / sqrtf(wave_sum(s) * (1.f / D) + EPS);
            u32x2* ho = (u32x2*)(h + (size_t)row * D) + lane;
#pragma unroll
            for (int j = 0; j < 4; ++j) { const f32x4 g = ((const f32x4*)gpre)[64 * j + lane]; const f32x4 v = xv[j] * r * g; u32x2 w; w.x = pkbf(v.x, v.y); w.y = pkbf(v.z, v.w); ho[64 * j] = w; }
        }
    }
}

constexpr int G_QD = 0, G_KD = 17408, G_KLT = 34816, G_VT = 53248, G_P = 90112, G_SEG = 99328, G_EBL = 101376, G_SS = 101888;
#define MFMA16(a, b, c) __builtin_amdgcn_mfma_f32_16x16x32_bf16(a, b, c, 0, 0, 0)
template <bool OUT>
__device__ __forceinline__ void gla_unit(int unit, const bf16* z, const float* gklr, const float* wgk2, const float* bgk2, const float* normg, float* E, float* DEC, bf16* mix, LAS unsigned char* lds) {
    const int tid = tid_l(), lane = tid & 63, w = __builtin_amdgcn_readfirstlane(tid >> 6), r = lane & 15, q = lane >> 4;
    const int g = unit >> 2, h = unit & 3;
    const int k = tid & 127, seg = tid >> 7, hk = h * 128 + k;
    const int vv = tid & 255, jh = tid >> 8;
    f32x4 S[8][2];
    float* Eu = E + (size_t)unit * 32768 + (size_t)w * 4096 + lane;
    if (OUT) {
#pragma unroll
        for (int mt = 0; mt < 8; ++mt)
#pragma unroll
            for (int nt = 0; nt < 2; ++nt)
#pragma unroll
                for (int i = 0; i < 4; ++i) S[mt][nt][i] = Eu[((mt * 2 + nt) * 4 + i) * 64];
    } else {
#pragma unroll
        for (int mt = 0; mt < 8; ++mt)
#pragma unroll
            for (int nt = 0; nt < 2; ++nt) S[mt][nt] = (f32x4){0.f, 0.f, 0.f, 0.f};
    }
    float bsum = 0.f;
    LAS float* SEG = (LAS float*)(lds + G_SEG); LAS float* EBL = (LAS float*)(lds + G_EBL); LAS float* SSQ = (LAS float*)(lds + G_SS);
    for (int ch = 0; ch < 4; ++ch) {
        const int t0 = g * 256 + ch * 64;
        int zofs = 0; asm volatile("" : "+v"(zofs));
        float w2r[16];
#pragma unroll
        for (int i = 0; i < 16; ++i) w2r[i] = wgk2[i * 512 + hk + zofs];
        const float bias = bgk2[hk + zofs];
        float b[16]; float run = 0.f;
#pragma unroll
        for (int jj = 0; jj < 16; ++jj) {
            const f32x4* gp = (const f32x4*)(gklr + (size_t)(t0 + seg * 16 + jj) * 16);
            const f32x4 g0 = gp[0], g1 = gp[1], g2 = gp[2], g3 = gp[3];
            float gv = bias;
            gv += g0.x * w2r[0] + g0.y * w2r[1] + g0.z * w2r[2] + g0.w * w2r[3];
            gv += g1.x * w2r[4] + g1.y * w2r[5] + g1.z * w2r[6] + g1.w * w2r[7];
            gv += g2.x * w2r[8] + g2.y * w2r[9] + g2.z * w2r[10] + g2.w * w2r[11];
            gv += g3.x * w2r[12] + g3.y * w2r[13] + g3.z * w2r[14] + g3.w * w2r[15];
            const float ls = -(fmaxf(-gv, 0.f) + log1pf(__expf(-fabsf(gv)))) * (1.f / 16.f);
            run += ls; b[jj] = run;
        }
        SEG[seg * 128 + k] = run;
        __syncthreads();
        float pre = 0.f, tot = 0.f;
#pragma unroll
        for (int s = 0; s < 4; ++s) { const float v = SEG[s * 128 + k]; tot += v; pre += (s < seg) ? v : 0.f; }
        if (seg == 0) { EBL[k] = __expf(tot); bsum += tot; }
        {
            unsigned klp[8];
#pragma unroll
            for (int jj = 0; jj < 16; jj += 2) {
                float kl2[2];
#pragma unroll
                for (int e = 0; e < 2; ++e) {
                    const int j = seg * 16 + jj + e; const bf16* zr = z + (size_t)(t0 + j) * ZLD; const float bb = b[jj + e] + pre;
                    const float kv = bf2f(zr[ZK + hk]);
                    kl2[e] = kv * __expf(tot - bb);
                    if (OUT) { const float qv = bf2f(zr[ZQ + hk]);
                        *(LAS bf16*)(lds + G_QD + (j * 136 + k) * 2) = (bf16)(pkbf(qv * 0.08838834764831845f * __expf(bb), 0.f) & 0xffffu);
                        *(LAS bf16*)(lds + G_KD + (j * 136 + k) * 2) = (bf16)(pkbf(kv * __expf(-bb), 0.f) & 0xffffu); }
                }
                klp[jj >> 1] = pkbf(kl2[0], kl2[1]);
            }
            LAS u32x4* kp = (LAS u32x4*)(lds + G_KLT + k * 144 + seg * 32);
            kp[0] = (u32x4){klp[0], klp[1], klp[2], klp[3]}; kp[1] = (u32x4){klp[4], klp[5], klp[6], klp[7]};
        }
        {
            const bf16* zv = z + (size_t)(t0 + jh * 32) * ZLD + ZV + h * 256 + vv;
            unsigned vp[16];
#pragma unroll
            for (int jj = 0; jj < 32; jj += 2) vp[jj >> 1] = (unsigned)zv[(size_t)jj * ZLD] | ((unsigned)zv[(size_t)(jj + 1) * ZLD] << 16);
            LAS u32x4* vpp = (LAS u32x4*)(lds + G_VT + vv * 144 + jh * 64);
#pragma unroll
            for (int i = 0; i < 4; ++i) vpp[i] = (u32x4){vp[4 * i], vp[4 * i + 1], vp[4 * i + 2], vp[4 * i + 3]};
        }
        __syncthreads();
        if (OUT) {
            const int jt = w >> 1;
#pragma unroll
            for (int ii = 0; ii < 2; ++ii) {
                const int it = (w & 1) * 2 + ii;
                f32x4 pa = (f32x4){0.f, 0.f, 0.f, 0.f};
                if (jt <= it) {
#pragma unroll
                    for (int s = 0; s < 4; ++s) {
                        const bf16x8 A = *(const LAS bf16x8*)(lds + G_KD + ((16 * jt + r) * 136 + 32 * s + 8 * q) * 2);
                        const bf16x8 B = *(const LAS bf16x8*)(lds + G_QD + ((16 * it + r) * 136 + 32 * s + 8 * q) * 2);
                        pa = MFMA16(A, B, pa);
                    }
                    const int i_ = 16 * it + r;
#pragma unroll
                    for (int e = 0; e < 4; ++e) { const int j_ = 16 * jt + 4 * q + e; if (j_ > i_) pa[e] = 0.f; }
                }
                u32x2 pw; pw.x = pkbf(pa[0], pa[1]); pw.y = pkbf(pa[2], pa[3]);
                *(LAS u32x2*)(lds + G_P + ((16 * it + r) * 72 + 16 * jt + 4 * q) * 2) = pw;
            }
            __syncthreads();
        }
        bf16x8 Bv[2][2];
#pragma unroll
        for (int s2 = 0; s2 < 2; ++s2)
#pragma unroll
            for (int nt = 0; nt < 2; ++nt) Bv[s2][nt] = *(const LAS bf16x8*)(lds + G_VT + ((32 * w + 16 * nt + r) * 72 + 32 * s2 + 8 * q) * 2);
        f32x4 o[4][2];
        if (OUT) {
#pragma unroll
            for (int mt = 0; mt < 4; ++mt)
#pragma unroll
                for (int nt = 0; nt < 2; ++nt) o[mt][nt] = (f32x4){0.f, 0.f, 0.f, 0.f};
#pragma unroll
            for (int s = 0; s < 4; ++s) {
                bf16x8 Sb[2];
#pragma unroll
                for (int nt = 0; nt < 2; ++nt) {
                    u32x4 t; t.x = pkbf(S[2 * s][nt][0], S[2 * s][nt][1]); t.y = pkbf(S[2 * s][nt][2], S[2 * s][nt][3]);
                    t.z = pkbf(S[2 * s + 1][nt][0], S[2 * s + 1][nt][1]); t.w = pkbf(S[2 * s + 1][nt][2], S[2 * s + 1][nt][3]);
                    Sb[nt] = __builtin_bit_cast(bf16x8, t);
                }
#pragma unroll
                for (int mt = 0; mt < 4; ++mt) {
                    const u32x2 lo = *(const LAS u32x2*)(lds + G_QD + ((16 * mt + r) * 136 + 32 * s + 4 * q) * 2);
                    const u32x2 hi = *(const LAS u32x2*)(lds + G_QD + ((16 * mt + r) * 136 + 32 * s + 16 + 4 * q) * 2);
                    const bf16x8 A = __builtin_bit_cast(bf16x8, (u32x4){lo.x, lo.y, hi.x, hi.y});
#pragma unroll
                    for (int nt = 0; nt < 2; ++nt) o[mt][nt] = MFMA16(A, Sb[nt], o[mt][nt]);
                }
            }
#pragma unroll
            for (int s2 = 0; s2 < 2; ++s2)
#pragma unroll
                for (int mt = 0; mt < 4; ++mt) {
                    const bf16x8 A = *(const LAS bf16x8*)(lds + G_P + ((16 * mt + r) * 72 + 32 * s2 + 8 * q) * 2);
#pragma unroll
                    for (int nt = 0; nt < 2; ++nt) o[mt][nt] = MFMA16(A, Bv[s2][nt], o[mt][nt]);
                }
        }
#pragma unroll
        for (int mt = 0; mt < 8; ++mt) {
            const f32x4 eb = *(const LAS f32x4*)(lds + G_EBL + (16 * mt + 4 * q) * 4);
#pragma unroll
            for (int nt = 0; nt < 2; ++nt) S[mt][nt] = S[mt][nt] * eb;
#pragma unroll
            for (int s2 = 0; s2 < 2; ++s2) {
                const bf16x8 A = *(const LAS bf16x8*)(lds + G_KLT + ((16 * mt + r) * 72 + 32 * s2 + 8 * q) * 2);
#pragma unroll
                for (int nt = 0; nt < 2; ++nt) S[mt][nt] = MFMA16(A, Bv[s2][nt], S[mt][nt]);
            }
        }
        if (OUT) {
#pragma unroll
            for (int mt = 0; mt < 4; ++mt)
#pragma unroll
                for (int e = 0; e < 4; ++e) {
                    float s = o[mt][0][e] * o[mt][0][e] + o[mt][1][e] * o[mt][1][e];
                    s += __shfl_xor(s, 1); s += __shfl_xor(s, 2); s += __shfl_xor(s, 4); s += __shfl_xor(s, 8);
                    if (r == 0) SSQ[(16 * mt + 4 * q + e) * 8 + w] = s;
                }
            __syncthreads();
            const float ng0 = normg[32 * w + r], ng1 = normg[32 * w + 16 + r];
#pragma unroll
            for (int mt = 0; mt < 4; ++mt)
#pragma unroll
                for (int e = 0; e < 4; ++e) {
                    const int i_ = 16 * mt + 4 * q + e;
                    const f32x4 sa = *(const LAS f32x4*)(lds + G_SS + i_ * 32), sb = *(const LAS f32x4*)(lds + G_SS + i_ * 32 + 16);
                    const float tot2 = ((sa.x + sa.y) + (sa.z + sa.w)) + ((sb.x + sb.y) + (sb.z + sb.w));
                    const float rs = 1.f / sqrtf(tot2 * (1.f / 256.f) + EPS);
                    const bf16* zg = z + (size_t)(t0 + i_) * ZLD + ZG + h * 256 + 32 * w + r;
                    bf16* mo = mix + (size_t)(t0 + i_) * MIXLD + 512 + h * 256 + 32 * w + r;
                    const float ga = bf2f(zg[0]), gb = bf2f(zg[16]);
                    const float va = o[mt][0][e] * rs * ng0 * ga * __builtin_amdgcn_rcpf(1.f + __expf(-ga));
                    const float vb = o[mt][1][e] * rs * ng1 * gb * __builtin_amdgcn_rcpf(1.f + __expf(-gb));
                    const unsigned pv = pkbf(va, vb);
                    mo[0] = (bf16)(pv & 0xffffu); mo[16] = (bf16)(pv >> 16);
                }
        }
        __syncthreads();
    }
    if (!OUT) {
#pragma unroll
        for (int mt = 0; mt < 8; ++mt)
#pragma unroll
            for (int nt = 0; nt < 2; ++nt)
#pragma unroll
                for (int i = 0; i < 4; ++i) Eu[((mt * 2 + nt) * 4 + i) * 64] = S[mt][nt][i];
        if (seg == 0) DEC[unit * 128 + k] = __expf(bsum);
    }
}

__device__ __forceinline__ void shortconv(const bf16* z, const float* wsc, bf16* mix, int gtid, int gthreads) {
    for (int idx = gtid; idx < T * 256; idx += gthreads) {
        const int t = idx >> 8, c = (idx & 255) * 2;
        float a0 = 0.f, a1 = 0.f;
#pragma unroll
        for (int j = 0; j < 3; ++j) { const int tt = t - 2 + j;
            if (tt >= 0) { const bf16* zr = z + (size_t)tt * ZLD; const unsigned x2 = *(const unsigned*)(zr + ZSX + c), c2 = *(const unsigned*)(zr + ZSC + c);
                const f32x2 wj = *(const f32x2*)(wsc + j * 512 + c);
                a0 += wj.x * (bf2f(x2 & 0xffffu) * bf2f(c2 & 0xffffu)); a1 += wj.y * (bf2f(x2 >> 16) * bf2f(c2 >> 16)); } }
        const unsigned b2 = *(const unsigned*)(z + (size_t)t * ZLD + ZSB + c);
        *(unsigned*)(mix + (size_t)t * MIXLD + c) = pkbf(bf2f(b2 & 0xffffu) * a0, bf2f(b2 >> 16) * a1);
    }
}

__device__ __forceinline__ void gla_scan(float* E, const float* DEC, int gtid, int gthreads) {
    for (int e = gtid; e < 4 * 32768; e += gthreads) {
        const int h = e >> 15, rem = e & 32767, rr = (rem >> 6) & 63, ln = rem & 63;
        const int k = 16 * (rr >> 3) + 4 * (ln >> 4) + (rr & 3);
        float s = 0.f;
#pragma unroll 8
        for (int g = 0; g < 64; ++g) { float* p = E + (size_t)(g * 4 + h) * 32768 + rem; const float tmp = *p; *p = s; s = DEC[(g * 4 + h) * 128 + k] * s + tmp; }
    }
}

__device__ __forceinline__ void conv_phase(const bf16* u, const float* wdw, const float* bdw, const float* lng, const float* lnb, bf16* dout, LAS unsigned char* lds, int G, int bid) {
    const int tid = tid_l(), lane = tid & 63, w = tid >> 6;
    LAS unsigned* UL = (LAS unsigned*)lds;
    LAS f32x2* RED = (LAS f32x2*)(lds + 126976);
    LAS f32x2* STAT = (LAS f32x2*)(lds + 126976 + 2048);
    float w0[31], w1[31];
#pragma unroll
    for (int j = 0; j < 31; ++j) { const f32x2 t = *(const f32x2*)(wdw + j * 1024 + 2 * tid); w0[j] = t.x; w1[j] = t.y; }
    const f32x2 bd = *(const f32x2*)(bdw + 2 * tid), lg = *(const f32x2*)(lng + 2 * tid), lb = *(const f32x2*)(lnb + 2 * tid);
    for (int tile = bid; tile < T / 32; tile += G) {
        const int t0 = tile * 32;
        for (int i = tid; i < 62 * 128; i += NTHR) { const int rr = i >> 7, cc = i & 127, t = t0 - 30 + rr;
            u32x4 v = (u32x4){0u, 0u, 0u, 0u}; if (t >= 0) v = *(const u32x4*)(u + (size_t)t * D + cc * 8);
            *(LAS u32x4*)(lds + rr * 2048 + cc * 16) = v; }
        __syncthreads();
#pragma unroll 1
        for (int sub = 0; sub < 2; ++sub) {
            float d0[16], d1[16];
#pragma unroll
            for (int tt = 0; tt < 16; ++tt) { d0[tt] = bd.x; d1[tt] = bd.y; }
            const LAS unsigned* ULs = UL + sub * 16 * 512 + tid;
#pragma unroll
            for (int rr = 0; rr < 46; ++rr) {
                const unsigned uu = ULs[rr * 512]; const float ua = bf2f(uu & 0xffffu), ub = bf2f(uu >> 16);
#pragma unroll
                for (int tt = 0; tt < 16; ++tt) { if (rr - tt >= 0 && rr - tt <= 30) { d0[tt] += w0[rr - tt] * ua; d1[tt] += w1[rr - tt] * ub; } }
                if ((rr & 7) == 7) __builtin_amdgcn_sched_barrier(0);
            }
#pragma unroll
            for (int tt = 0; tt < 16; ++tt) {
                float s1 = d0[tt] + d1[tt], s2 = d0[tt] * d0[tt] + d1[tt] * d1[tt];
                s1 = wave_sum(s1); s2 = wave_sum(s2);
                if (lane == 0) RED[tt * 8 + w] = (f32x2){s1, s2};
            }
            __syncthreads();
            if (tid < 16) { float s1 = 0.f, s2 = 0.f;
#pragma unroll
                for (int i = 0; i < 8; ++i) { const f32x2 t = RED[tid * 8 + i]; s1 += t.x; s2 += t.y; }
                const float mean = s1 * (1.f / D); const float var = fmaxf(s2 * (1.f / D) - mean * mean, 0.f);
                STAT[tid] = (f32x2){mean, 1.f / sqrtf(var + EPS)}; }
            __syncthreads();
#pragma unroll
            for (int tt = 0; tt < 16; ++tt) {
                const f32x2 st = STAT[tt];
                const float a = (d0[tt] - st.x) * st.y * lg.x + lb.x, b = (d1[tt] - st.x) * st.y * lg.y + lb.y;
                const float sa = a * __builtin_amdgcn_rcpf(1.f + __expf(-a)), sb = b * __builtin_amdgcn_rcpf(1.f + __expf(-b));
                *(unsigned*)(dout + (size_t)(t0 + sub * 16 + tt) * D + 2 * tid) = pkbf(sa, sb);
            }
        }
        __syncthreads();
    }
}

__global__ void __launch_bounds__(NTHR, 2) trunk_fwd(Args a) {
    extern __shared__ __attribute__((aligned(16))) unsigned char lds_raw[];
    LAS unsigned char* lds = (LAS unsigned char*)lds_raw;
    cg::grid_group grid = cg::this_grid();
    const int G0 = gridDim.x;
#define IDS int bid = blockIdx.x; asm volatile("" : "+s"(bid)); const int tid = tid_l(), lane = tid & 63, wave = __builtin_amdgcn_readfirstlane(tid >> 6), gw = bid * NWAVES + wave, gtid = bid * NTHR + tid; (void)lane; (void)gw; (void)gtid;
    unsigned char* ws = a.ws; float* const xout = a.out;
#define Wb ((bf16*)(wsl + WS_W))
#define Hb ((bf16*)(wsl + WS_H))
#define Eb ((float*)(wsl + WS_H))
#define DEC ((float*)(wsl + WS_DEC))
#define GK ((float*)(wsl + WS_GK))
#define big (wsl + WS_BIG)
#define Z ((bf16*)big)
#define MIX ((bf16*)(big + 144 * MiB))
#define U ((bf16*)big)
#define Dd ((bf16*)(big + 32 * MiB))
#define Ab ((bf16*)big)
#define ymlp ((float*)(big + 128 * MiB))
#define ymix ((float*)(big + ((l & 1) ? 64 * MiB : 0)))
#ifndef PH_LO
#define PH_LO 0
#endif
#ifndef PH_HI
#define PH_HI 33
#endif
    constexpr int lo = PH_LO, hi = PH_HI;
    int ph = 0;
#define PH_BEGIN if (ph >= lo && ph < hi) { IDS unsigned char* wsl = ws; asm volatile("" : "+s"(wsl)); int G = G0; asm volatile("" : "+s"(G)); const int NGW = G * NWAVES, gthreads = G * NTHR; (void)NGW; (void)gthreads;
#define PH_END   if (ph + 1 < hi) grid.sync(); } ++ph;

    PH_BEGIN
        convert_layer(wsl, 0, lds, gw, NGW, wave, lane);
        norm_rows<false, false, true>(nullptr, inp(0), nullptr, nullptr, inp(1), Hb, gw, NGW, lane);
    PH_END

    for (int l = 0; l < DEPTH; ++l) {
        const int i2 = l >> 1;
        const bool first = (l == 0);
        if ((l & 1) == 0) {
            PH_BEGIN
                pg8::Gemm g{Hb, Wb + WO_MIX1, T, ZN, D}; pg8::StaticOrder S; S.init(T, ZN, G, bid);
                pg8::EpiZ E{Z, GK};
                pg8::gemm_phase<pg8::EpiZ, pg8::StaticOrder, true, true>(lds, g, S, E);
            PH_END
            PH_BEGIN
                for (int un = bid; un < 256; un += G)
                    gla_unit<false>(un, Z, GK, inp(6) + (size_t)i2 * 16 * 512, inp(7) + (size_t)i2 * 512, inp(9) + (size_t)i2 * 256, Eb, DEC, MIX, lds);
                shortconv(Z, inp(8) + (size_t)i2 * 3 * 512, MIX, gtid, gthreads);
            PH_END
            PH_BEGIN
                gla_scan(Eb, DEC, gtid, gthreads);
            PH_END
            PH_BEGIN
                for (int un = bid; un < 256; un += G)
                    gla_unit<true>(un, Z, GK, inp(6) + (size_t)i2 * 16 * 512, inp(7) + (size_t)i2 * 512, inp(9) + (size_t)i2 * 256, Eb, DEC, MIX, lds);
            PH_END
            PH_BEGIN
                pg8::Gemm g{MIX, Wb + WO_MIX2_E, T, D, MIXLD}; pg8::StaticOrder S; S.init(T, D, G, bid);
                pg8::EpiF32<false> E{ymix, D, nullptr};
                pg8::gemm_phase<pg8::EpiF32<false>, pg8::StaticOrder, false, true>(lds, g, S, E);
            PH_END
        } else {
            PH_BEGIN
                pg8::Gemm g{Hb, Wb + WO_MIX1, T, 2048, D}; pg8::StaticOrder S; S.init(T, 2048, G, bid);
                pg8::EpiGLU E{U, inp(12) + (size_t)i2 * 2048};
                pg8::gemm_phase<pg8::EpiGLU, pg8::StaticOrder, true, true>(lds, g, S, E);
            PH_END
            PH_BEGIN
                conv_phase(U, inp(13) + (size_t)i2 * 31 * D, inp(14) + (size_t)i2 * D, inp(15) + (size_t)i2 * D, inp(16) + (size_t)i2 * D, Dd, lds, G, bid);
            PH_END
            PH_BEGIN
                pg8::Gemm g{Dd, Wb + WO_MIX2_O, T, D, D}; pg8::StaticOrder S; S.init(T, D, G, bid);
                pg8::EpiF32<true> E{ymix, D, inp(18) + (size_t)i2 * D};
                pg8::gemm_phase<pg8::EpiF32<true>, pg8::StaticOrder, false, true>(lds, g, S, E);
            PH_END
        }
        PH_BEGIN
            norm_rows<true, true, true>(ymix, first ? inp(0) : xout, xout, inp(2) + (size_t)l * D, inp(3) + (size_t)l * D, Hb, gw, NGW, lane);
        PH_END
        PH_BEGIN
            pg8::Gemm g{Hb, Wb + WO_W1, T, FF, D}; pg8::StaticOrder S; S.init(T, FF, G, bid);
            pg8::EpiRelu2 E{Ab, FF};
            pg8::gemm_phase<pg8::EpiRelu2, pg8::StaticOrder, true, true>(lds, g, S, E);
        PH_END
        PH_BEGIN
            pg8::Gemm g{Ab, Wb + WO_W2, T, D, FF}; pg8::StaticOrder S; S.init(T, D, G, bid);
            pg8::EpiF32<false> E{ymlp, D, nullptr};
            pg8::gemm_phase<pg8::EpiF32<false>, pg8::StaticOrder, false, true>(lds, g, S, E);
        PH_END
        PH_BEGIN
            if (l + 1 < DEPTH) convert_layer(wsl, l + 1, lds, gw, NGW, wave, lane);
            if (l + 1 < DEPTH) norm_rows<true, true, true>(ymlp, xout, xout, inp(4) + (size_t)l * D, inp(1) + (size_t)(l + 1) * D, Hb, gw, NGW, lane);
            else norm_rows<true, true, false>(ymlp, xout, xout, inp(4) + (size_t)l * D, nullptr, Hb, gw, NGW, lane);
        PH_END
    }
}

extern "C" void kernel_launch(void* const* d_in, const int* in_sizes, int n_in, void* d_out, int out_size, void* d_ws, size_t ws_size, hipStream_t stream) {
    static int grid = 0;
    if (grid == 0) {
        if (n_in != 21 || out_size != T * D || ws_size < WS_END) { fprintf(stderr, "kernel_launch: unexpected shapes (n_in %d out %d ws %zu)\n", n_in, out_size, ws_size); grid = -1; return; }
        int dev = 0, cus = 0, per_cu = 0;
        hipGetDevice(&dev); hipDeviceGetAttribute(&cus, hipDeviceAttributeMultiprocessorCount, dev);
        if (hipFuncSetAttribute((const void*)trunk_fwd, hipFuncAttributeMaxDynamicSharedMemorySize, LDS_BYTES) != hipSuccess) { fprintf(stderr, "kernel_launch: hipFuncSetAttribute failed\n"); grid = -1; return; }
        if (hipOccupancyMaxActiveBlocksPerMultiprocessor(&per_cu, (const void*)trunk_fwd, NTHR, LDS_BYTES) != hipSuccess || per_cu < 1) { fprintf(stderr, "kernel_launch: occupancy query failed (%d)\n", per_cu); (void)hipGetLastError(); per_cu = 1; }
        grid = cus * per_cu; if (grid > 256) grid = 256;
    }
    if (grid < 0) return;
    Args a{};
    for (int i = 0; i < 21; ++i) a.in[i] = (const float*)d_in[i];
    a.out = (float*)d_out; a.ws = (unsigned char*)d_ws; a.ph_lo = 0; a.ph_hi = 33;
    void* args[] = {&a};
    hipError_t e = hipLaunchCooperativeKernel((const void*)trunk_fwd, dim3(grid), dim3(NTHR), args, LDS_BYTES, stream);
    if (e != hipSuccess) fprintf(stderr, "cooperative launch failed: %s (grid %d)\n", hipGetErrorString(e), grid);
}
```

```cpp
#include <hip/hip_runtime.h>
#include <cstdio>
#include <cstdint>
namespace pg8 {
#define PG8_LAS __attribute__((address_space(3)))
typedef unsigned short bf16_t;
typedef short bf16x8 __attribute__((ext_vector_type(8)));
typedef float f32x4 __attribute__((ext_vector_type(4)));
typedef unsigned u32x4 __attribute__((ext_vector_type(4)));
constexpr int BM = 256, BK = 64, HALF = 128, HTB = HALF * BK * 2  , STAGE_BYTES = 8 * HTB, NXCD = 8, WGM = 8;

__host__ __device__ __forceinline__ int lds_byte(int r, int c) { const int st = (r >> 4) * 2 + (c >> 5), rr = r & 15, cc = c & 31, ob = rr * 64 + cc * 2; return st * 1024 + (ob ^ (((ob >> 9) & 1) << 5)); }
__host__ __device__ __forceinline__ void stage_rc(int b, int& R, int& C) { const int st = b / 1024, sb = b % 1024, swz = sb ^ (((sb >> 9) & 1) << 5); R = (st >> 1) * 16 + swz / 64; C = (st & 1) * 32 + (swz % 64) / 2; }
__host__ __device__ __forceinline__ int perm32(int rho) { const int n = rho >> 4, i = rho & 15; return 8 * (i >> 2) + 4 * n + (i & 3); }

struct Unit { int pm, pn; };
struct Gemm { const bf16_t* A; const bf16_t* Bt; int M, N, K; };

struct StaticOrder {
    int nM, nN, nwg, G, c;
    __host__ __device__ void init(int M, int N, int G_, int c_) { nM = M / BM; nN = N / BM; nwg = nM * nN; G = G_; c = c_; }
    __host__ __device__ bool next(int i, Unit& u) const {
        const long L = (long)i * G + c; if (L >= nwg) return false;
        int wgid = (int)L; { const int q = nwg / NXCD, r = nwg % NXCD, xcd = wgid % NXCD, off = wgid / NXCD; wgid = (xcd < r ? xcd * (q + 1) : r * (q + 1) + (xcd - r) * q) + off; }
        const int nig = WGM * nN, gid = wgid / nig, fm = gid * WGM, gsz = (nM - fm) < WGM ? (nM - fm) : WGM;
        u.pm = fm + ((wgid % nig) % gsz); u.pn = (wgid % nig) / gsz; return true;
    }
    __device__ __forceinline__ void a_ready(const Unit&) const {}
    __device__ __forceinline__ void done(const Unit&) const {}
};
__device__ __forceinline__ unsigned cvt_pk_bf16(float lo, float hi) { unsigned r; asm volatile("v_cvt_pk_bf16_f32 %0, %1, %2" : "=v"(r) : "v"(lo), "v"(hi)); return r; }
typedef float f32x2 __attribute__((ext_vector_type(2)));
}
namespace pg8 {
struct EpiZ {
    static constexpr bool PERM = true, AFTER_DRAIN = false;
    bf16_t* Z; float* GK;
    __device__ __forceinline__ void operator()(const f32x4 (&acc)[2][2][4][2], const Unit& u, int wr, int wc, int fr, int fq) const {
        const int row0 = u.pm * BM + wr * 64 + fr;
        if (u.pn < 18) {
            const int col0 = u.pn * BM + wc * 32 + 8 * fq;
#pragma unroll
            for (int ai = 0; ai < 2; ++ai)
#pragma unroll
                for (int m = 0; m < 4; ++m) { bf16_t* rowp = Z + (size_t)(row0 + ai * HALF + m * 16) * 4608 + col0;
#pragma unroll
                    for (int bj = 0; bj < 2; ++bj) { const f32x4 v0 = acc[ai][bj][m][0], v1 = acc[ai][bj][m][1];
                        u32x4 w; w.x = cvt_pk_bf16(v0[0], v0[1]); w.y = cvt_pk_bf16(v0[2], v0[3]); w.z = cvt_pk_bf16(v1[0], v1[1]); w.w = cvt_pk_bf16(v1[2], v1[3]);
                        *(u32x4*)(rowp + bj * HALF) = w; } }
        } else if (wc == 0 && fq < 2) {
#pragma unroll
            for (int ai = 0; ai < 2; ++ai)
#pragma unroll
                for (int m = 0; m < 4; ++m) { float* rp = GK + (size_t)(row0 + ai * HALF + m * 16) * 16 + 8 * fq;
                    *(f32x4*)rp = acc[ai][0][m][0]; *(f32x4*)(rp + 4) = acc[ai][0][m][1]; }
        }
    }
};
template <bool HAS_BIAS> struct EpiF32 {
    static constexpr bool PERM = false, AFTER_DRAIN = false;
    float* C; int ldc; const float* bias;
    __device__ __forceinline__ void operator()(const f32x4 (&acc)[2][2][4][2], const Unit& u, int wr, int wc, int fr, int fq) const {
        const int row0 = u.pm * BM + wr * 64 + fr, col0 = u.pn * BM + wc * 32 + 4 * fq;
        f32x4 bv[2][2];
#pragma unroll
        for (int bj = 0; bj < 2; ++bj)
#pragma unroll
            for (int n = 0; n < 2; ++n) bv[bj][n] = HAS_BIAS ? *(const f32x4*)(bias + col0 + bj * HALF + n * 16) : (f32x4){0.f, 0.f, 0.f, 0.f};
#pragma unroll
        for (int ai = 0; ai < 2; ++ai)
#pragma unroll
            for (int m = 0; m < 4; ++m) { float* rowp = C + (size_t)(row0 + ai * HALF + m * 16) * ldc + col0;
#pragma unroll
                for (int bj = 0; bj < 2; ++bj)
#pragma unroll
                    for (int n = 0; n < 2; ++n) *(f32x4*)(rowp + bj * HALF + n * 16) = acc[ai][bj][m][n] + bv[bj][n]; }
    }
};
struct EpiRelu2 {
    static constexpr bool PERM = true, AFTER_DRAIN = false;
    bf16_t* O; int ldc;
    __device__ __forceinline__ void operator()(const f32x4 (&acc)[2][2][4][2], const Unit& u, int wr, int wc, int fr, int fq) const {
        const int row0 = u.pm * BM + wr * 64 + fr, col0 = u.pn * BM + wc * 32 + 8 * fq;
#pragma unroll
        for (int ai = 0; ai < 2; ++ai)
#pragma unroll
            for (int m = 0; m < 4; ++m) { bf16_t* rowp = O + (size_t)(row0 + ai * HALF + m * 16) * ldc + col0;
#pragma unroll
                for (int bj = 0; bj < 2; ++bj) { f32x4 v0 = acc[ai][bj][m][0], v1 = acc[ai][bj][m][1];
#pragma unroll
                    for (int j = 0; j < 4; ++j) { const float a = fmaxf(v0[j], 0.f), b = fmaxf(v1[j], 0.f); v0[j] = a * a; v1[j] = b * b; }
                    u32x4 w; w.x = cvt_pk_bf16(v0[0], v0[1]); w.y = cvt_pk_bf16(v0[2], v0[3]); w.z = cvt_pk_bf16(v1[0], v1[1]); w.w = cvt_pk_bf16(v1[2], v1[3]);
                    *(u32x4*)(rowp + bj * HALF) = w; } }
    }
};
struct EpiGLU {
    static constexpr bool PERM = true, AFTER_DRAIN = false;
    bf16_t* U; const float* bias;
    __device__ __forceinline__ void operator()(const f32x4 (&acc)[2][2][4][2], const Unit& u, int wr, int wc, int fr, int fq) const {
        const int row0 = u.pm * BM + wr * 64 + fr, col0 = u.pn * HALF + wc * 32 + 8 * fq;
        f32x4 b1[2], b2[2];
#pragma unroll
        for (int n = 0; n < 2; ++n) { b1[n] = *(const f32x4*)(bias + col0 + 4 * n); b2[n] = *(const f32x4*)(bias + 1024 + col0 + 4 * n); }
#pragma unroll
        for (int ai = 0; ai < 2; ++ai)
#pragma unroll
            for (int m = 0; m < 4; ++m) { bf16_t* rowp = U + (size_t)(row0 + ai * HALF + m * 16) * 1024 + col0;
                f32x4 o[2];
#pragma unroll
                for (int n = 0; n < 2; ++n) { const f32x4 a = acc[ai][0][m][n] + b1[n], g = acc[ai][1][m][n] + b2[n];
#pragma unroll
                    for (int j = 0; j < 4; ++j) o[n][j] = a[j] * __builtin_amdgcn_rcpf(1.f + __expf(-g[j])); }
                u32x4 w; w.x = cvt_pk_bf16(o[0][0], o[0][1]); w.y = cvt_pk_bf16(o[0][2], o[0][3]); w.z = cvt_pk_bf16(o[1][0], o[1][1]); w.w = cvt_pk_bf16(o[1][2], o[1][3]);
                *(u32x4*)rowp = w; }
    }
};
}
namespace pg8 {
template <class Epi, class Sched, bool ALIGN_EPI = false, bool SP2 = false>
__device__ __forceinline__ void gemm_phase(PG8_LAS unsigned char* lds, const Gemm g, const Sched& S, const Epi& E) {
    int tid = threadIdx.x; asm volatile("" : "+v"(tid)); const int wid = __builtin_amdgcn_readfirstlane(tid >> 6), lane = tid & 63, wr = wid >> 2, wc = wid & 3, fr = lane & 15, fq = lane >> 4;
    const int K = g.K, nt = K / BK;
    unsigned voffA[2], voffB[2];
#pragma unroll
    for (int i = 0; i < 2; ++i) { int R, C; stage_rc(tid * 16 + i * 8192, R, C); const int Rb = Epi::PERM ? ((R & ~31) + perm32(R & 31)) : R;
        voffA[i] = (unsigned)(R * K + C) * 2u; voffB[i] = (unsigned)(Rb * K + C) * 2u; }
    const size_t kstep = (size_t)(BK * 2);
    const size_t hstep = (size_t)HALF * K * 2;
    const size_t tstep = 2 * hstep;
    const unsigned ldsw = (unsigned)wid * 1024u;
    const int aoff = lds_byte(wr * 64 + fr, fq * 8), boff = lds_byte(wc * 32 + fr, fq * 8);
#define PG8_SA(b, h) (((b) * 2 + (h)) * HTB)
#define PG8_SB(b, h) ((4 + (b) * 2 + (h)) * HTB)
#define PG8_STAGE(bufoff, gbase, voff) do { _Pragma("unroll") for (int _i = 0; _i < 2; ++_i) \
        __builtin_amdgcn_global_load_lds((const unsigned*)((const char*)(gbase) + (voff)[_i]), (PG8_LAS unsigned*)(lds + (bufoff) + ldsw + _i * 8192), 16, 0, 0); } while (0)
#define PG8_LDA(dst, b, h) do { _Pragma("unroll") for (int m = 0; m < 4; ++m) _Pragma("unroll") for (int k = 0; k < 2; ++k) dst[m][k] = *(const PG8_LAS bf16x8*)(lds + PG8_SA(b, h) + aoff + m * 2048 + k * 1024); } while (0)
#define PG8_LDB(dst, b, h) do { _Pragma("unroll") for (int n = 0; n < 2; ++n) _Pragma("unroll") for (int k = 0; k < 2; ++k) dst[n][k] = *(const PG8_LAS bf16x8*)(lds + PG8_SB(b, h) + boff + n * 2048 + k * 1024); } while (0)
#define PG8_MMA(ai, bj, At, Bt) do { __builtin_amdgcn_s_setprio(1); _Pragma("unroll") for (int m = 0; m < 4; ++m) _Pragma("unroll") for (int n = 0; n < 2; ++n) _Pragma("unroll") for (int k = 0; k < 2; ++k) \
        acc[ai][bj][m][n] = __builtin_amdgcn_mfma_f32_16x16x32_bf16(Bt[n][k], At[m][k], acc[ai][bj][m][n], 0, 0, 0); __builtin_amdgcn_s_setprio(0); } while (0)
#define PG8_WAIT_V(n) asm volatile("s_waitcnt vmcnt(" #n ")" ::: "memory")
#define PG8_WAIT_L(n) asm volatile("s_waitcnt lgkmcnt(" #n ")" ::: "memory")
#define PG8_BAR __builtin_amdgcn_s_barrier()
#define PG8_SCHED __builtin_amdgcn_sched_barrier(0)
    Unit cur, nxt; int ui = 0;
    if (!S.next(0, cur)) return;
    f32x4 acc[2][2][4][2];
#pragma unroll
    for (int a = 0; a < 2; ++a)
#pragma unroll
        for (int b = 0; b < 2; ++b)
#pragma unroll
            for (int m = 0; m < 4; ++m)
#pragma unroll
                for (int n = 0; n < 2; ++n) acc[a][b][m][n] = (f32x4){0.f, 0.f, 0.f, 0.f};
    bf16x8 At[4][2], B0[2][2], B1[2][2];
    const char* cA = (const char*)g.A + (size_t)cur.pm * tstep; const char* cB = (const char*)g.Bt + (size_t)cur.pn * tstep;
    S.a_ready(cur);
    if constexpr (SP2) {
        PG8_STAGE(PG8_SB(0, 0), cB, voffB); PG8_STAGE(PG8_SB(0, 1), cB + hstep, voffB); PG8_STAGE(PG8_SA(0, 0), cA, voffA); PG8_STAGE(PG8_SA(0, 1), cA + hstep, voffA);
        if (wr == 1) PG8_BAR;
        PG8_WAIT_V(2); PG8_BAR;
        PG8_STAGE(PG8_SB(1, 0), cB + kstep, voffB); PG8_STAGE(PG8_SA(1, 0), cA + kstep, voffA); PG8_STAGE(PG8_SB(1, 1), cB + hstep + kstep, voffB);
        PG8_WAIT_V(6); PG8_BAR;
    } else {
        PG8_STAGE(PG8_SB(0, 0), cB, voffB); PG8_STAGE(PG8_SA(0, 0), cA, voffA); PG8_STAGE(PG8_SB(0, 1), cB + hstep, voffB); PG8_STAGE(PG8_SA(0, 1), cA + hstep, voffA);
        if (wr == 1) PG8_BAR;
        PG8_WAIT_V(4); PG8_BAR;
        PG8_STAGE(PG8_SB(1, 0), cB + kstep, voffB); PG8_STAGE(PG8_SA(1, 0), cA + kstep, voffA); PG8_STAGE(PG8_SB(1, 1), cB + hstep + kstep, voffB);
        PG8_WAIT_V(6); PG8_BAR;
    }
    for (;;) {
        const bool has_next = S.next(ui + 1, nxt);
        const char* nA = has_next ? (const char*)g.A + (size_t)nxt.pm * tstep : cA; const char* nB = has_next ? (const char*)g.Bt + (size_t)nxt.pn * tstep : cB;
        for (int t = 0; t < nt; t += 2) {
            const bool last = (t == nt - 2);
            const char* a1 = cA + (size_t)(t + 1) * kstep;
            const char* a2 = last ? nA : cA + (size_t)(t + 2) * kstep; const char* b2 = last ? nB : cB + (size_t)(t + 2) * kstep;
            const char* a3 = a2 + kstep; const char* b3 = b2 + kstep;
            if (last && has_next) S.a_ready(nxt);
            if constexpr (SP2) {
            PG8_LDB(B0, 0, 0); PG8_LDB(B1, 0, 1); PG8_SCHED; PG8_LDA(At, 0, 0); PG8_STAGE(PG8_SA(1, 1), a1 + hstep, voffA);
            PG8_WAIT_V(8); PG8_WAIT_L(0); PG8_BAR; PG8_MMA(0, 0, At, B0); PG8_MMA(0, 1, At, B1); PG8_BAR; PG8_SCHED;
            PG8_LDA(At, 0, 1); PG8_STAGE(PG8_SB(0, 0), b2, voffB); PG8_STAGE(PG8_SB(0, 1), b2 + hstep, voffB); PG8_STAGE(PG8_SA(0, 0), a2, voffA);
            PG8_WAIT_V(8); PG8_WAIT_L(0); PG8_BAR; PG8_MMA(1, 0, At, B0); PG8_MMA(1, 1, At, B1); PG8_BAR; PG8_SCHED;
            PG8_LDB(B0, 1, 0); PG8_LDB(B1, 1, 1); PG8_SCHED; PG8_LDA(At, 1, 0); PG8_STAGE(PG8_SA(0, 1), a2 + hstep, voffA);
            PG8_WAIT_V(8); PG8_WAIT_L(0); PG8_BAR; PG8_MMA(0, 0, At, B0); PG8_MMA(0, 1, At, B1); PG8_BAR; PG8_SCHED;
            PG8_LDA(At, 1, 1); PG8_STAGE(PG8_SB(1, 0), b3, voffB); PG8_STAGE(PG8_SB(1, 1), b3 + hstep, voffB); PG8_STAGE(PG8_SA(1, 0), a3, voffA);
            PG8_WAIT_V(8); PG8_WAIT_L(0); PG8_BAR; PG8_MMA(1, 0, At, B0); PG8_MMA(1, 1, At, B1); PG8_BAR; PG8_SCHED;
            } else {
            PG8_LDB(B0, 0, 0); PG8_SCHED; PG8_LDA(At, 0, 0); PG8_STAGE(PG8_SA(1, 1), a1 + hstep, voffA);
            PG8_WAIT_L(8); PG8_BAR; PG8_WAIT_L(0); PG8_MMA(0, 0, At, B0); PG8_BAR; PG8_SCHED;
            PG8_LDB(B1, 0, 1); PG8_STAGE(PG8_SB(0, 0), b2, voffB);
            PG8_BAR; PG8_WAIT_L(0); PG8_MMA(0, 1, At, B1); PG8_BAR;
            PG8_LDA(At, 0, 1); PG8_STAGE(PG8_SA(0, 0), a2, voffA);
            PG8_BAR; PG8_WAIT_L(0); PG8_MMA(1, 0, At, B0); PG8_BAR; PG8_SCHED;
            PG8_STAGE(PG8_SB(0, 1), b2 + hstep, voffB);
            PG8_WAIT_V(6); PG8_BAR; PG8_MMA(1, 1, At, B1); PG8_BAR;
            PG8_LDB(B0, 1, 0); PG8_SCHED; PG8_LDA(At, 1, 0); PG8_STAGE(PG8_SA(0, 1), a2 + hstep, voffA);
            PG8_WAIT_L(8); PG8_BAR; PG8_WAIT_L(0); PG8_MMA(0, 0, At, B0); PG8_BAR; PG8_SCHED;
            PG8_LDB(B1, 1, 1); PG8_STAGE(PG8_SB(1, 0), b3, voffB);
            PG8_BAR; PG8_WAIT_L(0); PG8_MMA(0, 1, At, B1); PG8_BAR;
            PG8_LDA(At, 1, 1); PG8_STAGE(PG8_SA(1, 0), a3, voffA);
            PG8_BAR; PG8_WAIT_L(0); PG8_MMA(1, 0, At, B0); PG8_BAR; PG8_SCHED;
            PG8_STAGE(PG8_SB(1, 1), b3 + hstep, voffB);
            PG8_WAIT_V(6); PG8_BAR; PG8_MMA(1, 1, At, B1); PG8_BAR;
            }
        }
        if constexpr (ALIGN_EPI) { if (wr == 0) PG8_BAR; }
        if constexpr (!Epi::AFTER_DRAIN) { E(acc, cur, wr, wc, fr, fq); S.done(cur); }
        if (!has_next) break;
#pragma unroll
        for (int a = 0; a < 2; ++a)
#pragma unroll
            for (int b = 0; b < 2; ++b)
#pragma unroll
                for (int m = 0; m < 4; ++m)
#pragma unroll
                    for (int n = 0; n < 2; ++n) acc[a][b][m][n] = (f32x4){0.f, 0.f, 0.f, 0.f};
        cur = nxt; cA = nA; cB = nB; ++ui;
        if constexpr (ALIGN_EPI) { if (wr == 1) PG8_BAR; }
    }
    PG8_WAIT_V(0);
    if constexpr (!ALIGN_EPI) { if (wr == 0) PG8_BAR; }
    PG8_BAR;
    if constexpr (Epi::AFTER_DRAIN) { E.fused(acc, cur, wr, wc, fr, fq, lds, wid, lane); S.done(cur); }
#undef PG8_SA
#undef PG8_SB
#undef PG8_STAGE
#undef PG8_LDA
#undef PG8_LDB
#undef PG8_MMA
#undef PG8_WAIT_V
#undef PG8_WAIT_L
#undef PG8_BAR
#undef PG8_SCHED
}
}
#include <hip/hip_cooperative_groups.h>
namespace cg = cooperative_groups;
#define LAS __attribute__((address_space(3)))
typedef unsigned short bf16;
typedef float f32x4 __attribute__((ext_vector_type(4)));
typedef float f32x2 __attribute__((ext_vector_type(2)));
typedef short bf16x8 __attribute__((ext_vector_type(8)));
typedef unsigned u32x4 __attribute__((ext_vector_type(4)));
typedef unsigned u32x2 __attribute__((ext_vector_type(2)));

constexpr int T = 16384, D = 1024, DEPTH = 4, FF = 4096;
constexpr int ZLD = 4608, ZN = 4864, ABIN = 4624, MIXLD = 1536;
constexpr int ZSX = 0, ZSB = 512, ZSC = 1024, ZQ = 1536, ZK = 2048, ZV = 2560, ZG = 3584;
constexpr float EPS = 1e-6f;
constexpr int NWAVES = 8, NTHR = 512;
constexpr int LDS_BYTES = 147456;
constexpr size_t MiB = 1u << 20;
constexpr size_t WS_DEC = 0;
constexpr size_t WS_BAR = 512 * 1024;
constexpr size_t WS_W = 1 * MiB;
constexpr size_t WS_H = 30 * MiB;
constexpr size_t WS_BIG = 62 * MiB;
constexpr size_t WS_GK = 254 * MiB;
constexpr size_t WS_END = 255 * MiB;
constexpr size_t WO_MIX1 = 0;
constexpr size_t WO_MIX2_E = (size_t)ZN * D;
constexpr size_t WO_MIX2_O = (size_t)2048 * D;
constexpr size_t WO_W1 = (size_t)ZN * D + (size_t)D * MIXLD;
constexpr size_t WO_W2 = WO_W1 + (size_t)FF * D;
static_assert(WS_W + (WO_W2 + (size_t)FF * D) * 2 <= WS_H, "weights fit");

__device__ __forceinline__ int tid_l() { int t = threadIdx.x; asm volatile("" : "+v"(t)); return t; }
__device__ __forceinline__ float bf2f(unsigned b) { return __uint_as_float(b << 16); }
__device__ __forceinline__ unsigned pkbf(float lo, float hi) { return pg8::cvt_pk_bf16(lo, hi); }
__device__ __forceinline__ float wave_sum(float v) {
#pragma unroll
    for (int o = 1; o < 64; o <<= 1) v += __shfl_xor(v, o);
    return v;
}

template <int MODE>
__device__ __forceinline__ void transpose_item(const float* W, int K, int N, bf16* WT, LAS float* scr, int item, int lane) {
    const int nblk = (N + 31) / 32, kb = item / nblk, nb = item % nblk, k0 = 64 * kb, n0 = 32 * nb;
    const bool ok = (n0 + (lane & 31)) < N;
#pragma unroll 8
    for (int i = 0; i < 32; ++i) { const int kk = 2 * i + (lane >> 5); scr[kk * 33 + (lane & 31)] = ok ? W[(size_t)(k0 + kk) * N + n0 + (lane & 31)] : 0.f; }
    asm volatile("s_waitcnt lgkmcnt(0)" ::: "memory");
    int d0 = n0;
    if (MODE == 1) { const int half = n0 >> 10, c0 = n0 & 1023; d0 = ((c0 >> 7) << 8) + (half << 7) + (c0 & 127); }
    const int c = lane & 7;
#pragma unroll
    for (int j = 0; j < 4; ++j) { const int n = (lane >> 3) + 8 * j; const LAS float* s = scr + (8 * c) * 33 + n;
        u32x4 o; o.x = pkbf(s[0 * 33], s[1 * 33]); o.y = pkbf(s[2 * 33], s[3 * 33]); o.z = pkbf(s[4 * 33], s[5 * 33]); o.w = pkbf(s[6 * 33], s[7 * 33]);
        *(u32x4*)(WT + (size_t)(d0 + n) * K + k0 + 8 * c) = o; }
    asm volatile("s_waitcnt lgkmcnt(0)" ::: "memory");
}

struct Args { const float* in[21]; float* out; unsigned char* ws; int ph_lo, ph_hi; };
__device__ __forceinline__ const float* inp(int i) { const __attribute__((address_space(4))) char* kp = (const __attribute__((address_space(4))) char*)__builtin_amdgcn_kernarg_segment_ptr(); asm volatile("" : "+s"(kp)); return *(const float* const __attribute__((address_space(4)))*)(kp + 8 * i); }

__device__ __forceinline__ void convert_layer(unsigned char* wsp, int l, LAS unsigned char* lds, int gw, int NGW, int wave, int lane) {
    LAS float* scr = (LAS float*)(lds + wave * 8704);
    bf16* Wb = (bf16*)(wsp + WS_W);
    const int i2 = l >> 1;
    const float* w1 = inp(19) + (size_t)l * D * FF; const float* w2 = inp(20) + (size_t)l * FF * D;
    constexpr int I_W1 = (D / 64) * (FF / 32), I_W2 = (FF / 64) * (D / 32);
    if ((l & 1) == 0) {
        const float* win = inp(5) + (size_t)i2 * D * ABIN; const float* wout = inp(10) + (size_t)i2 * MIXLD * D;
        constexpr int I_IN = (D / 64) * ((ABIN + 31) / 32), I_OUT = (MIXLD / 64) * (D / 32);
        constexpr int NIT = I_IN + I_OUT + I_W1 + I_W2;
        for (int it = gw; it < NIT; it += NGW) { int r = it;
            if (r < I_IN) { transpose_item<0>(win, D, ABIN, Wb + WO_MIX1, scr, r, lane); continue; } r -= I_IN;
            if (r < I_OUT) { transpose_item<0>(wout, MIXLD, D, Wb + WO_MIX2_E, scr, r, lane); continue; } r -= I_OUT;
            if (r < I_W1) { transpose_item<0>(w1, D, FF, Wb + WO_W1, scr, r, lane); continue; } r -= I_W1;
            transpose_item<0>(w2, FF, D, Wb + WO_W2, scr, r, lane); }
        u32x4* pz = (u32x4*)(Wb + WO_MIX1 + (size_t)4640 * D); const int nz = (ZN - 4640) * D / 8;
        for (int i = gw * 64 + lane; i < nz; i += NGW * 64) pz[i] = (u32x4){0u, 0u, 0u, 0u};
    } else {
        const float* pw1 = inp(11) + (size_t)i2 * D * 2048; const float* pw2 = inp(17) + (size_t)i2 * D * D;
        constexpr int I_P1 = (D / 64) * (2048 / 32), I_P2 = (D / 64) * (D / 32);
        constexpr int NIT = I_P1 + I_P2 + I_W1 + I_W2;
        for (int it = gw; it < NIT; it += NGW) { int r = it;
            if (r < I_P1) { transpose_item<1>(pw1, D, 2048, Wb + WO_MIX1, scr, r, lane); continue; } r -= I_P1;
            if (r < I_P2) { transpose_item<0>(pw2, D, D, Wb + WO_MIX2_O, scr, r, lane); continue; } r -= I_P2;
            if (r < I_W1) { transpose_item<0>(w1, D, FF, Wb + WO_W1, scr, r, lane); continue; } r -= I_W1;
            transpose_item<0>(w2, FF, D, Wb + WO_W2, scr, r, lane); }
    }
}

template <bool HAS_Y, bool HAS_XD, bool HAS_PRE>
__device__ __forceinline__ void norm_rows(const float* y, const float* xs, float* xd, const float* gpost, const float* gpre, bf16* h, int gw, int NGW, int lane) {
    for (int row = gw; row < T; row += NGW) {
        const f32x4* xr = (const f32x4*)(xs + (size_t)row * D) + lane;
        f32x4 xv[4];
#pragma unroll
        for (int j = 0; j < 4; ++j) xv[j] = xr[64 * j];
        if (HAS_Y) {
            const f32x4* yr = (const f32x4*)(y + (size_t)row * D) + lane; f32x4 yv[4]; float s = 0.f;
#pragma unroll
            for (int j = 0; j < 4; ++j) { yv[j] = yr[64 * j]; s += (yv[j].x * yv[j].x + yv[j].y * yv[j].y) + (yv[j].z * yv[j].z + yv[j].w * yv[j].w); }
            const float r = 1.f / sqrtf(wave_sum(s) * (1.f / D) + EPS);
#pragma unroll
            for (int j = 0; j < 4; ++j) { const f32x4 g = ((const f32x4*)gpost)[64 * j + lane]; xv[j] = xv[j] + yv[j] * r * g; }
        }
        if (HAS_XD) { f32x4* xo = (f32x4*)(xd + (size_t)row * D) + lane;
#pragma unroll
            for (int j = 0; j < 4; ++j) xo[64 * j] = xv[j]; }
        if (HAS_PRE) {
            float s = 0.f;
#pragma unroll
            for (int j = 0; j < 4; ++j) s += (xv[j].x * xv[j].x + xv[j].y * xv[j].y) + (xv[j].z * xv[j].z + xv[j].w * xv[j].w);
            const float r = 1.f / sqrtf(wave_sum(s) * (1.f / D) + EPS);
            u32x2* ho = (u32x2*)(h + (size_t)row * D) + lane;
#pragma unroll
            for (int j = 0; j < 4; ++j) { const f32x4 g = ((const f32x4*)gpre)[64 * j + lane]; const f32x4 v = xv[j] * r * g; u32x2 w; w.x = pkbf(v.x, v.y); w.y = pkbf(v.z, v.w); ho[64 * j] = w; }
        }
    }
}

constexpr int G_QD = 0, G_KD = 17408, G_KLT = 34816, G_VT = 53248, G_P = 90112, G_SEG = 99328, G_EBL = 101376, G_SS = 101888;
#define MFMA16(a, b, c) __builtin_amdgcn_mfma_f32_16x16x32_bf16(a, b, c, 0, 0, 0)
template <bool OUT>
__device__ __forceinline__ void gla_unit(int unit, const bf16* z, const float* gklr, const float* wgk2, const float* bgk2, const float* normg, float* E, float* DEC, bf16* mix, LAS unsigned char* lds) {
    const int tid = tid_l(), lane = tid & 63, w = __builtin_amdgcn_readfirstlane(tid >> 6), r = lane & 15, q = lane >> 4;
    const int g = unit >> 2, h = unit & 3;
    const int k = tid & 127, seg = tid >> 7, hk = h * 128 + k;
    const int vv = tid & 255, jh = tid >> 8;
    f32x4 S[8][2];
    float* Eu = E + (size_t)unit * 32768 + (size_t)w * 4096 + lane;
    if (OUT) {
#pragma unroll
        for (int mt = 0; mt < 8; ++mt)
#pragma unroll
            for (int nt = 0; nt < 2; ++nt)
#pragma unroll
                for (int i = 0; i < 4; ++i) S[mt][nt][i] = Eu[((mt * 2 + nt) * 4 + i) * 64];
    } else {
#pragma unroll
        for (int mt = 0; mt < 8; ++mt)
#pragma unroll
            for (int nt = 0; nt < 2; ++nt) S[mt][nt] = (f32x4){0.f, 0.f, 0.f, 0.f};
    }
    float bsum = 0.f;
    LAS float* SEG = (LAS float*)(lds + G_SEG); LAS float* EBL = (LAS float*)(lds + G_EBL); LAS float* SSQ = (LAS float*)(lds + G_SS);
    for (int ch = 0; ch < 4; ++ch) {
        const int t0 = g * 256 + ch * 64;
        int zofs = 0; asm volatile("" : "+v"(zofs));
        float w2r[16];
#pragma unroll
        for (int i = 0; i < 16; ++i) w2r[i] = wgk2[i * 512 + hk + zofs];
        const float bias = bgk2[hk + zofs];
        float b[16]; float run = 0.f;
#pragma unroll
        for (int jj = 0; jj < 16; ++jj) {
            const f32x4* gp = (const f32x4*)(gklr + (size_t)(t0 + seg * 16 + jj) * 16);
            const f32x4 g0 = gp[0], g1 = gp[1], g2 = gp[2], g3 = gp[3];
            float gv = bias;
            gv += g0.x * w2r[0] + g0.y * w2r[1] + g0.z * w2r[2] + g0.w * w2r[3];
            gv += g1.x * w2r[4] + g1.y * w2r[5] + g1.z * w2r[6] + g1.w * w2r[7];
            gv += g2.x * w2r[8] + g2.y * w2r[9] + g2.z * w2r[10] + g2.w * w2r[11];
            gv += g3.x * w2r[12] + g3.y * w2r[13] + g3.z * w2r[14] + g3.w * w2r[15];
            const float ls = -(fmaxf(-gv, 0.f) + log1pf(__expf(-fabsf(gv)))) * (1.f / 16.f);
            run += ls; b[jj] = run;
        }
        SEG[seg * 128 + k] = run;
        __syncthreads();
        float pre = 0.f, tot = 0.f;
#pragma unroll
        for (int s = 0; s < 4; ++s) { const float v = SEG[s * 128 + k]; tot += v; pre += (s < seg) ? v : 0.f; }
        if (seg == 0) { EBL[k] = __expf(tot); bsum += tot; }
        {
            unsigned klp[8];
#pragma unroll
            for (int jj = 0; jj < 16; jj += 2) {
                float kl2[2];
#pragma unroll
                for (int e = 0; e < 2; ++e) {
                    const int j = seg * 16 + jj + e; const bf16* zr = z + (size_t)(t0 + j) * ZLD; const float bb = b[jj + e] + pre;
                    const float kv = bf2f(zr[ZK + hk]);
                    kl2[e] = kv * __expf(tot - bb);
                    if (OUT) { const float qv = bf2f(zr[ZQ + hk]);
                        *(LAS bf16*)(lds + G_QD + (j * 136 + k) * 2) = (bf16)(pkbf(qv * 0.08838834764831845f * __expf(bb), 0.f) & 0xffffu);
                        *(LAS bf16*)(lds + G_KD + (j * 136 + k) * 2) = (bf16)(pkbf(kv * __expf(-bb), 0.f) & 0xffffu); }
                }
                klp[jj >> 1] = pkbf(kl2[0], kl2[1]);
            }
            LAS u32x4* kp = (LAS u32x4*)(lds + G_KLT + k * 144 + seg * 32);
            kp[0] = (u32x4){klp[0], klp[1], klp[2], klp[3]}; kp[1] = (u32x4){klp[4], klp[5], klp[6], klp[7]};
        }
        {
            const bf16* zv = z + (size_t)(t0 + jh * 32) * ZLD + ZV + h * 256 + vv;
            unsigned vp[16];
#pragma unroll
            for (int jj = 0; jj < 32; jj += 2) vp[jj >> 1] = (unsigned)zv[(size_t)jj * ZLD] | ((unsigned)zv[(size_t)(jj + 1) * ZLD] << 16);
            LAS u32x4* vpp = (LAS u32x4*)(lds + G_VT + vv * 144 + jh * 64);
#pragma unroll
            for (int i = 0; i < 4; ++i) vpp[i] = (u32x4){vp[4 * i], vp[4 * i + 1], vp[4 * i + 2], vp[4 * i + 3]};
        }
        __syncthreads();
        if (OUT) {
            const int jt = w >> 1;
#pragma unroll
            for (int ii = 0; ii < 2; ++ii) {
                const int it = (w & 1) * 2 + ii;
                f32x4 pa = (f32x4){0.f, 0.f, 0.f, 0.f};
                if (jt <= it) {
#pragma unroll
                    for (int s = 0; s < 4; ++s) {
                        const bf16x8 A = *(const LAS bf16x8*)(lds + G_KD + ((16 * jt + r) * 136 + 32 * s + 8 * q) * 2);
                        const bf16x8 B = *(const LAS bf16x8*)(lds + G_QD + ((16 * it + r) * 136 + 32 * s + 8 * q) * 2);
                        pa = MFMA16(A, B, pa);
                    }
                    const int i_ = 16 * it + r;
#pragma unroll
                    for (int e = 0; e < 4; ++e) { const int j_ = 16 * jt + 4 * q + e; if (j_ > i_) pa[e] = 0.f; }
                }
                u32x2 pw; pw.x = pkbf(pa[0], pa[1]); pw.y = pkbf(pa[2], pa[3]);
                *(LAS u32x2*)(lds + G_P + ((16 * it + r) * 72 + 16 * jt + 4 * q) * 2) = pw;
            }
            __syncthreads();
        }
        bf16x8 Bv[2][2];
#pragma unroll
        for (int s2 = 0; s2 < 2; ++s2)
#pragma unroll
            for (int nt = 0; nt < 2; ++nt) Bv[s2][nt] = *(const LAS bf16x8*)(lds + G_VT + ((32 * w + 16 * nt + r) * 72 + 32 * s2 + 8 * q) * 2);
        f32x4 o[4][2];
        if (OUT) {
#pragma unroll
            for (int mt = 0; mt < 4; ++mt)
#pragma unroll
                for (int nt = 0; nt < 2; ++nt) o[mt][nt] = (f32x4){0.f, 0.f, 0.f, 0.f};
#pragma unroll
            for (int s = 0; s < 4; ++s) {
                bf16x8 Sb[2];
#pragma unroll
                for (int nt = 0; nt < 2; ++nt) {
                    u32x4 t; t.x = pkbf(S[2 * s][nt][0], S[2 * s][nt][1]); t.y = pkbf(S[2 * s][nt][2], S[2 * s][nt][3]);
                    t.z = pkbf(S[2 * s + 1][nt][0], S[2 * s + 1][nt][1]); t.w = pkbf(S[2 * s + 1][nt][2], S[2 * s + 1][nt][3]);
                    Sb[nt] = __builtin_bit_cast(bf16x8, t);
                }
#pragma unroll
                for (int mt = 0; mt < 4; ++mt) {
                    const u32x2 lo = *(const LAS u32x2*)(lds + G_QD + ((16 * mt + r) * 136 + 32 * s + 4 * q) * 2);
                    const u32x2 hi = *(const LAS u32x2*)(lds + G_QD + ((16 * mt + r) * 136 + 32 * s + 16 + 4 * q) * 2);
                    const bf16x8 A = __builtin_bit_cast(bf16x8, (u32x4){lo.x, lo.y, hi.x, hi.y});
#pragma unroll
                    for (int nt = 0; nt < 2; ++nt) o[mt][nt] = MFMA16(A, Sb[nt], o[mt][nt]);
                }
            }
#pragma unroll
            for (int s2 = 0; s2 < 2; ++s2)
#pragma unroll
                for (int mt = 0; mt < 4; ++mt) {
                    const bf16x8 A = *(const LAS bf16x8*)(lds + G_P + ((16 * mt + r) * 72 + 32 * s2 + 8 * q) * 2);
#pragma unroll
                    for (int nt = 0; nt < 2; ++nt) o[mt][nt] = MFMA16(A, Bv[s2][nt], o[mt][nt]);
                }
        }
#pragma unroll
        for (int mt = 0; mt < 8; ++mt) {
            const f32x4 eb = *(const LAS f32x4*)(lds + G_EBL + (16 * mt + 4 * q) * 4);
#pragma unroll
            for (int nt = 0; nt < 2; ++nt) S[mt][nt] = S[mt][nt] * eb;
#pragma unroll
            for (int s2 = 0; s2 < 2; ++s2) {
                const bf16x8 A = *(const LAS bf16x8*)(lds + G_KLT + ((16 * mt + r) * 72 + 32 * s2 + 8 * q) * 2);
#pragma unroll
                for (int nt = 0; nt < 2; ++nt) S[mt][nt] = MFMA16(A, Bv[s2][nt], S[mt][nt]);
            }
        }
        if (OUT) {
#pragma unroll
            for (int mt = 0; mt < 4; ++mt)
#pragma unroll
                for (int e = 0; e < 4; ++e) {
                    float s = o[mt][0][e] * o[mt][0][e] + o[mt][1][e] * o[mt][1][e];
                    s += __shfl_xor(s, 1); s += __shfl_xor(s, 2); s += __shfl_xor(s, 4); s += __shfl_xor(s, 8);
                    if (r == 0) SSQ[(16 * mt + 4 * q + e) * 8 + w] = s;
                }
            __syncthreads();
            const float ng0 = normg[32 * w + r], ng1 = normg[32 * w + 16 + r];
#pragma unroll
            for (int mt = 0; mt < 4; ++mt)
#pragma unroll
                for (int e = 0; e < 4; ++e) {
                    const int i_ = 16 * mt + 4 * q + e;
                    const f32x4 sa = *(const LAS f32x4*)(lds + G_SS + i_ * 32), sb = *(const LAS f32x4*)(lds + G_SS + i_ * 32 + 16);
                    const float tot2 = ((sa.x + sa.y) + (sa.z + sa.w)) + ((sb.x + sb.y) + (sb.z + sb.w));
                    const float rs = 1.f / sqrtf(tot2 * (1.f / 256.f) + EPS);
                    const bf16* zg = z + (size_t)(t0 + i_) * ZLD + ZG + h * 256 + 32 * w + r;
                    bf16* mo = mix + (size_t)(t0 + i_) * MIXLD + 512 + h * 256 + 32 * w + r;
                    const float ga = bf2f(zg[0]), gb = bf2f(zg[16]);
                    const float va = o[mt][0][e] * rs * ng0 * ga * __builtin_amdgcn_rcpf(1.f + __expf(-ga));
                    const float vb = o[mt][1][e] * rs * ng1 * gb * __builtin_amdgcn_rcpf(1.f + __expf(-gb));
                    const unsigned pv = pkbf(va, vb);
                    mo[0] = (bf16)(pv & 0xffffu); mo[16] = (bf16)(pv >> 16);
                }
        }
        __syncthreads();
    }
    if (!OUT) {
#pragma unroll
        for (int mt = 0; mt < 8; ++mt)
#pragma unroll
            for (int nt = 0; nt < 2; ++nt)
#pragma unroll
                for (int i = 0; i < 4; ++i) Eu[((mt * 2 + nt) * 4 + i) * 64] = S[mt][nt][i];
        if (seg == 0) DEC[unit * 128 + k] = __expf(bsum);
    }
}

__device__ __forceinline__ void shortconv(const bf16* z, const float* wsc, bf16* mix, int gtid, int gthreads) {
    for (int idx = gtid; idx < T * 256; idx += gthreads) {
        const int t = idx >> 8, c = (idx & 255) * 2;
        float a0 = 0.f, a1 = 0.f;
#pragma unroll
        for (int j = 0; j < 3; ++j) { const int tt = t - 2 + j;
            if (tt >= 0) { const bf16* zr = z + (size_t)tt * ZLD; const unsigned x2 = *(const unsigned*)(zr + ZSX + c), c2 = *(const unsigned*)(zr + ZSC + c);
                const f32x2 wj = *(const f32x2*)(wsc + j * 512 + c);
                a0 += wj.x * (bf2f(x2 & 0xffffu) * bf2f(c2 & 0xffffu)); a1 += wj.y * (bf2f(x2 >> 16) * bf2f(c2 >> 16)); } }
        const unsigned b2 = *(const unsigned*)(z + (size_t)t * ZLD + ZSB + c);
        *(unsigned*)(mix + (size_t)t * MIXLD + c) = pkbf(bf2f(b2 & 0xffffu) * a0, bf2f(b2 >> 16) * a1);
    }
}

__device__ __forceinline__ void gla_scan(float* E, const float* DEC, int gtid, int gthreads) {
    for (int e = gtid; e < 4 * 32768; e += gthreads) {
        const int h = e >> 15, rem = e & 32767, rr = (rem >> 6) & 63, ln = rem & 63;
        const int k = 16 * (rr >> 3) + 4 * (ln >> 4) + (rr & 3);
        float s = 0.f;
#pragma unroll 8
        for (int g = 0; g < 64; ++g) { float* p = E + (size_t)(g * 4 + h) * 32768 + rem; const float tmp = *p; *p = s; s = DEC[(g * 4 + h) * 128 + k] * s + tmp; }
    }
}

__device__ __forceinline__ void conv_phase(const bf16* u, const float* wdw, const float* bdw, const float* lng, const float* lnb, bf16* dout, LAS unsigned char* lds, int G, int bid) {
    const int tid = tid_l(), lane = tid & 63, w = tid >> 6;
    LAS unsigned* UL = (LAS unsigned*)lds;
    LAS f32x2* RED = (LAS f32x2*)(lds + 126976);
    LAS f32x2* STAT = (LAS f32x2*)(lds + 126976 + 2048);
    float w0[31], w1[31];
#pragma unroll
    for (int j = 0; j < 31; ++j) { const f32x2 t = *(const f32x2*)(wdw + j * 1024 + 2 * tid); w0[j] = t.x; w1[j] = t.y; }
    const f32x2 bd = *(const f32x2*)(bdw + 2 * tid), lg = *(const f32x2*)(lng + 2 * tid), lb = *(const f32x2*)(lnb + 2 * tid);
    for (int tile = bid; tile < T / 32; tile += G) {
        const int t0 = tile * 32;
        for (int i = tid; i < 62 * 128; i += NTHR) { const int rr = i >> 7, cc = i & 127, t = t0 - 30 + rr;
            u32x4 v = (u32x4){0u, 0u, 0u, 0u}; if (t >= 0) v = *(const u32x4*)(u + (size_t)t * D + cc * 8);
            *(LAS u32x4*)(lds + rr * 2048 + cc * 16) = v; }
        __syncthreads();
#pragma unroll 1
        for (int sub = 0; sub < 2; ++sub) {
            float d0[16], d1[16];
#pragma unroll
            for (int tt = 0; tt < 16; ++tt) { d0[tt] = bd.x; d1[tt] = bd.y; }
            const LAS unsigned* ULs = UL + sub * 16 * 512 + tid;
#pragma unroll
            for (int rr = 0; rr < 46; ++rr) {
                const unsigned uu = ULs[rr * 512]; const float ua = bf2f(uu & 0xffffu), ub = bf2f(uu >> 16);
#pragma unroll
                for (int tt = 0; tt < 16; ++tt) { if (rr - tt >= 0 && rr - tt <= 30) { d0[tt] += w0[rr - tt] * ua; d1[tt] += w1[rr - tt] * ub; } }
                if ((rr & 7) == 7) __builtin_amdgcn_sched_barrier(0);
            }
#pragma unroll
            for (int tt = 0; tt < 16; ++tt) {
                float s1 = d0[tt] + d1[tt], s2 = d0[tt] * d0[tt] + d1[tt] * d1[tt];
                s1 = wave_sum(s1); s2 = wave_sum(s2);
                if (lane == 0) RED[tt * 8 + w] = (f32x2){s1, s2};
            }
            __syncthreads();
            if (tid < 16) { float s1 = 0.f, s2 = 0.f;
#pragma unroll
                for (int i = 0; i < 8; ++i) { const f32x2 t = RED[tid * 8 + i]; s1 += t.x; s2 += t.y; }
                const float mean = s1 * (1.f / D); const float var = fmaxf(s2 * (1.f / D) - mean * mean, 0.f);
                STAT[tid] = (f32x2){mean, 1.f / sqrtf(var + EPS)}; }
            __syncthreads();
#pragma unroll
            for (int tt = 0; tt < 16; ++tt) {
                const f32x2 st = STAT[tt];
                const float a = (d0[tt] - st.x) * st.y * lg.x + lb.x, b = (d1[tt] - st.x) * st.y * lg.y + lb.y;
                const float sa = a * __builtin_amdgcn_rcpf(1.f + __expf(-a)), sb = b * __builtin_amdgcn_rcpf(1.f + __expf(-b));
                *(unsigned*)(dout + (size_t)(t0 + sub * 16 + tt) * D + 2 * tid) = pkbf(sa, sb);
            }
        }
        __syncthreads();
    }
}

#define XB_TMO      128
#define XB_XCNT(j)  (256  + 64 * (j))
#define XB_XSUB(j)  (1280 + 64 * (j))
#define XB_XGEN(j)  (2304 + 64 * (j))
#define XB_TOP      3328
#define XB_TOPGEN   3392
#define XCD_BAR_WORDS 3456
#define XB_SPIN_CAP (1u << 18)

__device__ __forceinline__ unsigned xb_ld(unsigned* p)              { return __hip_atomic_load(p, __ATOMIC_RELAXED, __HIP_MEMORY_SCOPE_AGENT); }
__device__ __forceinline__ unsigned xb_add(unsigned* p, unsigned v) { return __hip_atomic_fetch_add(p, v, __ATOMIC_RELAXED, __HIP_MEMORY_SCOPE_AGENT); }
__device__ __forceinline__ unsigned xb_xcc_id() { return (unsigned)__builtin_amdgcn_s_getreg((3 << 11) | 20) & 0xFu; }
#define XB_SPIN(cond, bar) do { unsigned _sp = 0; while (cond) { __builtin_amdgcn_s_sleep(1); \
    if ((++_sp & 255u) == 0u) { if (xb_ld(&(bar)[XB_TMO])) break; if (_sp > XB_SPIN_CAP) { atomicAdd(&(bar)[XB_TMO], 1u); break; } } } } while (0)

struct XcdBarrier {
    unsigned* bar; unsigned x;
    volatile LAS unsigned* st;
};

__device__ __forceinline__ XcdBarrier xcd_barrier_post(unsigned* bar, volatile LAS unsigned* st) {
    XcdBarrier b; b.bar = bar; b.x = xb_xcc_id(); b.st = st;
    if (threadIdx.x == 0) (void)xb_add(&bar[XB_XCNT(b.x)], 1u);
    return b;
}
__device__ __forceinline__ void xcd_barrier_complete(unsigned* bar, unsigned x, unsigned& nloc, unsigned& nx) {
    const unsigned G = gridDim.x * gridDim.y * gridDim.z;
    unsigned sum, cnt, mine, sp = 0u;
    for (;;) {
        sum = 0u; cnt = 0u; mine = 0u;
#pragma unroll
        for (unsigned j = 0; j < 16; ++j) { const unsigned c = xb_ld(&bar[XB_XCNT(j)]); sum += c; cnt += (c > 0u) ? 1u : 0u; mine = (j == x) ? c : mine; }
        if (sum == G) break;
        __builtin_amdgcn_s_sleep(1);
        if ((++sp & 255u) == 0u) { if (xb_ld(&bar[XB_TMO])) break; if (sp > XB_SPIN_CAP) { atomicAdd(&bar[XB_TMO], 1u); break; } }
    }
    nloc = mine > 0u ? mine : 1u; nx = cnt > 0u ? cnt : 1u;
}

__device__ __forceinline__ void xcd_barrier(const XcdBarrier& b) {
    asm volatile("s_waitcnt vmcnt(0)" ::: "memory");
    __syncthreads();
    if (threadIdx.x == 0) {
        unsigned* bar = b.bar;
        __builtin_amdgcn_s_waitcnt(0);
        unsigned nloc = b.st[0], nx = b.st[1];
        if (nloc == 0u) { xcd_barrier_complete(bar, b.x, nloc, nx); b.st[0] = nloc; b.st[1] = nx; }
        const unsigned old = xb_add(&bar[XB_XSUB(b.x)], 1u);
        const unsigned gen = old / nloc;
        if (old + 1u == (gen + 1u) * nloc) {
            __builtin_amdgcn_fence(__ATOMIC_RELEASE, "agent");
            asm volatile("s_waitcnt vmcnt(0)" ::: "memory");
            const unsigned og = xb_add(&bar[XB_TOP], 1u);
            const unsigned tg = og / nx;
            if (og + 1u == (tg + 1u) * nx) xb_add(&bar[XB_TOPGEN], 1u);
            else XB_SPIN(xb_ld(&bar[XB_TOPGEN]) == tg, bar);
            __builtin_amdgcn_fence(__ATOMIC_ACQUIRE, "agent");
            xb_add(&bar[XB_XGEN(b.x)], 1u);
            asm volatile("s_waitcnt vmcnt(0)" ::: "memory");
        } else {
            XB_SPIN(xb_ld(&bar[XB_XGEN(b.x)]) == gen, bar);
            __builtin_amdgcn_fence(__ATOMIC_ACQUIRE, "agent");
            asm volatile("s_waitcnt vmcnt(0)" ::: "memory");
        }
    }
    __syncthreads();
}

__global__ void __launch_bounds__(NTHR, 2) trunk_fwd(Args a) {
    extern __shared__ __attribute__((aligned(16))) unsigned char lds_raw[];
    LAS unsigned char* lds = (LAS unsigned char*)lds_raw;
    cg::grid_group grid = cg::this_grid();
    { volatile LAS unsigned* st0 = (volatile LAS unsigned*)(lds + LDS_BYTES - 16); if (threadIdx.x < 4) st0[threadIdx.x] = 0u; }
    __syncthreads();
    const XcdBarrier xbar = xcd_barrier_post((unsigned*)(a.ws + WS_BAR), (volatile LAS unsigned*)(lds + LDS_BYTES - 16));
    const int G0 = gridDim.x;
#define IDS int bid = blockIdx.x; asm volatile("" : "+s"(bid)); const int tid = tid_l(), lane = tid & 63, wave = __builtin_amdgcn_readfirstlane(tid >> 6), gw = bid * NWAVES + wave, gtid = bid * NTHR + tid; (void)lane; (void)gw; (void)gtid;
    unsigned char* ws = a.ws; float* const xout = a.out;
#define Wb ((bf16*)(wsl + WS_W))
#define Hb ((bf16*)(wsl + WS_H))
#define Eb ((float*)(wsl + WS_H))
#define DEC ((float*)(wsl + WS_DEC))
#define GK ((float*)(wsl + WS_GK))
#define big (wsl + WS_BIG)
#define Z ((bf16*)big)
#define MIX ((bf16*)(big + 144 * MiB))
#define U ((bf16*)big)
#define Dd ((bf16*)(big + 32 * MiB))
#define Ab ((bf16*)big)
#define ymlp ((float*)(big + 128 * MiB))
#define ymix ((float*)(big + ((l & 1) ? 64 * MiB : 0)))
#ifndef PH_LO
#define PH_LO 0
#endif
#ifndef PH_HI
#define PH_HI 33
#endif
    constexpr int lo = PH_LO, hi = PH_HI;
    int ph = 0;
#define PH_BEGIN if (ph >= lo && ph < hi) { IDS unsigned char* wsl = ws; asm volatile("" : "+s"(wsl)); int G = G0; asm volatile("" : "+s"(G)); const int NGW = G * NWAVES, gthreads = G * NTHR; (void)NGW; (void)gthreads;
#define PH_END   if (ph + 1 < hi) { if (ph == lo) grid.sync(); else xcd_barrier(xbar); } } ++ph;

    PH_BEGIN
        convert_layer(wsl, 0, lds, gw, NGW, wave, lane);
        norm_rows<false, false, true>(nullptr, inp(0), nullptr, nullptr, inp(1), Hb, gw, NGW, lane);
    PH_END

    for (int l = 0; l < DEPTH; ++l) {
        const int i2 = l >> 1;
        const bool first = (l == 0);
        if ((l & 1) == 0) {
            PH_BEGIN
                pg8::Gemm g{Hb, Wb + WO_MIX1, T, ZN, D}; pg8::StaticOrder S; S.init(T, ZN, G, bid);
                pg8::EpiZ E{Z, GK};
                pg8::gemm_phase<pg8::EpiZ, pg8::StaticOrder, true, true>(lds, g, S, E);
            PH_END
            PH_BEGIN
                for (int un = bid; un < 256; un += G)
                    gla_unit<false>(un, Z, GK, inp(6) + (size_t)i2 * 16 * 512, inp(7) + (size_t)i2 * 512, inp(9) + (size_t)i2 * 256, Eb, DEC, MIX, lds);
                shortconv(Z, inp(8) + (size_t)i2 * 3 * 512, MIX, gtid, gthreads);
            PH_END
            PH_BEGIN
                gla_scan(Eb, DEC, gtid, gthreads);
            PH_END
            PH_BEGIN
                for (int un = bid; un < 256; un += G)
                    gla_unit<true>(un, Z, GK, inp(6) + (size_t)i2 * 16 * 512, inp(7) + (size_t)i2 * 512, inp(9) + (size_t)i2 * 256, Eb, DEC, MIX, lds);
            PH_END
            PH_BEGIN
                pg8::Gemm g{MIX, Wb + WO_MIX2_E, T, D, MIXLD}; pg8::StaticOrder S; S.init(T, D, G, bid);
                pg8::EpiF32<false> E{ymix, D, nullptr};
                pg8::gemm_phase<pg8::EpiF32<false>, pg8::StaticOrder, false, true>(lds, g, S, E);
            PH_END
        } else {
            PH_BEGIN
                pg8::Gemm g{Hb, Wb + WO_MIX1, T, 2048, D}; pg8::StaticOrder S; S.init(T, 2048, G, bid);
                pg8::EpiGLU E{U, inp(12) + (size_t)i2 * 2048};
                pg8::gemm_phase<pg8::EpiGLU, pg8::StaticOrder, true, true>(lds, g, S, E);
            PH_END
            PH_BEGIN
                conv_phase(U, inp(13) + (size_t)i2 * 31 * D, inp(14) + (size_t)i2 * D, inp(15) + (size_t)i2 * D, inp(16) + (size_t)i2 * D, Dd, lds, G, bid);
            PH_END
            PH_BEGIN
                pg8::Gemm g{Dd, Wb + WO_MIX2_O, T, D, D}; pg8::StaticOrder S; S.init(T, D, G, bid);
                pg8::EpiF32<true> E{ymix, D, inp(18) + (size_t)i2 * D};
                pg8::gemm_phase<pg8::EpiF32<true>, pg8::StaticOrder, false, true>(lds, g, S, E);
            PH_END
        }
        PH_BEGIN
            norm_rows<true, true, true>(ymix, first ? inp(0) : xout, xout, inp(2) + (size_t)l * D, inp(3) + (size_t)l * D, Hb, gw, NGW, lane);
        PH_END
        PH_BEGIN
            pg8::Gemm g{Hb, Wb + WO_W1, T, FF, D}; pg8::StaticOrder S; S.init(T, FF, G, bid);
            pg8::EpiRelu2 E{Ab, FF};
            pg8::gemm_phase<pg8::EpiRelu2, pg8::StaticOrder, true, true>(lds, g, S, E);
        PH_END
        PH_BEGIN
            pg8::Gemm g{Ab, Wb + WO_W2, T, D, FF}; pg8::StaticOrder S; S.init(T, D, G, bid);
            pg8::EpiF32<false> E{ymlp, D, nullptr};
            pg8::gemm_phase<pg8::EpiF32<false>, pg8::StaticOrder, false, true>(lds, g, S, E);
        PH_END
        PH_BEGIN
            if (l + 1 < DEPTH) convert_layer(wsl, l + 1, lds, gw, NGW, wave, lane);
            if (l + 1 < DEPTH) norm_rows<true, true, true>(ymlp, xout, xout, inp(4) + (size_t)l * D, inp(1) + (size_t)(l + 1) * D, Hb, gw, NGW, lane);
            else norm_rows<true, true, false>(ymlp, xout, xout, inp(4) + (size_t)l * D, nullptr, Hb, gw, NGW, lane);
        PH_END
    }
}

extern "C" void kernel_launch(void* const* d_in, const int* in_sizes, int n_in, void* d_out, int out_size, void* d_ws, size_t ws_size, hipStream_t stream) {
    static int grid = 0;
    if (grid == 0) {
        if (n_in != 21 || out_size != T * D || ws_size < WS_END) { fprintf(stderr, "kernel_launch: unexpected shapes (n_in %d out %d ws %zu)\n", n_in, out_size, ws_size); grid = -1; return; }
        int dev = 0, cus = 0, per_cu = 0;
        hipGetDevice(&dev); hipDeviceGetAttribute(&cus, hipDeviceAttributeMultiprocessorCount, dev);
        if (hipFuncSetAttribute((const void*)trunk_fwd, hipFuncAttributeMaxDynamicSharedMemorySize, LDS_BYTES) != hipSuccess) { fprintf(stderr, "kernel_launch: hipFuncSetAttribute failed\n"); grid = -1; return; }
        if (hipOccupancyMaxActiveBlocksPerMultiprocessor(&per_cu, (const void*)trunk_fwd, NTHR, LDS_BYTES) != hipSuccess || per_cu < 1) { fprintf(stderr, "kernel_launch: occupancy query failed (%d)\n", per_cu); (void)hipGetLastError(); per_cu = 1; }
        grid = cus * per_cu; if (grid > 256) grid = 256;
    }
    if (grid < 0) return;
    Args a{};
    for (int i = 0; i < 21; ++i) a.in[i] = (const float*)d_in[i];
    a.out = (float*)d_out; a.ws = (unsigned char*)d_ws; a.ph_lo = 0; a.ph_hi = 33;
    if (hipMemsetAsync((char*)d_ws + WS_BAR, 0, 16384, stream) != hipSuccess) { fprintf(stderr, "kernel_launch: memset failed\n"); return; }
    void* args[] = {&a};
    hipError_t e = hipLaunchCooperativeKernel((const void*)trunk_fwd, dim3(grid), dim3(NTHR), args, LDS_BYTES, stream);
    if (e != hipSuccess) fprintf(stderr, "cooperative launch failed: %s (grid %d)\n", hipGetErrorString(e), grid);
}
```

```cpp
#include <hip/hip_runtime.h>
#include <cstdio>
#include <cstdint>
namespace pg8 {
#define PG8_LAS __attribute__((address_space(3)))
typedef unsigned short bf16_t;
typedef short bf16x8 __attribute__((ext_vector_type(8)));
typedef float f32x4 __attribute__((ext_vector_type(4)));
typedef unsigned u32x4 __attribute__((ext_vector_type(4)));
constexpr int BM = 256, BK = 64, HALF = 128, HTB = HALF * BK * 2  , STAGE_BYTES = 8 * HTB, NXCD = 8, WGM = 8;

__host__ __device__ __forceinline__ int lds_byte(int r, int c) { const int st = (r >> 4) * 2 + (c >> 5), rr = r & 15, cc = c & 31, ob = rr * 64 + cc * 2; return st * 1024 + (ob ^ (((ob >> 9) & 1) << 5)); }
__host__ __device__ __forceinline__ void stage_rc(int b, int& R, int& C) { const int st = b / 1024, sb = b % 1024, swz = sb ^ (((sb >> 9) & 1) << 5); R = (st >> 1) * 16 + swz / 64; C = (st & 1) * 32 + (swz % 64) / 2; }
__host__ __device__ __forceinline__ int perm32(int rho) { const int n = rho >> 4, i = rho & 15; return 8 * (i >> 2) + 4 * n + (i & 3); }

struct Unit { int pm, pn; };
struct Gemm { const bf16_t* A; const bf16_t* Bt; int M, N, K; };

struct StaticOrder {
    int nM, nN, nwg, G, c;
    __host__ __device__ void init(int M, int N, int G_, int c_) { nM = M / BM; nN = N / BM; nwg = nM * nN; G = G_; c = c_; }
    __host__ __device__ bool next(int i, Unit& u) const {
        const long L = (long)i * G + c; if (L >= nwg) return false;
        int wgid = (int)L; { const int q = nwg / NXCD, r = nwg % NXCD, xcd = wgid % NXCD, off = wgid / NXCD; wgid = (xcd < r ? xcd * (q + 1) : r * (q + 1) + (xcd - r) * q) + off; }
        const int nig = WGM * nN, gid = wgid / nig, fm = gid * WGM, gsz = (nM - fm) < WGM ? (nM - fm) : WGM;
        u.pm = fm + ((wgid % nig) % gsz); u.pn = (wgid % nig) / gsz; return true;
    }
    __device__ __forceinline__ void a_ready(const Unit&) const {}
    __device__ __forceinline__ void done(const Unit&) const {}
};
__device__ __forceinline__ unsigned cvt_pk_bf16(float lo, float hi) { unsigned r; asm volatile("v_cvt_pk_bf16_f32 %0, %1, %2" : "=v"(r) : "v"(lo), "v"(hi)); return r; }
typedef float f32x2 __attribute__((ext_vector_type(2)));
}
namespace pg8 {
struct EpiZ {
    static constexpr bool PERM = true, AFTER_DRAIN = false;
    bf16_t* Z; float* GK;
    __device__ __forceinline__ void operator()(const f32x4 (&acc)[2][2][4][2], const Unit& u, int wr, int wc, int fr, int fq) const {
        const int row0 = u.pm * BM + wr * 64 + fr;
        if (u.pn < 18) {
            const int col0 = u.pn * BM + wc * 32 + 8 * fq;
#pragma unroll
            for (int ai = 0; ai < 2; ++ai)
#pragma unroll
                for (int m = 0; m < 4; ++m) { bf16_t* rowp = Z + (size_t)(row0 + ai * HALF + m * 16) * 4608 + col0;
#pragma unroll
                    for (int bj = 0; bj < 2; ++bj) { const f32x4 v0 = acc[ai][bj][m][0], v1 = acc[ai][bj][m][1];
                        u32x4 w; w.x = cvt_pk_bf16(v0[0], v0[1]); w.y = cvt_pk_bf16(v0[2], v0[3]); w.z = cvt_pk_bf16(v1[0], v1[1]); w.w = cvt_pk_bf16(v1[2], v1[3]);
                        *(u32x4*)(rowp + bj * HALF) = w; } }
        } else if (wc == 0 && fq < 2) {
#pragma unroll
            for (int ai = 0; ai < 2; ++ai)
#pragma unroll
                for (int m = 0; m < 4; ++m) { float* rp = GK + (size_t)(row0 + ai * HALF + m * 16) * 16 + 8 * fq;
                    *(f32x4*)rp = acc[ai][0][m][0]; *(f32x4*)(rp + 4) = acc[ai][0][m][1]; }
        }
    }
};
template <bool HAS_BIAS> struct EpiF32 {
    static constexpr bool PERM = false, AFTER_DRAIN = false;
    float* C; int ldc; const float* bias;
    __device__ __forceinline__ void operator()(const f32x4 (&acc)[2][2][4][2], const Unit& u, int wr, int wc, int fr, int fq) const {
        const int row0 = u.pm * BM + wr * 64 + fr, col0 = u.pn * BM + wc * 32 + 4 * fq;
        f32x4 bv[2][2];
#pragma unroll
        for (int bj = 0; bj < 2; ++bj)
#pragma unroll
            for (int n = 0; n < 2; ++n) bv[bj][n] = HAS_BIAS ? *(const f32x4*)(bias + col0 + bj * HALF + n * 16) : (f32x4){0.f, 0.f, 0.f, 0.f};
#pragma unroll
        for (int ai = 0; ai < 2; ++ai)
#pragma unroll
            for (int m = 0; m < 4; ++m) { float* rowp = C + (size_t)(row0 + ai * HALF + m * 16) * ldc + col0;
#pragma unroll
                for (int bj = 0; bj < 2; ++bj)
#pragma unroll
                    for (int n = 0; n < 2; ++n) *(f32x4*)(rowp + bj * HALF + n * 16) = acc[ai][bj][m][n] + bv[bj][n]; }
    }
};
struct EpiRelu2 {
    static constexpr bool PERM = true, AFTER_DRAIN = false;
    bf16_t* O; int ldc;
    __device__ __forceinline__ void operator()(const f32x4 (&acc)[2][2][4][2], const Unit& u, int wr, int wc, int fr, int fq) const {
        const int row0 = u.pm * BM + wr * 64 + fr, col0 = u.pn * BM + wc * 32 + 8 * fq;
#pragma unroll
        for (int ai = 0; ai < 2; ++ai)
#pragma unroll
            for (int m = 0; m < 4; ++m) { bf16_t* rowp = O + (size_t)(row0 + ai * HALF + m * 16) * ldc + col0;
#pragma unroll
                for (int bj = 0; bj < 2; ++bj) { f32x4 v0 = acc[ai][bj][m][0], v1 = acc[ai][bj][m][1];
#pragma unroll
                    for (int j = 0; j < 4; ++j) { const float a = fmaxf(v0[j], 0.f), b = fmaxf(v1[j], 0.f); v0[j] = a * a; v1[j] = b * b; }
                    u32x4 w; w.x = cvt_pk_bf16(v0[0], v0[1]); w.y = cvt_pk_bf16(v0[2], v0[3]); w.z = cvt_pk_bf16(v1[0], v1[1]); w.w = cvt_pk_bf16(v1[2], v1[3]);
                    *(u32x4*)(rowp + bj * HALF) = w; } }
    }
};
struct EpiGLU {
    static constexpr bool PERM = true, AFTER_DRAIN = false;
    bf16_t* U; const float* bias;
    __device__ __forceinline__ void operator()(const f32x4 (&acc)[2][2][4][2], const Unit& u, int wr, int wc, int fr, int fq) const {
        const int row0 = u.pm * BM + wr * 64 + fr, col0 = u.pn * HALF + wc * 32 + 8 * fq;
        f32x4 b1[2], b2[2];
#pragma unroll
        for (int n = 0; n < 2; ++n) { b1[n] = *(const f32x4*)(bias + col0 + 4 * n); b2[n] = *(const f32x4*)(bias + 1024 + col0 + 4 * n); }
#pragma unroll
        for (int ai = 0; ai < 2; ++ai)
#pragma unroll
            for (int m = 0; m < 4; ++m) { bf16_t* rowp = U + (size_t)(row0 + ai * HALF + m * 16) * 1024 + col0;
                f32x4 o[2];
#pragma unroll
                for (int n = 0; n < 2; ++n) { const f32x4 a = acc[ai][0][m][n] + b1[n], g = acc[ai][1][m][n] + b2[n];
#pragma unroll
                    for (int j = 0; j < 4; ++j) o[n][j] = a[j] * __builtin_amdgcn_rcpf(1.f + __expf(-g[j])); }
                u32x4 w; w.x = cvt_pk_bf16(o[0][0], o[0][1]); w.y = cvt_pk_bf16(o[0][2], o[0][3]); w.z = cvt_pk_bf16(o[1][0], o[1][1]); w.w = cvt_pk_bf16(o[1][2], o[1][3]);
                *(u32x4*)rowp = w; }
    }
};
}
namespace pg8 {
template <class Epi, class Sched, bool ALIGN_EPI = false, bool SP2 = false>
__device__ __forceinline__ void gemm_phase(PG8_LAS unsigned char* lds, const Gemm g, const Sched& S, const Epi& E) {
    int tid = threadIdx.x; asm volatile("" : "+v"(tid)); const int wid = __builtin_amdgcn_readfirstlane(tid >> 6), lane = tid & 63, wr = wid >> 2, wc = wid & 3, fr = lane & 15, fq = lane >> 4;
    const int K = g.K, nt = K / BK;
    unsigned voffA[2], voffB[2];
#pragma unroll
    for (int i = 0; i < 2; ++i) { int R, C; stage_rc(tid * 16 + i * 8192, R, C); const int Rb = Epi::PERM ? ((R & ~31) + perm32(R & 31)) : R;
        voffA[i] = (unsigned)(R * K + C) * 2u; voffB[i] = (unsigned)(Rb * K + C) * 2u; }
    const size_t kstep = (size_t)(BK * 2);
    const size_t hstep = (size_t)HALF * K * 2;
    const size_t tstep = 2 * hstep;
    const unsigned ldsw = (unsigned)wid * 1024u;
    const int aoff = lds_byte(wr * 64 + fr, fq * 8), boff = lds_byte(wc * 32 + fr, fq * 8);
#define PG8_SA(b, h) (((b) * 2 + (h)) * HTB)
#define PG8_SB(b, h) ((4 + (b) * 2 + (h)) * HTB)
#define PG8_STAGE(bufoff, gbase, voff) do { _Pragma("unroll") for (int _i = 0; _i < 2; ++_i) \
        __builtin_amdgcn_global_load_lds((const unsigned*)((const char*)(gbase) + (voff)[_i]), (PG8_LAS unsigned*)(lds + (bufoff) + ldsw + _i * 8192), 16, 0, 0); } while (0)
#define PG8_LDA(dst, b, h) do { _Pragma("unroll") for (int m = 0; m < 4; ++m) _Pragma("unroll") for (int k = 0; k < 2; ++k) dst[m][k] = *(const PG8_LAS bf16x8*)(lds + PG8_SA(b, h) + aoff + m * 2048 + k * 1024); } while (0)
#define PG8_LDB(dst, b, h) do { _Pragma("unroll") for (int n = 0; n < 2; ++n) _Pragma("unroll") for (int k = 0; k < 2; ++k) dst[n][k] = *(const PG8_LAS bf16x8*)(lds + PG8_SB(b, h) + boff + n * 2048 + k * 1024); } while (0)
#define PG8_MMA(ai, bj, At, Bt) do { __builtin_amdgcn_s_setprio(1); _Pragma("unroll") for (int m = 0; m < 4; ++m) _Pragma("unroll") for (int n = 0; n < 2; ++n) _Pragma("unroll") for (int k = 0; k < 2; ++k) \
        acc[ai][bj][m][n] = __builtin_amdgcn_mfma_f32_16x16x32_bf16(Bt[n][k], At[m][k], acc[ai][bj][m][n], 0, 0, 0); __builtin_amdgcn_s_setprio(0); } while (0)
#define PG8_WAIT_V(n) asm volatile("s_waitcnt vmcnt(" #n ")" ::: "memory")
#define PG8_WAIT_L(n) asm volatile("s_waitcnt lgkmcnt(" #n ")" ::: "memory")
#define PG8_BAR __builtin_amdgcn_s_barrier()
#define PG8_SCHED __builtin_amdgcn_sched_barrier(0)
    Unit cur, nxt; int ui = 0;
    if (!S.next(0, cur)) return;
    f32x4 acc[2][2][4][2];
#pragma unroll
    for (int a = 0; a < 2; ++a)
#pragma unroll
        for (int b = 0; b < 2; ++b)
#pragma unroll
            for (int m = 0; m < 4; ++m)
#pragma unroll
                for (int n = 0; n < 2; ++n) acc[a][b][m][n] = (f32x4){0.f, 0.f, 0.f, 0.f};
    bf16x8 At[4][2], B0[2][2], B1[2][2];
    const char* cA = (const char*)g.A + (size_t)cur.pm * tstep; const char* cB = (const char*)g.Bt + (size_t)cur.pn * tstep;
    S.a_ready(cur);
    if constexpr (SP2) {
        PG8_STAGE(PG8_SB(0, 0), cB, voffB); PG8_STAGE(PG8_SB(0, 1), cB + hstep, voffB); PG8_STAGE(PG8_SA(0, 0), cA, voffA); PG8_STAGE(PG8_SA(0, 1), cA + hstep, voffA);
        if (wr == 1) PG8_BAR;
        PG8_WAIT_V(2); PG8_BAR;
        PG8_STAGE(PG8_SB(1, 0), cB + kstep, voffB); PG8_STAGE(PG8_SA(1, 0), cA + kstep, voffA); PG8_STAGE(PG8_SB(1, 1), cB + hstep + kstep, voffB);
        PG8_WAIT_V(6); PG8_BAR;
    } else {
        PG8_STAGE(PG8_SB(0, 0), cB, voffB); PG8_STAGE(PG8_SA(0, 0), cA, voffA); PG8_STAGE(PG8_SB(0, 1), cB + hstep, voffB); PG8_STAGE(PG8_SA(0, 1), cA + hstep, voffA);
        if (wr == 1) PG8_BAR;
        PG8_WAIT_V(4); PG8_BAR;
        PG8_STAGE(PG8_SB(1, 0), cB + kstep, voffB); PG8_STAGE(PG8_SA(1, 0), cA + kstep, voffA); PG8_STAGE(PG8_SB(1, 1), cB + hstep + kstep, voffB);
        PG8_WAIT_V(6); PG8_BAR;
    }
    for (;;) {
        const bool has_next = S.next(ui + 1, nxt);
        const char* nA = has_next ? (const char*)g.A + (size_t)nxt.pm * tstep : cA; const char* nB = has_next ? (const char*)g.Bt + (size_t)nxt.pn * tstep : cB;
        for (int t = 0; t < nt; t += 2) {
            const bool last = (t == nt - 2);
            const char* a1 = cA + (size_t)(t + 1) * kstep;
            const char* a2 = last ? nA : cA + (size_t)(t + 2) * kstep; const char* b2 = last ? nB : cB + (size_t)(t + 2) * kstep;
            const char* a3 = a2 + kstep; const char* b3 = b2 + kstep;
            if (last && has_next) S.a_ready(nxt);
            if constexpr (SP2) {
            PG8_LDB(B0, 0, 0); PG8_LDB(B1, 0, 1); PG8_SCHED; PG8_LDA(At, 0, 0); PG8_STAGE(PG8_SA(1, 1), a1 + hstep, voffA);
            PG8_WAIT_V(8); PG8_WAIT_L(0); PG8_BAR; PG8_MMA(0, 0, At, B0); PG8_MMA(0, 1, At, B1); PG8_BAR; PG8_SCHED;
            PG8_LDA(At, 0, 1); PG8_STAGE(PG8_SB(0, 0), b2, voffB); PG8_STAGE(PG8_SB(0, 1), b2 + hstep, voffB); PG8_STAGE(PG8_SA(0, 0), a2, voffA);
            PG8_WAIT_V(8); PG8_WAIT_L(0); PG8_BAR; PG8_MMA(1, 0, At, B0); PG8_MMA(1, 1, At, B1); PG8_BAR; PG8_SCHED;
            PG8_LDB(B0, 1, 0); PG8_LDB(B1, 1, 1); PG8_SCHED; PG8_LDA(At, 1, 0); PG8_STAGE(PG8_SA(0, 1), a2 + hstep, voffA);
            PG8_WAIT_V(8); PG8_WAIT_L(0); PG8_BAR; PG8_MMA(0, 0, At, B0); PG8_MMA(0, 1, At, B1); PG8_BAR; PG8_SCHED;
            PG8_LDA(At, 1, 1); PG8_STAGE(PG8_SB(1, 0), b3, voffB); PG8_STAGE(PG8_SB(1, 1), b3 + hstep, voffB); PG8_STAGE(PG8_SA(1, 0), a3, voffA);
            PG8_WAIT_V(8); PG8_WAIT_L(0); PG8_BAR; PG8_MMA(1, 0, At, B0); PG8_MMA(1, 1, At, B1); PG8_BAR; PG8_SCHED;
            } else {
            PG8_LDB(B0, 0, 0); PG8_SCHED; PG8_LDA(At, 0, 0); PG8_STAGE(PG8_SA(1, 1), a1 + hstep, voffA);
            PG8_WAIT_L(8); PG8_BAR; PG8_WAIT_L(0); PG8_MMA(0, 0, At, B0); PG8_BAR; PG8_SCHED;
            PG8_LDB(B1, 0, 1); PG8_STAGE(PG8_SB(0, 0), b2, voffB);
            PG8_BAR; PG8_WAIT_L(0); PG8_MMA(0, 1, At, B1); PG8_BAR;
            PG8_LDA(At, 0, 1); PG8_STAGE(PG8_SA(0, 0), a2, voffA);
            PG8_BAR; PG8_WAIT_L(0); PG8_MMA(1, 0, At, B0); PG8_BAR; PG8_SCHED;
            PG8_STAGE(PG8_SB(0, 1), b2 + hstep, voffB);
            PG8_WAIT_V(6); PG8_BAR; PG8_MMA(1, 1, At, B1); PG8_BAR;
            PG8_LDB(B0, 1, 0); PG8_SCHED; PG8_LDA(At, 1, 0); PG8_STAGE(PG8_SA(0, 1), a2 + hstep, voffA);
            PG8_WAIT_L(8); PG8_BAR; PG8_WAIT_L(0); PG8_MMA(0, 0, At, B0); PG8_BAR; PG8_SCHED;
            PG8_LDB(B1, 1, 1); PG8_STAGE(PG8_SB(1, 0), b3, voffB);
            PG8_BAR; PG8_WAIT_L(0); PG8_MMA(0, 1, At, B1); PG8_BAR;
            PG8_LDA(At, 1, 1); PG8_STAGE(PG8_SA(1, 0), a3, voffA);
            PG8_BAR; PG8_WAIT_L(0); PG8_MMA(1, 0, At, B0); PG8_BAR; PG8_SCHED;
            PG8_STAGE(PG8_SB(1, 1), b3 + hstep, voffB);
            PG8_WAIT_V(6); PG8_BAR; PG8_MMA(1, 1, At, B1); PG8_BAR;
            }
        }
        if constexpr (ALIGN_EPI) { if (wr == 0) PG8_BAR; }
        if constexpr (!Epi::AFTER_DRAIN) { E(acc, cur, wr, wc, fr, fq); S.done(cur); }
        if (!has_next) break;
#pragma unroll
        for (int a = 0; a < 2; ++a)
#pragma unroll
            for (int b = 0; b < 2; ++b)
#pragma unroll
                for (int m = 0; m < 4; ++m)
#pragma unroll
                    for (int n = 0; n < 2; ++n) acc[a][b][m][n] = (f32x4){0.f, 0.f, 0.f, 0.f};
        cur = nxt; cA = nA; cB = nB; ++ui;
        if constexpr (ALIGN_EPI) { if (wr == 1) PG8_BAR; }
    }
    PG8_WAIT_V(0);
    if constexpr (!ALIGN_EPI) { if (wr == 0) PG8_BAR; }
    PG8_BAR;
    if constexpr (Epi::AFTER_DRAIN) { E.fused(acc, cur, wr, wc, fr, fq, lds, wid, lane); S.done(cur); }
#undef PG8_SA
#undef PG8_SB
#undef PG8_STAGE
#undef PG8_LDA
#undef PG8_LDB
#undef PG8_MMA
#undef PG8_WAIT_V
#undef PG8_WAIT_L
#undef PG8_BAR
#undef PG8_SCHED
}
}
#include <hip/hip_cooperative_groups.h>
namespace cg = cooperative_groups;
#define LAS __attribute__((address_space(3)))
typedef unsigned short bf16;
typedef float f32x4 __attribute__((ext_vector_type(4)));
typedef float f32x2 __attribute__((ext_vector_type(2)));
typedef short bf16x8 __attribute__((ext_vector_type(8)));
typedef unsigned u32x4 __attribute__((ext_vector_type(4)));
typedef unsigned u32x2 __attribute__((ext_vector_type(2)));

constexpr int T = 16384, D = 1024, DEPTH = 4, FF = 4096;
constexpr int ZLD = 4608, ZN = 4864, ABIN = 4624, MIXLD = 1536;
constexpr int ZSX = 0, ZSB = 512, ZSC = 1024, ZQ = 1536, ZK = 2048, ZV = 2560, ZG = 3584;
constexpr float EPS = 1e-6f;
constexpr int NWAVES = 8, NTHR = 512;
constexpr int LDS_BYTES = 147456;
constexpr size_t MiB = 1u << 20;
constexpr size_t WS_DEC = 0;
constexpr size_t WS_BAR = 128 * 1024;
constexpr size_t WS_EBL = 256 * 1024;
constexpr size_t WS_W = 1 * MiB;
constexpr size_t WS_H = 30 * MiB;
constexpr size_t WS_BIG = 62 * MiB;
constexpr size_t WS_GK = 254 * MiB;
constexpr size_t WS_END = 255 * MiB;
constexpr size_t WO_MIX1 = 0;
constexpr size_t WO_MIX2_E = (size_t)ZN * D;
constexpr size_t WO_MIX2_O = (size_t)2048 * D;
constexpr size_t WO_W1 = (size_t)ZN * D + (size_t)D * MIXLD;
constexpr size_t WO_W2 = WO_W1 + (size_t)FF * D;
static_assert(WS_W + (WO_W2 + (size_t)FF * D) * 2 <= WS_H, "weights fit");

__device__ __forceinline__ int tid_l() { int t = threadIdx.x; asm volatile("" : "+v"(t)); return t; }
__device__ __forceinline__ float bf2f(unsigned b) { return __uint_as_float(b << 16); }
__device__ __forceinline__ unsigned pkbf(float lo, float hi) { return pg8::cvt_pk_bf16(lo, hi); }
__device__ __forceinline__ float wave_sum(float v) {
#pragma unroll
    for (int o = 1; o < 64; o <<= 1) v += __shfl_xor(v, o);
    return v;
}

template <int MODE>
__device__ __forceinline__ void transpose_item(const float* W, int K, int N, bf16* WT, LAS float* scr, int item, int lane) {
    const int nblk = (N + 31) / 32, kb = item / nblk, nb = item % nblk, k0 = 64 * kb, n0 = 32 * nb;
    const bool ok = (n0 + (lane & 31)) < N;
#pragma unroll 8
    for (int i = 0; i < 32; ++i) { const int kk = 2 * i + (lane >> 5); scr[kk * 33 + (lane & 31)] = ok ? W[(size_t)(k0 + kk) * N + n0 + (lane & 31)] : 0.f; }
    asm volatile("s_waitcnt lgkmcnt(0)" ::: "memory");
    int d0 = n0;
    if (MODE == 1) { const int half = n0 >> 10, c0 = n0 & 1023; d0 = ((c0 >> 7) << 8) + (half << 7) + (c0 & 127); }
    const int c = lane & 7;
#pragma unroll
    for (int j = 0; j < 4; ++j) { const int n = (lane >> 3) + 8 * j; const LAS float* s = scr + (8 * c) * 33 + n;
        u32x4 o; o.x = pkbf(s[0 * 33], s[1 * 33]); o.y = pkbf(s[2 * 33], s[3 * 33]); o.z = pkbf(s[4 * 33], s[5 * 33]); o.w = pkbf(s[6 * 33], s[7 * 33]);
        *(u32x4*)(WT + (size_t)(d0 + n) * K + k0 + 8 * c) = o; }
    asm volatile("s_waitcnt lgkmcnt(0)" ::: "memory");
}

struct Args { const float* in[21]; float* out; unsigned char* ws; int ph_lo, ph_hi; };
__device__ __forceinline__ const float* inp(int i) { const __attribute__((address_space(4))) char* kp = (const __attribute__((address_space(4))) char*)__builtin_amdgcn_kernarg_segment_ptr(); asm volatile("" : "+s"(kp)); return *(const float* const __attribute__((address_space(4)))*)(kp + 8 * i); }

__device__ __forceinline__ void convert_layer(unsigned char* wsp, int l, LAS unsigned char* lds, int gw, int NGW, int wave, int lane) {
    LAS float* scr = (LAS float*)(lds + wave * 8704);
    bf16* Wb = (bf16*)(wsp + WS_W);
    const int i2 = l >> 1;
    const float* w1 = inp(19) + (size_t)l * D * FF; const float* w2 = inp(20) + (size_t)l * FF * D;
    constexpr int I_W1 = (D / 64) * (FF / 32), I_W2 = (FF / 64) * (D / 32);
    if ((l & 1) == 0) {
        const float* win = inp(5) + (size_t)i2 * D * ABIN; const float* wout = inp(10) + (size_t)i2 * MIXLD * D;
        constexpr int I_IN = (D / 64) * ((ABIN + 31) / 32), I_OUT = (MIXLD / 64) * (D / 32);
        constexpr int NIT = I_IN + I_OUT + I_W1 + I_W2;
        for (int it = gw; it < NIT; it += NGW) { int r = it;
            if (r < I_IN) { transpose_item<0>(win, D, ABIN, Wb + WO_MIX1, scr, r, lane); continue; } r -= I_IN;
            if (r < I_OUT) { transpose_item<0>(wout, MIXLD, D, Wb + WO_MIX2_E, scr, r, lane); continue; } r -= I_OUT;
            if (r < I_W1) { transpose_item<0>(w1, D, FF, Wb + WO_W1, scr, r, lane); continue; } r -= I_W1;
            transpose_item<0>(w2, FF, D, Wb + WO_W2, scr, r, lane); }
        u32x4* pz = (u32x4*)(Wb + WO_MIX1 + (size_t)4640 * D); const int nz = (ZN - 4640) * D / 8;
        for (int i = gw * 64 + lane; i < nz; i += NGW * 64) pz[i] = (u32x4){0u, 0u, 0u, 0u};
    } else {
        const float* pw1 = inp(11) + (size_t)i2 * D * 2048; const float* pw2 = inp(17) + (size_t)i2 * D * D;
        constexpr int I_P1 = (D / 64) * (2048 / 32), I_P2 = (D / 64) * (D / 32);
        constexpr int NIT = I_P1 + I_P2 + I_W1 + I_W2;
        for (int it = gw; it < NIT; it += NGW) { int r = it;
            if (r < I_P1) { transpose_item<1>(pw1, D, 2048, Wb + WO_MIX1, scr, r, lane); continue; } r -= I_P1;
            if (r < I_P2) { transpose_item<0>(pw2, D, D, Wb + WO_MIX2_O, scr, r, lane); continue; } r -= I_P2;
            if (r < I_W1) { transpose_item<0>(w1, D, FF, Wb + WO_W1, scr, r, lane); continue; } r -= I_W1;
            transpose_item<0>(w2, FF, D, Wb + WO_W2, scr, r, lane); }
    }
}

template <bool HAS_Y, bool HAS_XD, bool HAS_PRE>
__device__ __forceinline__ void norm_rows(const float* y, const float* xs, float* xd, const float* gpost, const float* gpre, bf16* h, int gw, int NGW, int lane) {
    for (int row = gw; row < T; row += NGW) {
        const f32x4* xr = (const f32x4*)(xs + (size_t)row * D) + lane;
        f32x4 xv[4];
#pragma unroll
        for (int j = 0; j < 4; ++j) xv[j] = xr[64 * j];
        if (HAS_Y) {
            const f32x4* yr = (const f32x4*)(y + (size_t)row * D) + lane; f32x4 yv[4]; float s = 0.f;
#pragma unroll
            for (int j = 0; j < 4; ++j) { yv[j] = yr[64 * j]; s += (yv[j].x * yv[j].x + yv[j].y * yv[j].y) + (yv[j].z * yv[j].z + yv[j].w * yv[j].w); }
            const float r = 1.f / sqrtf(wave_sum(s) * (1.f / D) + EPS);
#pragma unroll
            for (int j = 0; j < 4; ++j) { const f32x4 g = ((const f32x4*)gpost)[64 * j + lane]; xv[j] = xv[j] + yv[j] * r * g; }
        }
        if (HAS_XD) { f32x4* xo = (f32x4*)(xd + (size_t)row * D) + lane;
#pragma unroll
            for (int j = 0; j < 4; ++j) xo[64 * j] = xv[j]; }
        if (HAS_PRE) {
            float s = 0.f;
#pragma unroll
            for (int j = 0; j < 4; ++j) s += (xv[j].x * xv[j].x + xv[j].y * xv[j].y) + (xv[j].z * xv[j].z + xv[j].w * xv[j].w);
            const float r = 1.f / sqrtf(wave_sum(s) * (1.f / D) + EPS);
            u32x2* ho = (u32x2*)(h + (size_t)row * D) + lane;
#pragma unroll
            for (int j = 0; j < 4; ++j) { const f32x4 g = ((const f32x4*)gpre)[64 * j + lane]; const f32x4 v = xv[j] * r * g; u32x2 w; w.x = pkbf(v.x, v.y); w.y = pkbf(v.z, v.w); ho[64 * j] = w; }
        }
    }
}

constexpr int G_QD = 0, G_KD = 17408, G_KLT = 34816, G_VT = 53248, G_P = 90112, G_SEG = 99328, G_EBL = 101376, G_SS = 101888, G_GT = 103936;
#define MFMA16(a, b, c) __builtin_amdgcn_mfma_f32_16x16x32_bf16(a, b, c, 0, 0, 0)
template <bool OUT>
__device__ __forceinline__ void gla_unit(int unit, bf16* z, const float* gklr, const float* wgk2, const float* bgk2, const float* normg, float* E, float* DEC, float* EBLG, bf16* mix, LAS unsigned char* lds) {
    const int tid = tid_l(), lane = tid & 63, w = __builtin_amdgcn_readfirstlane(tid >> 6), r = lane & 15, q = lane >> 4;
    const int g = unit >> 2, h = unit & 3;
    const int seg = w >> 1, k = (w & 1) * 64 + lane, hk = h * 128 + k;
    const int vv = tid & 255, jh = w >> 2;
    f32x4 S[8][2];
    float* Eu = E + (size_t)unit * 32768 + (size_t)w * 4096 + lane;
    if (OUT) {
#pragma unroll
        for (int mt = 0; mt < 8; ++mt)
#pragma unroll
            for (int nt = 0; nt < 2; ++nt)
#pragma unroll
                for (int i = 0; i < 4; ++i) S[mt][nt][i] = Eu[((mt * 2 + nt) * 4 + i) * 64];
    } else {
#pragma unroll
        for (int mt = 0; mt < 8; ++mt)
#pragma unroll
            for (int nt = 0; nt < 2; ++nt) S[mt][nt] = (f32x4){0.f, 0.f, 0.f, 0.f};
    }
    float bsum = 0.f;
    LAS float* SEG = (LAS float*)(lds + G_SEG); LAS float* EBL = (LAS float*)(lds + G_EBL); LAS float* SSQ = (LAS float*)(lds + G_SS);
    for (int ch = 0; ch < 4; ++ch) {
        const int t0 = g * 256 + ch * 64, cgl = g * 4 + ch;
        if (!OUT) {
            int zofs = 0; asm volatile("" : "+v"(zofs));
            float w2r[16];
#pragma unroll
            for (int i = 0; i < 16; ++i) w2r[i] = wgk2[i * 512 + hk + zofs];
            const float bias = bgk2[hk + zofs];
            float b[16]; float run = 0.f;
#pragma unroll
            for (int jj = 0; jj < 16; ++jj) {
                const f32x4* gp = (const f32x4*)(gklr + (size_t)(t0 + seg * 16 + jj) * 16);
                const f32x4 g0 = gp[0], g1 = gp[1], g2 = gp[2], g3 = gp[3];
                float gv = bias;
                gv += g0.x * w2r[0] + g0.y * w2r[1] + g0.z * w2r[2] + g0.w * w2r[3];
                gv += g1.x * w2r[4] + g1.y * w2r[5] + g1.z * w2r[6] + g1.w * w2r[7];
                gv += g2.x * w2r[8] + g2.y * w2r[9] + g2.z * w2r[10] + g2.w * w2r[11];
                gv += g3.x * w2r[12] + g3.y * w2r[13] + g3.z * w2r[14] + g3.w * w2r[15];
                const float ls = -(fmaxf(-gv, 0.f) + __logf(1.f + __expf(-fabsf(gv)))) * (1.f / 16.f);
                run += ls; b[jj] = run;
            }
            SEG[seg * 128 + k] = run;
            __syncthreads();
            float pre = 0.f, tot = 0.f;
#pragma unroll
            for (int s = 0; s < 4; ++s) { const float v = SEG[s * 128 + k]; tot += v; pre += (s < seg) ? v : 0.f; }
            if (seg == 0) { const float eb = __expf(tot); EBL[k] = eb; EBLG[cgl * 512 + hk] = eb; bsum += tot; }
            unsigned klp[8];
#pragma unroll
            for (int jj = 0; jj < 16; jj += 2) {
                float kl2[2];
#pragma unroll
                for (int e = 0; e < 2; ++e) {
                    bf16* zr = z + (size_t)(t0 + seg * 16 + jj + e) * ZLD; const float bb = b[jj + e] + pre;
                    const float kv = bf2f(zr[ZK + hk]), qv = bf2f(zr[ZQ + hk]);
                    kl2[e] = kv * __expf(tot - bb);
                    zr[ZQ + hk] = (bf16)(pkbf(qv * 0.08838834764831845f * __expf(bb), 0.f) & 0xffffu);
                    zr[ZK + hk] = (bf16)(pkbf(kv * __expf(-bb), 0.f) & 0xffffu);
                }
                klp[jj >> 1] = pkbf(kl2[0], kl2[1]);
            }
            LAS u32x4* kp = (LAS u32x4*)(lds + G_KLT + k * 144 + seg * 32);
            kp[0] = (u32x4){klp[0], klp[1], klp[2], klp[3]}; kp[1] = (u32x4){klp[4], klp[5], klp[6], klp[7]};
        } else {
#pragma unroll
            for (int i = 0; i < 4; ++i) { const int c = tid + 512 * i, row = c >> 5, c16 = c & 31;
                *(LAS u32x4*)(lds + G_GT + row * 528 + c16 * 16) = *(const u32x4*)(z + (size_t)(t0 + row) * ZLD + ZG + h * 256 + c16 * 8); }
#pragma unroll
            for (int i = 0; i < 2; ++i) { const int c = tid + 512 * i, row = c >> 4, c16 = c & 15; const bf16* zr = z + (size_t)(t0 + row) * ZLD + h * 128 + c16 * 8;
                *(LAS u32x4*)(lds + G_QD + row * 272 + c16 * 16) = *(const u32x4*)(zr + ZQ);
                *(LAS u32x4*)(lds + G_KD + row * 272 + c16 * 16) = *(const u32x4*)(zr + ZK); }
            const float eb = EBLG[cgl * 512 + hk];
            if (seg == 0) EBL[k] = eb;
            unsigned klp[8];
#pragma unroll
            for (int jj = 0; jj < 16; jj += 2) {
                const bf16* zr = z + (size_t)(t0 + seg * 16 + jj) * ZLD + ZK + hk;
                klp[jj >> 1] = pkbf(bf2f(zr[0]) * eb, bf2f(zr[ZLD]) * eb);
            }
            LAS u32x4* kp = (LAS u32x4*)(lds + G_KLT + k * 144 + seg * 32);
            kp[0] = (u32x4){klp[0], klp[1], klp[2], klp[3]}; kp[1] = (u32x4){klp[4], klp[5], klp[6], klp[7]};
        }
        {
            const bf16* zv = z + (size_t)(t0 + jh * 32) * ZLD + ZV + h * 256 + vv;
            unsigned vp[16];
#pragma unroll
            for (int jj = 0; jj < 32; jj += 2) vp[jj >> 1] = (unsigned)zv[(size_t)jj * ZLD] | ((unsigned)zv[(size_t)(jj + 1) * ZLD] << 16);
            LAS u32x4* vpp = (LAS u32x4*)(lds + G_VT + vv * 144 + jh * 64);
#pragma unroll
            for (int i = 0; i < 4; ++i) vpp[i] = (u32x4){vp[4 * i], vp[4 * i + 1], vp[4 * i + 2], vp[4 * i + 3]};
        }
        __syncthreads();
        if (OUT) {
            const int jt = w >> 1;
#pragma unroll
            for (int ii = 0; ii < 2; ++ii) {
                const int it = (w & 1) * 2 + ii;
                f32x4 pa = (f32x4){0.f, 0.f, 0.f, 0.f};
                if (jt <= it) {
#pragma unroll
                    for (int s = 0; s < 4; ++s) {
                        const bf16x8 A = *(const LAS bf16x8*)(lds + G_KD + ((16 * jt + r) * 136 + 32 * s + 8 * q) * 2);
                        const bf16x8 B = *(const LAS bf16x8*)(lds + G_QD + ((16 * it + r) * 136 + 32 * s + 8 * q) * 2);
                        pa = MFMA16(A, B, pa);
                    }
                    const int i_ = 16 * it + r;
#pragma unroll
                    for (int e = 0; e < 4; ++e) { const int j_ = 16 * jt + 4 * q + e; if (j_ > i_) pa[e] = 0.f; }
                }
                u32x2 pw; pw.x = pkbf(pa[0], pa[1]); pw.y = pkbf(pa[2], pa[3]);
                *(LAS u32x2*)(lds + G_P + ((16 * it + r) * 72 + 16 * jt + 4 * q) * 2) = pw;
            }
            __syncthreads();
        }
        bf16x8 Bv[2][2];
#pragma unroll
        for (int s2 = 0; s2 < 2; ++s2)
#pragma unroll
            for (int nt = 0; nt < 2; ++nt) Bv[s2][nt] = *(const LAS bf16x8*)(lds + G_VT + ((32 * w + 16 * nt + r) * 72 + 32 * s2 + 8 * q) * 2);
        f32x4 o[4][2];
        if (OUT) {
#pragma unroll
            for (int mt = 0; mt < 4; ++mt)
#pragma unroll
                for (int nt = 0; nt < 2; ++nt) o[mt][nt] = (f32x4){0.f, 0.f, 0.f, 0.f};
#pragma unroll
            for (int s = 0; s < 4; ++s) {
                bf16x8 Sb[2];
#pragma unroll
                for (int nt = 0; nt < 2; ++nt) {
                    u32x4 t; t.x = pkbf(S[2 * s][nt][0], S[2 * s][nt][1]); t.y = pkbf(S[2 * s][nt][2], S[2 * s][nt][3]);
                    t.z = pkbf(S[2 * s + 1][nt][0], S[2 * s + 1][nt][1]); t.w = pkbf(S[2 * s + 1][nt][2], S[2 * s + 1][nt][3]);
                    Sb[nt] = __builtin_bit_cast(bf16x8, t);
                }
#pragma unroll
                for (int mt = 0; mt < 4; ++mt) {
                    const u32x2 lo = *(const LAS u32x2*)(lds + G_QD + ((16 * mt + r) * 136 + 32 * s + 4 * q) * 2);
                    const u32x2 hi = *(const LAS u32x2*)(lds + G_QD + ((16 * mt + r) * 136 + 32 * s + 16 + 4 * q) * 2);
                    const bf16x8 A = __builtin_bit_cast(bf16x8, (u32x4){lo.x, lo.y, hi.x, hi.y});
#pragma unroll
                    for (int nt = 0; nt < 2; ++nt) o[mt][nt] = MFMA16(A, Sb[nt], o[mt][nt]);
                }
            }
#pragma unroll
            for (int s2 = 0; s2 < 2; ++s2)
#pragma unroll
                for (int mt = 0; mt < 4; ++mt) {
                    const bf16x8 A = *(const LAS bf16x8*)(lds + G_P + ((16 * mt + r) * 72 + 32 * s2 + 8 * q) * 2);
#pragma unroll
                    for (int nt = 0; nt < 2; ++nt) o[mt][nt] = MFMA16(A, Bv[s2][nt], o[mt][nt]);
                }
        }
#pragma unroll
        for (int mt = 0; mt < 8; ++mt) {
            const f32x4 eb = *(const LAS f32x4*)(lds + G_EBL + (16 * mt + 4 * q) * 4);
#pragma unroll
            for (int nt = 0; nt < 2; ++nt) S[mt][nt] = S[mt][nt] * eb;
#pragma unroll
            for (int s2 = 0; s2 < 2; ++s2) {
                const bf16x8 A = *(const LAS bf16x8*)(lds + G_KLT + ((16 * mt + r) * 72 + 32 * s2 + 8 * q) * 2);
#pragma unroll
                for (int nt = 0; nt < 2; ++nt) S[mt][nt] = MFMA16(A, Bv[s2][nt], S[mt][nt]);
            }
        }
        if (OUT) {
#pragma unroll
            for (int mt = 0; mt < 4; ++mt)
#pragma unroll
                for (int e = 0; e < 4; ++e) {
                    float s = o[mt][0][e] * o[mt][0][e] + o[mt][1][e] * o[mt][1][e];
                    s += __shfl_xor(s, 1); s += __shfl_xor(s, 2); s += __shfl_xor(s, 4); s += __shfl_xor(s, 8);
                    if (r == 0) SSQ[(16 * mt + 4 * q + e) * 8 + w] = s;
                }
            __syncthreads();
            const float ng0 = normg[32 * w + r], ng1 = normg[32 * w + 16 + r];
#pragma unroll
            for (int mt = 0; mt < 4; ++mt)
#pragma unroll
                for (int e = 0; e < 4; ++e) {
                    const int i_ = 16 * mt + 4 * q + e;
                    const f32x4 sa = *(const LAS f32x4*)(lds + G_SS + i_ * 32), sb = *(const LAS f32x4*)(lds + G_SS + i_ * 32 + 16);
                    const float tot2 = ((sa.x + sa.y) + (sa.z + sa.w)) + ((sb.x + sb.y) + (sb.z + sb.w));
                    const float rs = 1.f / sqrtf(tot2 * (1.f / 256.f) + EPS);
                    LAS bf16* gp = (LAS bf16*)(lds + G_GT + i_ * 528 + (32 * w + r) * 2);
                    const float ga = bf2f(gp[0]), gb = bf2f(gp[16]);
                    const float va = o[mt][0][e] * rs * ng0 * ga * __builtin_amdgcn_rcpf(1.f + __expf(-ga));
                    const float vb = o[mt][1][e] * rs * ng1 * gb * __builtin_amdgcn_rcpf(1.f + __expf(-gb));
                    const unsigned pv = pkbf(va, vb);
                    gp[0] = (bf16)(pv & 0xffffu); gp[16] = (bf16)(pv >> 16);
                }
            __syncthreads();
#pragma unroll
            for (int i = 0; i < 4; ++i) { const int c = tid + 512 * i, row = c >> 5, c16 = c & 31;
                *(u32x4*)(mix + (size_t)(t0 + row) * MIXLD + 512 + h * 256 + c16 * 8) = *(const LAS u32x4*)(lds + G_GT + row * 528 + c16 * 16); }
        }
        __syncthreads();
    }
    if (!OUT) {
#pragma unroll
        for (int mt = 0; mt < 8; ++mt)
#pragma unroll
            for (int nt = 0; nt < 2; ++nt)
#pragma unroll
                for (int i = 0; i < 4; ++i) Eu[((mt * 2 + nt) * 4 + i) * 64] = S[mt][nt][i];
        if (seg == 0) DEC[unit * 128 + k] = __expf(bsum);
    }
}

__device__ __forceinline__ void shortconv(const bf16* z, const float* wsc, bf16* mix, int gtid, int gthreads) {
    for (int idx = gtid; idx < T * 256; idx += gthreads) {
        const int t = idx >> 8, c = (idx & 255) * 2;
        float a0 = 0.f, a1 = 0.f;
#pragma unroll
        for (int j = 0; j < 3; ++j) { const int tt = t - 2 + j;
            if (tt >= 0) { const bf16* zr = z + (size_t)tt * ZLD; const unsigned x2 = *(const unsigned*)(zr + ZSX + c), c2 = *(const unsigned*)(zr + ZSC + c);
                const f32x2 wj = *(const f32x2*)(wsc + j * 512 + c);
                a0 += wj.x * (bf2f(x2 & 0xffffu) * bf2f(c2 & 0xffffu)); a1 += wj.y * (bf2f(x2 >> 16) * bf2f(c2 >> 16)); } }
        const unsigned b2 = *(const unsigned*)(z + (size_t)t * ZLD + ZSB + c);
        *(unsigned*)(mix + (size_t)t * MIXLD + c) = pkbf(bf2f(b2 & 0xffffu) * a0, bf2f(b2 >> 16) * a1);
    }
}

__device__ __forceinline__ void gla_scan(float* E, const float* DEC, int gtid, int gthreads) {
    for (int e = gtid; e < 4 * 32768; e += gthreads) {
        const int h = e >> 15, rem = e & 32767, rr = (rem >> 6) & 63, ln = rem & 63;
        const int k = 16 * (rr >> 3) + 4 * (ln >> 4) + (rr & 3);
        float s = 0.f;
#pragma unroll 8
        for (int g = 0; g < 64; ++g) { float* p = E + (size_t)(g * 4 + h) * 32768 + rem; const float tmp = *p; *p = s; s = DEC[(g * 4 + h) * 128 + k] * s + tmp; }
    }
}

__device__ __forceinline__ void conv_phase(const bf16* u, const float* wdw, const float* bdw, const float* lng, const float* lnb, bf16* dout, LAS unsigned char* lds, int G, int bid) {
    const int tid = tid_l(), lane = tid & 63, w = tid >> 6;
    LAS unsigned* UL = (LAS unsigned*)lds;
    LAS f32x2* RED = (LAS f32x2*)(lds + 126976);
    LAS f32x2* STAT = (LAS f32x2*)(lds + 126976 + 2048);
    float w0[31], w1[31];
#pragma unroll
    for (int j = 0; j < 31; ++j) { const f32x2 t = *(const f32x2*)(wdw + j * 1024 + 2 * tid); w0[j] = t.x; w1[j] = t.y; }
    const f32x2 bd = *(const f32x2*)(bdw + 2 * tid), lg = *(const f32x2*)(lng + 2 * tid), lb = *(const f32x2*)(lnb + 2 * tid);
    for (int tile = bid; tile < T / 32; tile += G) {
        const int t0 = tile * 32;
        for (int i = tid; i < 62 * 128; i += NTHR) { const int rr = i >> 7, cc = i & 127, t = t0 - 30 + rr;
            u32x4 v = (u32x4){0u, 0u, 0u, 0u}; if (t >= 0) v = *(const u32x4*)(u + (size_t)t * D + cc * 8);
            *(LAS u32x4*)(lds + rr * 2048 + cc * 16) = v; }
        __syncthreads();
#pragma unroll 1
        for (int sub = 0; sub < 2; ++sub) {
            float d0[16], d1[16];
#pragma unroll
            for (int tt = 0; tt < 16; ++tt) { d0[tt] = bd.x; d1[tt] = bd.y; }
            const LAS unsigned* ULs = UL + sub * 16 * 512 + tid;
#pragma unroll
            for (int rr = 0; rr < 46; ++rr) {
                const unsigned uu = ULs[rr * 512]; const float ua = bf2f(uu & 0xffffu), ub = bf2f(uu >> 16);
#pragma unroll
                for (int tt = 0; tt < 16; ++tt) { if (rr - tt >= 0 && rr - tt <= 30) { d0[tt] += w0[rr - tt] * ua; d1[tt] += w1[rr - tt] * ub; } }
                if ((rr & 7) == 7) __builtin_amdgcn_sched_barrier(0);
            }
#pragma unroll
            for (int tt = 0; tt < 16; ++tt) {
                float s1 = d0[tt] + d1[tt], s2 = d0[tt] * d0[tt] + d1[tt] * d1[tt];
                s1 = wave_sum(s1); s2 = wave_sum(s2);
                if (lane == 0) RED[tt * 8 + w] = (f32x2){s1, s2};
            }
            __syncthreads();
            if (tid < 16) { float s1 = 0.f, s2 = 0.f;
#pragma unroll
                for (int i = 0; i < 8; ++i) { const f32x2 t = RED[tid * 8 + i]; s1 += t.x; s2 += t.y; }
                const float mean = s1 * (1.f / D); const float var = fmaxf(s2 * (1.f / D) - mean * mean, 0.f);
                STAT[tid] = (f32x2){mean, 1.f / sqrtf(var + EPS)}; }
            __syncthreads();
#pragma unroll
            for (int tt = 0; tt < 16; ++tt) {
                const f32x2 st = STAT[tt];
                const float a = (d0[tt] - st.x) * st.y * lg.x + lb.x, b = (d1[tt] - st.x) * st.y * lg.y + lb.y;
                const float sa = a * __builtin_amdgcn_rcpf(1.f + __expf(-a)), sb = b * __builtin_amdgcn_rcpf(1.f + __expf(-b));
                *(unsigned*)(dout + (size_t)(t0 + sub * 16 + tt) * D + 2 * tid) = pkbf(sa, sb);
            }
        }
        __syncthreads();
    }
}

#define XB_TMO      128
#define XB_XCNT(j)  (256  + 64 * (j))
#define XB_XSUB(j)  (1280 + 64 * (j))
#define XB_XGEN(j)  (2304 + 64 * (j))
#define XB_TOP      3328
#define XB_TOPGEN   3392
#define XCD_BAR_WORDS 3456
#define XB_SPIN_CAP (1u << 18)

__device__ __forceinline__ unsigned xb_ld(unsigned* p)              { return __hip_atomic_load(p, __ATOMIC_RELAXED, __HIP_MEMORY_SCOPE_AGENT); }
__device__ __forceinline__ unsigned xb_add(unsigned* p, unsigned v) { return __hip_atomic_fetch_add(p, v, __ATOMIC_RELAXED, __HIP_MEMORY_SCOPE_AGENT); }
__device__ __forceinline__ unsigned xb_xcc_id() { return (unsigned)__builtin_amdgcn_s_getreg((3 << 11) | 20) & 0xFu; }
#define XB_SPIN(cond, bar) do { unsigned _sp = 0; while (cond) { __builtin_amdgcn_s_sleep(1); \
    if ((++_sp & 255u) == 0u) { if (xb_ld(&(bar)[XB_TMO])) break; if (_sp > XB_SPIN_CAP) { atomicAdd(&(bar)[XB_TMO], 1u); break; } } } } while (0)

struct XcdBarrier {
    unsigned* bar; unsigned x;
    volatile LAS unsigned* st;
};

__device__ __forceinline__ XcdBarrier xcd_barrier_post(unsigned* bar, volatile LAS unsigned* st) {
    XcdBarrier b; b.bar = bar; b.x = xb_xcc_id(); b.st = st;
    if (threadIdx.x == 0) (void)xb_add(&bar[XB_XCNT(b.x)], 1u);
    return b;
}
__device__ __forceinline__ void xcd_barrier_complete(unsigned* bar, unsigned x, unsigned& nloc, unsigned& nx) {
    const unsigned G = gridDim.x * gridDim.y * gridDim.z;
    unsigned sum, cnt, mine, sp = 0u;
    for (;;) {
        sum = 0u; cnt = 0u; mine = 0u;
#pragma unroll
        for (unsigned j = 0; j < 16; ++j) { const unsigned c = xb_ld(&bar[XB_XCNT(j)]); sum += c; cnt += (c > 0u) ? 1u : 0u; mine = (j == x) ? c : mine; }
        if (sum == G) break;
        __builtin_amdgcn_s_sleep(1);
        if ((++sp & 255u) == 0u) { if (xb_ld(&bar[XB_TMO])) break; if (sp > XB_SPIN_CAP) { atomicAdd(&bar[XB_TMO], 1u); break; } }
    }
    nloc = mine > 0u ? mine : 1u; nx = cnt > 0u ? cnt : 1u;
}

__device__ __forceinline__ void xcd_barrier(const XcdBarrier& b) {
    asm volatile("s_waitcnt vmcnt(0)" ::: "memory");
    __syncthreads();
    if (threadIdx.x == 0) {
        unsigned* bar = b.bar;
        __builtin_amdgcn_s_waitcnt(0);
        unsigned nloc = b.st[0], nx = b.st[1];
        if (nloc == 0u) { xcd_barrier_complete(bar, b.x, nloc, nx); b.st[0] = nloc; b.st[1] = nx; }
        const unsigned old = xb_add(&bar[XB_XSUB(b.x)], 1u);
        const unsigned gen = old / nloc;
        if (old + 1u == (gen + 1u) * nloc) {
            __builtin_amdgcn_fence(__ATOMIC_RELEASE, "agent");
            asm volatile("s_waitcnt vmcnt(0)" ::: "memory");
            const unsigned og = xb_add(&bar[XB_TOP], 1u);
            const unsigned tg = og / nx;
            if (og + 1u == (tg + 1u) * nx) xb_add(&bar[XB_TOPGEN], 1u);
            else XB_SPIN(xb_ld(&bar[XB_TOPGEN]) == tg, bar);
            __builtin_amdgcn_fence(__ATOMIC_ACQUIRE, "agent");
            xb_add(&bar[XB_XGEN(b.x)], 1u);
            asm volatile("s_waitcnt vmcnt(0)" ::: "memory");
        } else {
            XB_SPIN(xb_ld(&bar[XB_XGEN(b.x)]) == gen, bar);
            __builtin_amdgcn_fence(__ATOMIC_ACQUIRE, "agent");
            asm volatile("s_waitcnt vmcnt(0)" ::: "memory");
        }
    }
    __syncthreads();
}

__global__ void __launch_bounds__(NTHR, 2) trunk_fwd(Args a) {
    extern __shared__ __attribute__((aligned(16))) unsigned char lds_raw[];
    LAS unsigned char* lds = (LAS unsigned char*)lds_raw;
    cg::grid_group grid = cg::this_grid();
    { volatile LAS unsigned* st0 = (volatile LAS unsigned*)(lds + LDS_BYTES - 16); if (threadIdx.x < 4) st0[threadIdx.x] = 0u; }
    __syncthreads();
    const XcdBarrier xbar = xcd_barrier_post((unsigned*)(a.ws + WS_BAR), (volatile LAS unsigned*)(lds + LDS_BYTES - 16));
    const int G0 = gridDim.x;
#define IDS int bid = blockIdx.x; asm volatile("" : "+s"(bid)); const int tid = tid_l(), lane = tid & 63, wave = __builtin_amdgcn_readfirstlane(tid >> 6), gw = bid * NWAVES + wave, gtid = bid * NTHR + tid; (void)lane; (void)gw; (void)gtid;
    unsigned char* ws = a.ws; float* const xout = a.out;
#define Wb ((bf16*)(wsl + WS_W))
#define Hb ((bf16*)(wsl + WS_H))
#define Eb ((float*)(wsl + WS_H))
#define DEC ((float*)(wsl + WS_DEC))
#define GK ((float*)(wsl + WS_GK))
#define EBLG ((float*)(wsl + WS_EBL))
#define big (wsl + WS_BIG)
#define Z ((bf16*)big)
#define MIX ((bf16*)(big + 144 * MiB))
#define U ((bf16*)big)
#define Dd ((bf16*)(big + 32 * MiB))
#define Ab ((bf16*)big)
#define ymlp ((float*)(big + 128 * MiB))
#define ymix ((float*)(big + ((l & 1) ? 64 * MiB : 0)))
#ifndef PH_LO
#define PH_LO 0
#endif
#ifndef PH_HI
#define PH_HI 33
#endif
    constexpr int lo = PH_LO, hi = PH_HI;
    int ph = 0;
#define PH_BEGIN if (ph >= lo && ph < hi) { IDS unsigned char* wsl = ws; asm volatile("" : "+s"(wsl)); int G = G0; asm volatile("" : "+s"(G)); const int NGW = G * NWAVES, gthreads = G * NTHR; (void)NGW; (void)gthreads;
#define PH_END   if (ph + 1 < hi) { if (ph == lo) grid.sync(); else xcd_barrier(xbar); } } ++ph;

    PH_BEGIN
        convert_layer(wsl, 0, lds, gw, NGW, wave, lane);
        norm_rows<false, false, true>(nullptr, inp(0), nullptr, nullptr, inp(1), Hb, gw, NGW, lane);
    PH_END

    for (int l = 0; l < DEPTH; ++l) {
        const int i2 = l >> 1;
        const bool first = (l == 0);
        if ((l & 1) == 0) {
            PH_BEGIN
                pg8::Gemm g{Hb, Wb + WO_MIX1, T, ZN, D}; pg8::StaticOrder S; S.init(T, ZN, G, bid);
                pg8::EpiZ E{Z, GK};
                pg8::gemm_phase<pg8::EpiZ, pg8::StaticOrder, true, true>(lds, g, S, E);
            PH_END
            PH_BEGIN
                for (int un = bid; un < 256; un += G)
                    gla_unit<false>(un, Z, GK, inp(6) + (size_t)i2 * 16 * 512, inp(7) + (size_t)i2 * 512, inp(9) + (size_t)i2 * 256, Eb, DEC, EBLG, MIX, lds);
                shortconv(Z, inp(8) + (size_t)i2 * 3 * 512, MIX, gtid, gthreads);
            PH_END
            PH_BEGIN
                gla_scan(Eb, DEC, gtid, gthreads);
            PH_END
            PH_BEGIN
                for (int un = bid; un < 256; un += G)
                    gla_unit<true>(un, Z, GK, inp(6) + (size_t)i2 * 16 * 512, inp(7) + (size_t)i2 * 512, inp(9) + (size_t)i2 * 256, Eb, DEC, EBLG, MIX, lds);
            PH_END
            PH_BEGIN
                pg8::Gemm g{MIX, Wb + WO_MIX2_E, T, D, MIXLD}; pg8::StaticOrder S; S.init(T, D, G, bid);
                pg8::EpiF32<false> E{ymix, D, nullptr};
                pg8::gemm_phase<pg8::EpiF32<false>, pg8::StaticOrder, false, true>(lds, g, S, E);
            PH_END
        } else {
            PH_BEGIN
                pg8::Gemm g{Hb, Wb + WO_MIX1, T, 2048, D}; pg8::StaticOrder S; S.init(T, 2048, G, bid);
                pg8::EpiGLU E{U, inp(12) + (size_t)i2 * 2048};
                pg8::gemm_phase<pg8::EpiGLU, pg8::StaticOrder, true, true>(lds, g, S, E);
            PH_END
            PH_BEGIN
                conv_phase(U, inp(13) + (size_t)i2 * 31 * D, inp(14) + (size_t)i2 * D, inp(15) + (size_t)i2 * D, inp(16) + (size_t)i2 * D, Dd, lds, G, bid);
            PH_END
            PH_BEGIN
                pg8::Gemm g{Dd, Wb + WO_MIX2_O, T, D, D}; pg8::StaticOrder S; S.init(T, D, G, bid);
                pg8::EpiF32<true> E{ymix, D, inp(18) + (size_t)i2 * D};
                pg8::gemm_phase<pg8::EpiF32<true>, pg8::StaticOrder, false, true>(lds, g, S, E);
            PH_END
        }
        PH_BEGIN
            norm_rows<true, true, true>(ymix, first ? inp(0) : xout, xout, inp(2) + (size_t)l * D, inp(3) + (size_t)l * D, Hb, gw, NGW, lane);
        PH_END
        PH_BEGIN
            pg8::Gemm g{Hb, Wb + WO_W1, T, FF, D}; pg8::StaticOrder S; S.init(T, FF, G, bid);
            pg8::EpiRelu2 E{Ab, FF};
            pg8::gemm_phase<pg8::EpiRelu2, pg8::StaticOrder, true, true>(lds, g, S, E);
        PH_END
        PH_BEGIN
            pg8::Gemm g{Ab, Wb + WO_W2, T, D, FF}; pg8::StaticOrder S; S.init(T, D, G, bid);
            pg8::EpiF32<false> E{ymlp, D, nullptr};
            pg8::gemm_phase<pg8::EpiF32<false>, pg8::StaticOrder, false, true>(lds, g, S, E);
        PH_END
        PH_BEGIN
            if (l + 1 < DEPTH) convert_layer(wsl, l + 1, lds, gw, NGW, wave, lane);
            if (l + 1 < DEPTH) norm_rows<true, true, true>(ymlp, xout, xout, inp(4) + (size_t)l * D, inp(1) + (size_t)(l + 1) * D, Hb, gw, NGW, lane);
            else norm_rows<true, true, false>(ymlp, xout, xout, inp(4) + (size_t)l * D, nullptr, Hb, gw, NGW, lane);
        PH_END
    }
}

extern "C" void kernel_launch(void* const* d_in, const int* in_sizes, int n_in, void* d_out, int out_size, void* d_ws, size_t ws_size, hipStream_t stream) {
    static int grid = 0;
    if (grid == 0) {
        if (n_in != 21 || out_size != T * D || ws_size < WS_END) { fprintf(stderr, "kernel_launch: unexpected shapes (n_in %d out %d ws %zu)\n", n_in, out_size, ws_size); grid = -1; return; }
        int dev = 0, cus = 0, per_cu = 0;
        hipGetDevice(&dev); hipDeviceGetAttribute(&cus, hipDeviceAttributeMultiprocessorCount, dev);
        if (hipFuncSetAttribute((const void*)trunk_fwd, hipFuncAttributeMaxDynamicSharedMemorySize, LDS_BYTES) != hipSuccess) { fprintf(stderr, "kernel_launch: hipFuncSetAttribute failed\n"); grid = -1; return; }
        if (hipOccupancyMaxActiveBlocksPerMultiprocessor(&per_cu, (const void*)trunk_fwd, NTHR, LDS_BYTES) != hipSuccess || per_cu < 1) { fprintf(stderr, "kernel_launch: occupancy query failed (%d)\n", per_cu); (void)hipGetLastError(); per_cu = 1; }
        grid = cus * per_cu; if (grid > 256) grid = 256;
    }
    if (grid < 0) return;
    Args a{};
    for (int i = 0; i < 21; ++i) a.in[i] = (const float*)d_in[i];
    a.out = (float*)d_out; a.ws = (unsigned char*)d_ws; a.ph_lo = 0; a.ph_hi = 33;
    if (hipMemsetAsync((char*)d_ws + WS_BAR, 0, 16384, stream) != hipSuccess) { fprintf(stderr, "kernel_launch: memset failed\n"); return; }
    void* args[] = {&a};
    hipError_t e = hipLaunchCooperativeKernel((const void*)trunk_fwd, dim3(grid), dim3(NTHR), args, LDS_BYTES, stream);
    if (e != hipSuccess) fprintf(stderr, "cooperative launch failed: %s (grid %d)\n", hipGetErrorString(e), grid);
}
```

```cpp
#include <hip/hip_runtime.h>
#include <cstdio>
#include <cstdint>
namespace pg8 {
#define PG8_LAS __attribute__((address_space(3)))
typedef unsigned short bf16_t;
typedef short bf16x8 __attribute__((ext_vector_type(8)));
typedef float f32x4 __attribute__((ext_vector_type(4)));
typedef unsigned u32x4 __attribute__((ext_vector_type(4)));
constexpr int BM = 256, BK = 64, HALF = 128, HTB = HALF * BK * 2  , STAGE_BYTES = 8 * HTB, NXCD = 8, WGM = 8;

__host__ __device__ __forceinline__ int lds_byte(int r, int c) { const int st = (r >> 4) * 2 + (c >> 5), rr = r & 15, cc = c & 31, ob = rr * 64 + cc * 2; return st * 1024 + (ob ^ (((ob >> 9) & 1) << 5)); }
__host__ __device__ __forceinline__ void stage_rc(int b, int& R, int& C) { const int st = b / 1024, sb = b % 1024, swz = sb ^ (((sb >> 9) & 1) << 5); R = (st >> 1) * 16 + swz / 64; C = (st & 1) * 32 + (swz % 64) / 2; }
__host__ __device__ __forceinline__ int perm32(int rho) { const int n = rho >> 4, i = rho & 15; return 8 * (i >> 2) + 4 * n + (i & 3); }

struct Unit { int pm, pn; };
struct Gemm { const bf16_t* A; const bf16_t* Bt; int M, N, K; };

struct StaticOrder {
    int nM, nN, nwg, G, c;
    __host__ __device__ void init(int M, int N, int G_, int c_) { nM = M / BM; nN = N / BM; nwg = nM * nN; G = G_; c = c_; }
    __host__ __device__ bool next(int i, Unit& u) const {
        const long L = (long)i * G + c; if (L >= nwg) return false;
        int wgid = (int)L; { const int q = nwg / NXCD, r = nwg % NXCD, xcd = wgid % NXCD, off = wgid / NXCD; wgid = (xcd < r ? xcd * (q + 1) : r * (q + 1) + (xcd - r) * q) + off; }
        const int nig = WGM * nN, gid = wgid / nig, fm = gid * WGM, gsz = (nM - fm) < WGM ? (nM - fm) : WGM;
        u.pm = fm + ((wgid % nig) % gsz); u.pn = (wgid % nig) / gsz; return true;
    }
    __device__ __forceinline__ void a_ready(const Unit&) const {}
    __device__ __forceinline__ void done(const Unit&) const {}
};
__device__ __forceinline__ unsigned cvt_pk_bf16(float lo, float hi) { unsigned r; asm volatile("v_cvt_pk_bf16_f32 %0, %1, %2" : "=v"(r) : "v"(lo), "v"(hi)); return r; }
typedef float f32x2 __attribute__((ext_vector_type(2)));
}
namespace pg8 {
struct EpiZ {
    static constexpr bool PERM = true, AFTER_DRAIN = false;
    bf16_t* Z; float* GK;
    __device__ __forceinline__ void operator()(const f32x4 (&acc)[2][2][4][2], const Unit& u, int wr, int wc, int fr, int fq) const {
        const int row0 = u.pm * BM + wr * 64 + fr;
        if (u.pn < 18) {
            const int col0 = u.pn * BM + wc * 32 + 8 * fq;
#pragma unroll
            for (int ai = 0; ai < 2; ++ai)
#pragma unroll
                for (int m = 0; m < 4; ++m) { bf16_t* rowp = Z + (size_t)(row0 + ai * HALF + m * 16) * 4608 + col0;
#pragma unroll
                    for (int bj = 0; bj < 2; ++bj) { const f32x4 v0 = acc[ai][bj][m][0], v1 = acc[ai][bj][m][1];
                        u32x4 w; w.x = cvt_pk_bf16(v0[0], v0[1]); w.y = cvt_pk_bf16(v0[2], v0[3]); w.z = cvt_pk_bf16(v1[0], v1[1]); w.w = cvt_pk_bf16(v1[2], v1[3]);
                        *(u32x4*)(rowp + bj * HALF) = w; } }
        } else if (wc == 0 && fq < 2) {
#pragma unroll
            for (int ai = 0; ai < 2; ++ai)
#pragma unroll
                for (int m = 0; m < 4; ++m) { float* rp = GK + (size_t)(row0 + ai * HALF + m * 16) * 16 + 8 * fq;
                    *(f32x4*)rp = acc[ai][0][m][0]; *(f32x4*)(rp + 4) = acc[ai][0][m][1]; }
        }
    }
};
template <bool HAS_BIAS> struct EpiF32 {
    static constexpr bool PERM = false, AFTER_DRAIN = false;
    float* C; int ldc; const float* bias;
    __device__ __forceinline__ void operator()(const f32x4 (&acc)[2][2][4][2], const Unit& u, int wr, int wc, int fr, int fq) const {
        const int row0 = u.pm * BM + wr * 64 + fr, col0 = u.pn * BM + wc * 32 + 4 * fq;
        f32x4 bv[2][2];
#pragma unroll
        for (int bj = 0; bj < 2; ++bj)
#pragma unroll
            for (int n = 0; n < 2; ++n) bv[bj][n] = HAS_BIAS ? *(const f32x4*)(bias + col0 + bj * HALF + n * 16) : (f32x4){0.f, 0.f, 0.f, 0.f};
#pragma unroll
        for (int ai = 0; ai < 2; ++ai)
#pragma unroll
            for (int m = 0; m < 4; ++m) { float* rowp = C + (size_t)(row0 + ai * HALF + m * 16) * ldc + col0;
#pragma unroll
                for (int bj = 0; bj < 2; ++bj)
#pragma unroll
                    for (int n = 0; n < 2; ++n) *(f32x4*)(rowp + bj * HALF + n * 16) = acc[ai][bj][m][n] + bv[bj][n]; }
    }
};
struct EpiRelu2 {
    static constexpr bool PERM = true, AFTER_DRAIN = false;
    bf16_t* O; int ldc;
    __device__ __forceinline__ void operator()(const f32x4 (&acc)[2][2][4][2], const Unit& u, int wr, int wc, int fr, int fq) const {
        const int row0 = u.pm * BM + wr * 64 + fr, col0 = u.pn * BM + wc * 32 + 8 * fq;
#pragma unroll
        for (int ai = 0; ai < 2; ++ai)
#pragma unroll
            for (int m = 0; m < 4; ++m) { bf16_t* rowp = O + (size_t)(row0 + ai * HALF + m * 16) * ldc + col0;
#pragma unroll
                for (int bj = 0; bj < 2; ++bj) { f32x4 v0 = acc[ai][bj][m][0], v1 = acc[ai][bj][m][1];
#pragma unroll
                    for (int j = 0; j < 4; ++j) { const float a = fmaxf(v0[j], 0.f), b = fmaxf(v1[j], 0.f); v0[j] = a * a; v1[j] = b * b; }
                    u32x4 w; w.x = cvt_pk_bf16(v0[0], v0[1]); w.y = cvt_pk_bf16(v0[2], v0[3]); w.z = cvt_pk_bf16(v1[0], v1[1]); w.w = cvt_pk_bf16(v1[2], v1[3]);
                    *(u32x4*)(rowp + bj * HALF) = w; } }
    }
};
struct EpiGLU {
    static constexpr bool PERM = true, AFTER_DRAIN = false;
    bf16_t* U; const float* bias;
    __device__ __forceinline__ void operator()(const f32x4 (&acc)[2][2][4][2], const Unit& u, int wr, int wc, int fr, int fq) const {
        const int row0 = u.pm * BM + wr * 64 + fr, col0 = u.pn * HALF + wc * 32 + 8 * fq;
        f32x4 b1[2], b2[2];
#pragma unroll
        for (int n = 0; n < 2; ++n) { b1[n] = *(const f32x4*)(bias + col0 + 4 * n); b2[n] = *(const f32x4*)(bias + 1024 + col0 + 4 * n); }
#pragma unroll
        for (int ai = 0; ai < 2; ++ai)
#pragma unroll
            for (int m = 0; m < 4; ++m) { bf16_t* rowp = U + (size_t)(row0 + ai * HALF + m * 16) * 1024 + col0;
                f32x4 o[2];
#pragma unroll
                for (int n = 0; n < 2; ++n) { const f32x4 a = acc[ai][0][m][n] + b1[n], g = acc[ai][1][m][n] + b2[n];
#pragma unroll
                    for (int j = 0; j < 4; ++j) o[n][j] = a[j] * __builtin_amdgcn_rcpf(1.f + __expf(-g[j])); }
                u32x4 w; w.x = cvt_pk_bf16(o[0][0], o[0][1]); w.y = cvt_pk_bf16(o[0][2], o[0][3]); w.z = cvt_pk_bf16(o[1][0], o[1][1]); w.w = cvt_pk_bf16(o[1][2], o[1][3]);
                *(u32x4*)rowp = w; }
    }
};

struct RmsStats {
    float* xbuf;
    unsigned* cnt;
    __device__ __forceinline__ void run(const f32x4 (&v)[2][2][4][2], const Unit& u, int wr, int wc, int fr, int fq, PG8_LAS unsigned char* lds, int wid, int lane) const {
        PG8_LAS float* P = (PG8_LAS float*)lds;
        PG8_LAS float* S = (PG8_LAS float*)(lds + 4096);
#pragma unroll
        for (int ai = 0; ai < 2; ++ai)
#pragma unroll
            for (int m = 0; m < 4; ++m) {
                float s = 0.f;
#pragma unroll
                for (int bj = 0; bj < 2; ++bj)
#pragma unroll
                    for (int n = 0; n < 2; ++n) { const f32x4 x = v[ai][bj][m][n]; s += (x[0] * x[0] + x[1] * x[1]) + (x[2] * x[2] + x[3] * x[3]); }
                s += __shfl_xor(s, 16); s += __shfl_xor(s, 32);
                if (fq == 0) P[(ai * HALF + wr * 64 + m * 16 + fr) * 4 + wc] = s;
            }
        asm volatile("s_waitcnt lgkmcnt(0)" ::: "memory"); __builtin_amdgcn_s_barrier(); asm volatile("" ::: "memory");
        const int row = wid * 32 + (lane & 31);
        if (lane < 32) { const f32x4 p = *(const PG8_LAS f32x4*)(P + row * 4); const float t = (p[0] + p[1]) + (p[2] + p[3]);
            __hip_atomic_store(xbuf + ((size_t)(u.pm * BM + row) * 4 + u.pn), t, __ATOMIC_RELAXED, __HIP_MEMORY_SCOPE_AGENT); }
        asm volatile("s_waitcnt vmcnt(0)" ::: "memory");
        if (lane == 0) __hip_atomic_fetch_add(cnt + 64 * u.pm, 1u, __ATOMIC_RELAXED, __HIP_MEMORY_SCOPE_AGENT);
        if (wid == 0) {
            unsigned sp = 0u;
            while ((unsigned)__builtin_amdgcn_readfirstlane(__hip_atomic_load(cnt + 64 * u.pm, __ATOMIC_RELAXED, __HIP_MEMORY_SCOPE_AGENT)) < 32u) { __builtin_amdgcn_s_sleep(2); if (++sp > (1u << 22)) break; }
            __builtin_amdgcn_fence(__ATOMIC_ACQUIRE, "agent");
        }
        asm volatile("s_waitcnt vmcnt(0) lgkmcnt(0)" ::: "memory"); __builtin_amdgcn_s_barrier(); asm volatile("" ::: "memory");
        if (lane < 32) { const float* slot = xbuf + (size_t)(u.pm * BM + row) * 4; float t = 0.f;
#pragma unroll
            for (int i = 0; i < 4; ++i) t += __hip_atomic_load(slot + i, __ATOMIC_RELAXED, __HIP_MEMORY_SCOPE_AGENT);
            S[row] = 1.0f / sqrtf(t * (1.0f / 1024.0f) + 1e-6f); }
        asm volatile("s_waitcnt lgkmcnt(0)" ::: "memory"); __builtin_amdgcn_s_barrier(); asm volatile("" ::: "memory");
    }
};
template <bool HAS_BIAS, bool HAS_PRE> struct EpiNorm {
    static constexpr bool PERM = false, AFTER_DRAIN = true;
    const float* xs; float* xd; bf16_t* H; const float* bias; const float* gpost; const float* gpre; RmsStats st1, st2;
    __device__ __forceinline__ void fused(f32x4 (&acc)[2][2][4][2], const Unit& u, int wr, int wc, int fr, int fq, PG8_LAS unsigned char* lds, int wid, int lane) const {
        typedef unsigned u32x2v __attribute__((ext_vector_type(2)));
        const PG8_LAS float* S = (const PG8_LAS float*)(lds + 4096);
        const int col0 = u.pn * BM + wc * 32 + 4 * fq;
        if (HAS_BIAS) {
#pragma unroll
            for (int bj = 0; bj < 2; ++bj)
#pragma unroll
                for (int n = 0; n < 2; ++n) { const f32x4 bv = *(const f32x4*)(bias + col0 + bj * HALF + n * 16);
#pragma unroll
                    for (int ai = 0; ai < 2; ++ai)
#pragma unroll
                        for (int m = 0; m < 4; ++m) acc[ai][bj][m][n] += bv; }
        }
        st1.run(acc, u, wr, wc, fr, fq, lds, wid, lane);
#pragma unroll
        for (int ai = 0; ai < 2; ++ai)
#pragma unroll
            for (int m = 0; m < 4; ++m) { const int r = ai * HALF + wr * 64 + m * 16 + fr; const float rs = S[r]; const size_t off = (size_t)(u.pm * BM + r) * 1024 + col0;
#pragma unroll
                for (int bj = 0; bj < 2; ++bj)
#pragma unroll
                    for (int n = 0; n < 2; ++n) { const f32x4 xv = *(const f32x4*)(xs + off + bj * HALF + n * 16); const f32x4 gv = *(const f32x4*)(gpost + col0 + bj * HALF + n * 16);
                        const f32x4 o = xv + acc[ai][bj][m][n] * rs * gv; acc[ai][bj][m][n] = o; *(f32x4*)(xd + off + bj * HALF + n * 16) = o; }
                asm volatile("" : "+v"(acc[ai][0][m][0]), "+v"(acc[ai][0][m][1]), "+v"(acc[ai][1][m][0]), "+v"(acc[ai][1][m][1]));
                if (m & 1) asm volatile("" ::: "memory"); }
        if (HAS_PRE) {
            st2.run(acc, u, wr, wc, fr, fq, lds, wid, lane);
#pragma unroll
            for (int ai = 0; ai < 2; ++ai)
#pragma unroll
                for (int m = 0; m < 4; ++m) { const int r = ai * HALF + wr * 64 + m * 16 + fr; const float rs = S[r]; const size_t off = (size_t)(u.pm * BM + r) * 1024 + col0;
#pragma unroll
                    for (int bj = 0; bj < 2; ++bj)
#pragma unroll
                        for (int n = 0; n < 2; ++n) { const f32x4 gv = *(const f32x4*)(gpre + col0 + bj * HALF + n * 16); const f32x4 o = acc[ai][bj][m][n] * rs * gv;
                            u32x2v w; w.x = cvt_pk_bf16(o[0], o[1]); w.y = cvt_pk_bf16(o[2], o[3]); *(u32x2v*)(H + off + bj * HALF + n * 16) = w; }
                    asm volatile("" ::: "memory"); }
        }
    }
};
}
namespace pg8 {
template <class Epi, class Sched, bool ALIGN_EPI = false, bool SP2 = false>
__device__ __forceinline__ void gemm_phase(PG8_LAS unsigned char* lds, const Gemm g, const Sched& S, const Epi& E) {
    int tid = threadIdx.x; asm volatile("" : "+v"(tid)); const int wid = __builtin_amdgcn_readfirstlane(tid >> 6), lane = tid & 63, wr = wid >> 2, wc = wid & 3, fr = lane & 15, fq = lane >> 4;
    const int K = g.K, nt = K / BK;
    unsigned voffA[2], voffB[2];
#pragma unroll
    for (int i = 0; i < 2; ++i) { int R, C; stage_rc(tid * 16 + i * 8192, R, C); const int Rb = Epi::PERM ? ((R & ~31) + perm32(R & 31)) : R;
        voffA[i] = (unsigned)(R * K + C) * 2u; voffB[i] = (unsigned)(Rb * K + C) * 2u; }
    const size_t kstep = (size_t)(BK * 2);
    const size_t hstep = (size_t)HALF * K * 2;
    const size_t tstep = 2 * hstep;
    const unsigned ldsw = (unsigned)wid * 1024u;
    const int aoff = lds_byte(wr * 64 + fr, fq * 8), boff = lds_byte(wc * 32 + fr, fq * 8);
#define PG8_SA(b, h) (((b) * 2 + (h)) * HTB)
#define PG8_SB(b, h) ((4 + (b) * 2 + (h)) * HTB)
#define PG8_STAGE(bufoff, gbase, voff) do { _Pragma("unroll") for (int _i = 0; _i < 2; ++_i) \
        __builtin_amdgcn_global_load_lds((const unsigned*)((const char*)(gbase) + (voff)[_i]), (PG8_LAS unsigned*)(lds + (bufoff) + ldsw + _i * 8192), 16, 0, 0); } while (0)
#define PG8_LDA(dst, b, h) do { _Pragma("unroll") for (int m = 0; m < 4; ++m) _Pragma("unroll") for (int k = 0; k < 2; ++k) dst[m][k] = *(const PG8_LAS bf16x8*)(lds + PG8_SA(b, h) + aoff + m * 2048 + k * 1024); } while (0)
#define PG8_LDB(dst, b, h) do { _Pragma("unroll") for (int n = 0; n < 2; ++n) _Pragma("unroll") for (int k = 0; k < 2; ++k) dst[n][k] = *(const PG8_LAS bf16x8*)(lds + PG8_SB(b, h) + boff + n * 2048 + k * 1024); } while (0)
#define PG8_MMA(ai, bj, At, Bt) do { __builtin_amdgcn_s_setprio(1); _Pragma("unroll") for (int m = 0; m < 4; ++m) _Pragma("unroll") for (int n = 0; n < 2; ++n) _Pragma("unroll") for (int k = 0; k < 2; ++k) \
        acc[ai][bj][m][n] = __builtin_amdgcn_mfma_f32_16x16x32_bf16(Bt[n][k], At[m][k], acc[ai][bj][m][n], 0, 0, 0); __builtin_amdgcn_s_setprio(0); } while (0)
#define PG8_WAIT_V(n) asm volatile("s_waitcnt vmcnt(" #n ")" ::: "memory")
#define PG8_WAIT_L(n) asm volatile("s_waitcnt lgkmcnt(" #n ")" ::: "memory")
#define PG8_BAR __builtin_amdgcn_s_barrier()
#define PG8_SCHED __builtin_amdgcn_sched_barrier(0)
    Unit cur, nxt; int ui = 0;
    if (!S.next(0, cur)) return;
    f32x4 acc[2][2][4][2];
#pragma unroll
    for (int a = 0; a < 2; ++a)
#pragma unroll
        for (int b = 0; b < 2; ++b)
#pragma unroll
            for (int m = 0; m < 4; ++m)
#pragma unroll
                for (int n = 0; n < 2; ++n) acc[a][b][m][n] = (f32x4){0.f, 0.f, 0.f, 0.f};
    bf16x8 At[4][2], B0[2][2], B1[2][2];
    const char* cA = (const char*)g.A + (size_t)cur.pm * tstep; const char* cB = (const char*)g.Bt + (size_t)cur.pn * tstep;
    S.a_ready(cur);
    if constexpr (SP2) {
        PG8_STAGE(PG8_SB(0, 0), cB, voffB); PG8_STAGE(PG8_SB(0, 1), cB + hstep, voffB); PG8_STAGE(PG8_SA(0, 0), cA, voffA); PG8_STAGE(PG8_SA(0, 1), cA + hstep, voffA);
        if (wr == 1) PG8_BAR;
        PG8_WAIT_V(2); PG8_BAR;
        PG8_STAGE(PG8_SB(1, 0), cB + kstep, voffB); PG8_STAGE(PG8_SA(1, 0), cA + kstep, voffA); PG8_STAGE(PG8_SB(1, 1), cB + hstep + kstep, voffB);
        PG8_WAIT_V(6); PG8_BAR;
    } else {
        PG8_STAGE(PG8_SB(0, 0), cB, voffB); PG8_STAGE(PG8_SA(0, 0), cA, voffA); PG8_STAGE(PG8_SB(0, 1), cB + hstep, voffB); PG8_STAGE(PG8_SA(0, 1), cA + hstep, voffA);
        if (wr == 1) PG8_BAR;
        PG8_WAIT_V(4); PG8_BAR;
        PG8_STAGE(PG8_SB(1, 0), cB + kstep, voffB); PG8_STAGE(PG8_SA(1, 0), cA + kstep, voffA); PG8_STAGE(PG8_SB(1, 1), cB + hstep + kstep, voffB);
        PG8_WAIT_V(6); PG8_BAR;
    }
    for (;;) {
        const bool has_next = S.next(ui + 1, nxt);
        const char* nA = has_next ? (const char*)g.A + (size_t)nxt.pm * tstep : cA; const char* nB = has_next ? (const char*)g.Bt + (size_t)nxt.pn * tstep : cB;
        for (int t = 0; t < nt; t += 2) {
            const bool last = (t == nt - 2);
            const char* a1 = cA + (size_t)(t + 1) * kstep;
            const char* a2 = last ? nA : cA + (size_t)(t + 2) * kstep; const char* b2 = last ? nB : cB + (size_t)(t + 2) * kstep;
            const char* a3 = a2 + kstep; const char* b3 = b2 + kstep;
            if (last && has_next) S.a_ready(nxt);
            if constexpr (SP2) {
            PG8_LDB(B0, 0, 0); PG8_LDB(B1, 0, 1); PG8_SCHED; PG8_LDA(At, 0, 0); PG8_STAGE(PG8_SA(1, 1), a1 + hstep, voffA);
            PG8_WAIT_V(8); PG8_WAIT_L(0); PG8_BAR; PG8_MMA(0, 0, At, B0); PG8_MMA(0, 1, At, B1); PG8_BAR; PG8_SCHED;
            PG8_LDA(At, 0, 1); PG8_STAGE(PG8_SB(0, 0), b2, voffB); PG8_STAGE(PG8_SB(0, 1), b2 + hstep, voffB); PG8_STAGE(PG8_SA(0, 0), a2, voffA);
            PG8_WAIT_V(8); PG8_WAIT_L(0); PG8_BAR; PG8_MMA(1, 0, At, B0); PG8_MMA(1, 1, At, B1); PG8_BAR; PG8_SCHED;
            PG8_LDB(B0, 1, 0); PG8_LDB(B1, 1, 1); PG8_SCHED; PG8_LDA(At, 1, 0); PG8_STAGE(PG8_SA(0, 1), a2 + hstep, voffA);
            PG8_WAIT_V(8); PG8_WAIT_L(0); PG8_BAR; PG8_MMA(0, 0, At, B0); PG8_MMA(0, 1, At, B1); PG8_BAR; PG8_SCHED;
            PG8_LDA(At, 1, 1); PG8_STAGE(PG8_SB(1, 0), b3, voffB); PG8_STAGE(PG8_SB(1, 1), b3 + hstep, voffB); PG8_STAGE(PG8_SA(1, 0), a3, voffA);
            PG8_WAIT_V(8); PG8_WAIT_L(0); PG8_BAR; PG8_MMA(1, 0, At, B0); PG8_MMA(1, 1, At, B1); PG8_BAR; PG8_SCHED;
            } else {
            PG8_LDB(B0, 0, 0); PG8_SCHED; PG8_LDA(At, 0, 0); PG8_STAGE(PG8_SA(1, 1), a1 + hstep, voffA);
            PG8_WAIT_L(8); PG8_BAR; PG8_WAIT_L(0); PG8_MMA(0, 0, At, B0); PG8_BAR; PG8_SCHED;
            PG8_LDB(B1, 0, 1); PG8_STAGE(PG8_SB(0, 0), b2, voffB);
            PG8_BAR; PG8_WAIT_L(0); PG8_MMA(0, 1, At, B1); PG8_BAR;
            PG8_LDA(At, 0, 1); PG8_STAGE(PG8_SA(0, 0), a2, voffA);
            PG8_BAR; PG8_WAIT_L(0); PG8_MMA(1, 0, At, B0); PG8_BAR; PG8_SCHED;
            PG8_STAGE(PG8_SB(0, 1), b2 + hstep, voffB);
            PG8_WAIT_V(6); PG8_BAR; PG8_MMA(1, 1, At, B1); PG8_BAR;
            PG8_LDB(B0, 1, 0); PG8_SCHED; PG8_LDA(At, 1, 0); PG8_STAGE(PG8_SA(0, 1), a2 + hstep, voffA);
            PG8_WAIT_L(8); PG8_BAR; PG8_WAIT_L(0); PG8_MMA(0, 0, At, B0); PG8_BAR; PG8_SCHED;
            PG8_LDB(B1, 1, 1); PG8_STAGE(PG8_SB(1, 0), b3, voffB);
            PG8_BAR; PG8_WAIT_L(0); PG8_MMA(0, 1, At, B1); PG8_BAR;
            PG8_LDA(At, 1, 1); PG8_STAGE(PG8_SA(1, 0), a3, voffA);
            PG8_BAR; PG8_WAIT_L(0); PG8_MMA(1, 0, At, B0); PG8_BAR; PG8_SCHED;
            PG8_STAGE(PG8_SB(1, 1), b3 + hstep, voffB);
            PG8_WAIT_V(6); PG8_BAR; PG8_MMA(1, 1, At, B1); PG8_BAR;
            }
        }
        if constexpr (ALIGN_EPI) { if (wr == 0) PG8_BAR; }
        if constexpr (!Epi::AFTER_DRAIN) { E(acc, cur, wr, wc, fr, fq); S.done(cur); }
        if (!has_next) break;
#pragma unroll
        for (int a = 0; a < 2; ++a)
#pragma unroll
            for (int b = 0; b < 2; ++b)
#pragma unroll
                for (int m = 0; m < 4; ++m)
#pragma unroll
                    for (int n = 0; n < 2; ++n) acc[a][b][m][n] = (f32x4){0.f, 0.f, 0.f, 0.f};
        cur = nxt; cA = nA; cB = nB; ++ui;
        if constexpr (ALIGN_EPI) { if (wr == 1) PG8_BAR; }
    }
    PG8_WAIT_V(0);
    if constexpr (!ALIGN_EPI) { if (wr == 0) PG8_BAR; }
    PG8_BAR;
    if constexpr (Epi::AFTER_DRAIN) { E.fused(acc, cur, wr, wc, fr, fq, lds, wid, lane); S.done(cur); }
#undef PG8_SA
#undef PG8_SB
#undef PG8_STAGE
#undef PG8_LDA
#undef PG8_LDB
#undef PG8_MMA
#undef PG8_WAIT_V
#undef PG8_WAIT_L
#undef PG8_BAR
#undef PG8_SCHED
}
}
#include <hip/hip_cooperative_groups.h>
namespace cg = cooperative_groups;
#define LAS __attribute__((address_space(3)))
typedef unsigned short bf16;
typedef float f32x4 __attribute__((ext_vector_type(4)));
typedef float f32x2 __attribute__((ext_vector_type(2)));
typedef short bf16x8 __attribute__((ext_vector_type(8)));
typedef unsigned u32x4 __attribute__((ext_vector_type(4)));
typedef unsigned u32x2 __attribute__((ext_vector_type(2)));

constexpr int T = 16384, D = 1024, DEPTH = 4, FF = 4096;
constexpr int ZLD = 4608, ZN = 4864, ABIN = 4624, MIXLD = 1536;
constexpr int ZSX = 0, ZSB = 512, ZSC = 1024, ZQ = 1536, ZK = 2048, ZV = 2560, ZG = 3584;
constexpr float EPS = 1e-6f;
constexpr int NWAVES = 8, NTHR = 512;
constexpr int LDS_BYTES = 147456;
constexpr size_t MiB = 1u << 20;
constexpr size_t WS_DEC = 0;
constexpr size_t WS_BAR = 128 * 1024;
constexpr size_t WS_EBL = 256 * 1024;
constexpr size_t WS_CNT = 768 * 1024;
constexpr size_t WS_X1 = 30 * MiB - 512 * 1024, WS_X2 = 30 * MiB - 256 * 1024;
constexpr size_t WS_W = 1 * MiB;
constexpr size_t WS_H = 30 * MiB;
constexpr size_t WS_BIG = 62 * MiB;
constexpr size_t WS_GK = 254 * MiB;
constexpr size_t WS_END = 255 * MiB;
constexpr size_t WO_MIX1 = 0;
constexpr size_t WO_MIX2_E = (size_t)ZN * D;
constexpr size_t WO_MIX2_O = (size_t)2048 * D;
constexpr size_t WO_W1 = (size_t)ZN * D + (size_t)D * MIXLD;
constexpr size_t WO_W2 = WO_W1 + (size_t)FF * D;
static_assert(WS_W + (WO_W2 + (size_t)FF * D) * 2 <= WS_X1, "weights fit");

__device__ __forceinline__ int tid_l() { int t = threadIdx.x; asm volatile("" : "+v"(t)); return t; }
__device__ __forceinline__ float bf2f(unsigned b) { return __uint_as_float(b << 16); }
__device__ __forceinline__ unsigned pkbf(float lo, float hi) { return pg8::cvt_pk_bf16(lo, hi); }
__device__ __forceinline__ float wave_sum(float v) {
#pragma unroll
    for (int o = 1; o < 64; o <<= 1) v += __shfl_xor(v, o);
    return v;
}

template <int MODE>
__device__ __forceinline__ void transpose_item(const float* W, int K, int N, bf16* WT, LAS float* scr, int item, int lane) {
    const int nblk = (N + 31) / 32, kb = item / nblk, nb = item % nblk, k0 = 64 * kb, n0 = 32 * nb;
    const bool ok = (n0 + (lane & 31)) < N;
#pragma unroll 8
    for (int i = 0; i < 32; ++i) { const int kk = 2 * i + (lane >> 5); scr[kk * 33 + (lane & 31)] = ok ? W[(size_t)(k0 + kk) * N + n0 + (lane & 31)] : 0.f; }
    asm volatile("s_waitcnt lgkmcnt(0)" ::: "memory");
    int d0 = n0;
    if (MODE == 1) { const int half = n0 >> 10, c0 = n0 & 1023; d0 = ((c0 >> 7) << 8) + (half << 7) + (c0 & 127); }
    const int c = lane & 7;
#pragma unroll
    for (int j = 0; j < 4; ++j) { const int n = (lane >> 3) + 8 * j; const LAS float* s = scr + (8 * c) * 33 + n;
        u32x4 o; o.x = pkbf(s[0 * 33], s[1 * 33]); o.y = pkbf(s[2 * 33], s[3 * 33]); o.z = pkbf(s[4 * 33], s[5 * 33]); o.w = pkbf(s[6 * 33], s[7 * 33]);
        *(u32x4*)(WT + (size_t)(d0 + n) * K + k0 + 8 * c) = o; }
    asm volatile("s_waitcnt lgkmcnt(0)" ::: "memory");
}

struct Args { const float* in[21]; float* out; unsigned char* ws; int ph_lo, ph_hi; };
__device__ __forceinline__ const float* inp(int i) { const __attribute__((address_space(4))) char* kp = (const __attribute__((address_space(4))) char*)__builtin_amdgcn_kernarg_segment_ptr(); asm volatile("" : "+s"(kp)); return *(const float* const __attribute__((address_space(4)))*)(kp + 8 * i); }

template <int PART>
__device__ __forceinline__ void convert_layer(unsigned char* wsp, int l, LAS unsigned char* lds, int gw, int NGW, int wave, int lane) {
    LAS float* scr = (LAS float*)(lds + wave * 8704);
    bf16* Wb_ = (bf16*)(wsp + WS_W);
    const int i2 = l >> 1;
    if (PART == 1) {
        const float* w1 = inp(19) + (size_t)l * D * FF; const float* w2 = inp(20) + (size_t)l * FF * D;
        constexpr int I_W1 = (D / 64) * (FF / 32), I_W2 = (FF / 64) * (D / 32);
        for (int it = gw; it < I_W1 + I_W2; it += NGW) {
            if (it < I_W1) transpose_item<0>(w1, D, FF, Wb_ + WO_W1, scr, it, lane);
            else transpose_item<0>(w2, FF, D, Wb_ + WO_W2, scr, it - I_W1, lane); }
    } else if ((l & 1) == 0) {
        const float* win = inp(5) + (size_t)i2 * D * ABIN; const float* wout = inp(10) + (size_t)i2 * MIXLD * D;
        constexpr int I_IN = (D / 64) * ((ABIN + 31) / 32), I_OUT = (MIXLD / 64) * (D / 32);
        for (int it = gw; it < I_IN + I_OUT; it += NGW) {
            if (it < I_IN) transpose_item<0>(win, D, ABIN, Wb_ + WO_MIX1, scr, it, lane);
            else transpose_item<0>(wout, MIXLD, D, Wb_ + WO_MIX2_E, scr, it - I_IN, lane); }
        u32x4* pz = (u32x4*)(Wb_ + WO_MIX1 + (size_t)4640 * D); const int nz = (ZN - 4640) * D / 8;
        for (int i = gw * 64 + lane; i < nz; i += NGW * 64) pz[i] = (u32x4){0u, 0u, 0u, 0u};
    } else {
        const float* pw1 = inp(11) + (size_t)i2 * D * 2048; const float* pw2 = inp(17) + (size_t)i2 * D * D;
        constexpr int I_P1 = (D / 64) * (2048 / 32), I_P2 = (D / 64) * (D / 32);
        for (int it = gw; it < I_P1 + I_P2; it += NGW) {
            if (it < I_P1) transpose_item<1>(pw1, D, 2048, Wb_ + WO_MIX1, scr, it, lane);
            else transpose_item<0>(pw2, D, D, Wb_ + WO_MIX2_O, scr, it - I_P1, lane); }
    }
}

template <bool HAS_Y, bool HAS_XD, bool HAS_PRE>
__device__ __forceinline__ void norm_rows(const float* y, const float* xs, float* xd, const float* gpost, const float* gpre, bf16* h, int gw, int NGW, int lane) {
    for (int row = gw; row < T; row += NGW) {
        const f32x4* xr = (const f32x4*)(xs + (size_t)row * D) + lane;
        f32x4 xv[4];
#pragma unroll
        for (int j = 0; j < 4; ++j) xv[j] = xr[64 * j];
        if (HAS_Y) {
            const f32x4* yr = (const f32x4*)(y + (size_t)row * D) + lane; f32x4 yv[4]; float s = 0.f;
#pragma unroll
            for (int j = 0; j < 4; ++j) { yv[j] = yr[64 * j]; s += (yv[j].x * yv[j].x + yv[j].y * yv[j].y) + (yv[j].z * yv[j].z + yv[j].w * yv[j].w); }
            const float r = 1.f / sqrtf(wave_sum(s) * (1.f / D) + EPS);
#pragma unroll
            for (int j = 0; j < 4; ++j) { const f32x4 g = ((const f32x4*)gpost)[64 * j + lane]; xv[j] = xv[j] + yv[j] * r * g; }
        }
        if (HAS_XD) { f32x4* xo = (f32x4*)(xd + (size_t)row * D) + lane;
#pragma unroll
            for (int j = 0; j < 4; ++j) xo[64 * j] = xv[j]; }
        if (HAS_PRE) {
            float s = 0.f;
#pragma unroll
            for (int j = 0; j < 4; ++j) s += (xv[j].x * xv[j].x + xv[j].y * xv[j].y) + (xv[j].z * xv[j].z + xv[j].w * xv[j].w);
            const float r = 1.f / sqrtf(wave_sum(s) * (1.f / D) + EPS);
            u32x2* ho = (u32x2*)(h + (size_t)row * D) + lane;
#pragma unroll
            for (int j = 0; j < 4; ++j) { const f32x4 g = ((const f32x4*)gpre)[64 * j + lane]; const f32x4 v = xv[j] * r * g; u32x2 w; w.x = pkbf(v.x, v.y); w.y = pkbf(v.z, v.w); ho[64 * j] = w; }
        }
    }
}

constexpr int G_QD = 0, G_KD = 17408, G_KLT = 34816, G_VT = 53248, G_P = 90112, G_SEG = 99328, G_EBL = 101376, G_SS = 101888, G_GT = 103936;
#define MFMA16(a, b, c) __builtin_amdgcn_mfma_f32_16x16x32_bf16(a, b, c, 0, 0, 0)
template <bool OUT>
__device__ __forceinline__ void gla_unit(int unit, bf16* z, const float* gklr, const float* wgk2, const float* bgk2, const float* normg, float* E, float* DEC, float* EBLG, bf16* mix, LAS unsigned char* lds) {
    const int tid = tid_l(), lane = tid & 63, w = __builtin_amdgcn_readfirstlane(tid >> 6), r = lane & 15, q = lane >> 4;
    const int g = unit >> 2, h = unit & 3;
    const int seg = w >> 1, k = (w & 1) * 64 + lane, hk = h * 128 + k;
    const int vv = tid & 255, jh = w >> 2;
    f32x4 S[8][2];
    float* Eu = E + (size_t)unit * 32768 + (size_t)w * 4096 + lane;
    if (OUT) {
#pragma unroll
        for (int mt = 0; mt < 8; ++mt)
#pragma unroll
            for (int nt = 0; nt < 2; ++nt)
#pragma unroll
                for (int i = 0; i < 4; ++i) S[mt][nt][i] = Eu[((mt * 2 + nt) * 4 + i) * 64];
    } else {
#pragma unroll
        for (int mt = 0; mt < 8; ++mt)
#pragma unroll
            for (int nt = 0; nt < 2; ++nt) S[mt][nt] = (f32x4){0.f, 0.f, 0.f, 0.f};
    }
    float bsum = 0.f;
    LAS float* SEG = (LAS float*)(lds + G_SEG); LAS float* EBL = (LAS float*)(lds + G_EBL); LAS float* SSQ = (LAS float*)(lds + G_SS);
    for (int ch = 0; ch < 4; ++ch) {
        const int t0 = g * 256 + ch * 64, cgl = g * 4 + ch;
        if (!OUT) {
            int zofs = 0; asm volatile("" : "+v"(zofs));
            float w2r[16];
#pragma unroll
            for (int i = 0; i < 16; ++i) w2r[i] = wgk2[i * 512 + hk + zofs];
            const float bias = bgk2[hk + zofs];
            float b[16]; float run = 0.f;
#pragma unroll
            for (int jj = 0; jj < 16; ++jj) {
                const f32x4* gp = (const f32x4*)(gklr + (size_t)(t0 + seg * 16 + jj) * 16);
                const f32x4 g0 = gp[0], g1 = gp[1], g2 = gp[2], g3 = gp[3];
                float gv = bias;
                gv += g0.x * w2r[0] + g0.y * w2r[1] + g0.z * w2r[2] + g0.w * w2r[3];
                gv += g1.x * w2r[4] + g1.y * w2r[5] + g1.z * w2r[6] + g1.w * w2r[7];
                gv += g2.x * w2r[8] + g2.y * w2r[9] + g2.z * w2r[10] + g2.w * w2r[11];
                gv += g3.x * w2r[12] + g3.y * w2r[13] + g3.z * w2r[14] + g3.w * w2r[15];
                const float ls = -(fmaxf(-gv, 0.f) + __logf(1.f + __expf(-fabsf(gv)))) * (1.f / 16.f);
                run += ls; b[jj] = run;
            }
            SEG[seg * 128 + k] = run;
            __syncthreads();
            float pre = 0.f, tot = 0.f;
#pragma unroll
            for (int s = 0; s < 4; ++s) { const float v = SEG[s * 128 + k]; tot += v; pre += (s < seg) ? v : 0.f; }
            if (seg == 0) { const float eb = __expf(tot); EBL[k] = eb; EBLG[cgl * 512 + hk] = eb; bsum += tot; }
            unsigned klp[8];
#pragma unroll
            for (int jj = 0; jj < 16; jj += 2) {
                float kl2[2];
#pragma unroll
                for (int e = 0; e < 2; ++e) {
                    bf16* zr = z + (size_t)(t0 + seg * 16 + jj + e) * ZLD; const float bb = b[jj + e] + pre;
                    const float kv = bf2f(zr[ZK + hk]), qv = bf2f(zr[ZQ + hk]);
                    kl2[e] = kv * __expf(tot - bb);
                    zr[ZQ + hk] = (bf16)(pkbf(qv * 0.08838834764831845f * __expf(bb), 0.f) & 0xffffu);
                    zr[ZK + hk] = (bf16)(pkbf(kv * __expf(-bb), 0.f) & 0xffffu);
                }
                klp[jj >> 1] = pkbf(kl2[0], kl2[1]);
            }
            LAS u32x4* kp = (LAS u32x4*)(lds + G_KLT + k * 144 + seg * 32);
            kp[0] = (u32x4){klp[0], klp[1], klp[2], klp[3]}; kp[1] = (u32x4){klp[4], klp[5], klp[6], klp[7]};
        } else {
#pragma unroll
            for (int i = 0; i < 4; ++i) { const int c = tid + 512 * i, row = c >> 5, c16 = c & 31;
                *(LAS u32x4*)(lds + G_GT + row * 528 + c16 * 16) = *(const u32x4*)(z + (size_t)(t0 + row) * ZLD + ZG + h * 256 + c16 * 8); }
#pragma unroll
            for (int i = 0; i < 2; ++i) { const int c = tid + 512 * i, row = c >> 4, c16 = c & 15; const bf16* zr = z + (size_t)(t0 + row) * ZLD + h * 128 + c16 * 8;
                *(LAS u32x4*)(lds + G_QD + row * 272 + c16 * 16) = *(const u32x4*)(zr + ZQ);
                *(LAS u32x4*)(lds + G_KD + row * 272 + c16 * 16) = *(const u32x4*)(zr + ZK); }
            const float eb = EBLG[cgl * 512 + hk];
            if (seg == 0) EBL[k] = eb;
            unsigned klp[8];
#pragma unroll
            for (int jj = 0; jj < 16; jj += 2) {
                const bf16* zr = z + (size_t)(t0 + seg * 16 + jj) * ZLD + ZK + hk;
                klp[jj >> 1] = pkbf(bf2f(zr[0]) * eb, bf2f(zr[ZLD]) * eb);
            }
            LAS u32x4* kp = (LAS u32x4*)(lds + G_KLT + k * 144 + seg * 32);
            kp[0] = (u32x4){klp[0], klp[1], klp[2], klp[3]}; kp[1] = (u32x4){klp[4], klp[5], klp[6], klp[7]};
        }
        {
            const bf16* zv = z + (size_t)(t0 + jh * 32) * ZLD + ZV + h * 256 + vv;
            unsigned vp[16];
#pragma unroll
            for (int jj = 0; jj < 32; jj += 2) vp[jj >> 1] = (unsigned)zv[(size_t)jj * ZLD] | ((unsigned)zv[(size_t)(jj + 1) * ZLD] << 16);
            LAS u32x4* vpp = (LAS u32x4*)(lds + G_VT + vv * 144 + jh * 64);
#pragma unroll
            for (int i = 0; i < 4; ++i) vpp[i] = (u32x4){vp[4 * i], vp[4 * i + 1], vp[4 * i + 2], vp[4 * i + 3]};
        }
        __syncthreads();
        if (OUT) {
            const int jt = w >> 1;
#pragma unroll
            for (int ii = 0; ii < 2; ++ii) {
                const int it = (w & 1) * 2 + ii;
                f32x4 pa = (f32x4){0.f, 0.f, 0.f, 0.f};
                if (jt <= it) {
#pragma unroll
                    for (int s = 0; s < 4; ++s) {
                        const bf16x8 A = *(const LAS bf16x8*)(lds + G_KD + ((16 * jt + r) * 136 + 32 * s + 8 * q) * 2);
                        const bf16x8 B = *(const LAS bf16x8*)(lds + G_QD + ((16 * it + r) * 136 + 32 * s + 8 * q) * 2);
                        pa = MFMA16(A, B, pa);
                    }
                    const int i_ = 16 * it + r;
#pragma unroll
                    for (int e = 0; e < 4; ++e) { const int j_ = 16 * jt + 4 * q + e; if (j_ > i_) pa[e] = 0.f; }
                }
                u32x2 pw; pw.x = pkbf(pa[0], pa[1]); pw.y = pkbf(pa[2], pa[3]);
                *(LAS u32x2*)(lds + G_P + ((16 * it + r) * 72 + 16 * jt + 4 * q) * 2) = pw;
            }
            __syncthreads();
        }
        bf16x8 Bv[2][2];
#pragma unroll
        for (int s2 = 0; s2 < 2; ++s2)
#pragma unroll
            for (int nt = 0; nt < 2; ++nt) Bv[s2][nt] = *(const LAS bf16x8*)(lds + G_VT + ((32 * w + 16 * nt + r) * 72 + 32 * s2 + 8 * q) * 2);
        f32x4 o[4][2];
        if (OUT) {
#pragma unroll
            for (int mt = 0; mt < 4; ++mt)
#pragma unroll
                for (int nt = 0; nt < 2; ++nt) o[mt][nt] = (f32x4){0.f, 0.f, 0.f, 0.f};
#pragma unroll
            for (int s = 0; s < 4; ++s) {
                bf16x8 Sb[2];
#pragma unroll
                for (int nt = 0; nt < 2; ++nt) {
                    u32x4 t; t.x = pkbf(S[2 * s][nt][0], S[2 * s][nt][1]); t.y = pkbf(S[2 * s][nt][2], S[2 * s][nt][3]);
                    t.z = pkbf(S[2 * s + 1][nt][0], S[2 * s + 1][nt][1]); t.w = pkbf(S[2 * s + 1][nt][2], S[2 * s + 1][nt][3]);
                    Sb[nt] = __builtin_bit_cast(bf16x8, t);
                }
#pragma unroll
                for (int mt = 0; mt < 4; ++mt) {
                    const u32x2 lo = *(const LAS u32x2*)(lds + G_QD + ((16 * mt + r) * 136 + 32 * s + 4 * q) * 2);
                    const u32x2 hi = *(const LAS u32x2*)(lds + G_QD + ((16 * mt + r) * 136 + 32 * s + 16 + 4 * q) * 2);
                    const bf16x8 A = __builtin_bit_cast(bf16x8, (u32x4){lo.x, lo.y, hi.x, hi.y});
#pragma unroll
                    for (int nt = 0; nt < 2; ++nt) o[mt][nt] = MFMA16(A, Sb[nt], o[mt][nt]);
                }
            }
#pragma unroll
            for (int s2 = 0; s2 < 2; ++s2)
#pragma unroll
                for (int mt = 0; mt < 4; ++mt) {
                    const bf16x8 A = *(const LAS bf16x8*)(lds + G_P + ((16 * mt + r) * 72 + 32 * s2 + 8 * q) * 2);
#pragma unroll
                    for (int nt = 0; nt < 2; ++nt) o[mt][nt] = MFMA16(A, Bv[s2][nt], o[mt][nt]);
                }
        }
#pragma unroll
        for (int mt = 0; mt < 8; ++mt) {
            const f32x4 eb = *(const LAS f32x4*)(lds + G_EBL + (16 * mt + 4 * q) * 4);
#pragma unroll
            for (int nt = 0; nt < 2; ++nt) S[mt][nt] = S[mt][nt] * eb;
#pragma unroll
            for (int s2 = 0; s2 < 2; ++s2) {
                const bf16x8 A = *(const LAS bf16x8*)(lds + G_KLT + ((16 * mt + r) * 72 + 32 * s2 + 8 * q) * 2);
#pragma unroll
                for (int nt = 0; nt < 2; ++nt) S[mt][nt] = MFMA16(A, Bv[s2][nt], S[mt][nt]);
            }
        }
        if (OUT) {
#pragma unroll
            for (int mt = 0; mt < 4; ++mt)
#pragma unroll
                for (int e = 0; e < 4; ++e) {
                    float s = o[mt][0][e] * o[mt][0][e] + o[mt][1][e] * o[mt][1][e];
                    s += __shfl_xor(s, 1); s += __shfl_xor(s, 2); s += __shfl_xor(s, 4); s += __shfl_xor(s, 8);
                    if (r == 0) SSQ[(16 * mt + 4 * q + e) * 8 + w] = s;
                }
            __syncthreads();
            const float ng0 = normg[32 * w + r], ng1 = normg[32 * w + 16 + r];
#pragma unroll
            for (int mt = 0; mt < 4; ++mt)
#pragma unroll
                for (int e = 0; e < 4; ++e) {
                    const int i_ = 16 * mt + 4 * q + e;
                    const f32x4 sa = *(const LAS f32x4*)(lds + G_SS + i_ * 32), sb = *(const LAS f32x4*)(lds + G_SS + i_ * 32 + 16);
                    const float tot2 = ((sa.x + sa.y) + (sa.z + sa.w)) + ((sb.x + sb.y) + (sb.z + sb.w));
                    const float rs = 1.f / sqrtf(tot2 * (1.f / 256.f) + EPS);
                    LAS bf16* gp = (LAS bf16*)(lds + G_GT + i_ * 528 + (32 * w + r) * 2);
                    const float ga = bf2f(gp[0]), gb = bf2f(gp[16]);
                    const float va = o[mt][0][e] * rs * ng0 * ga * __builtin_amdgcn_rcpf(1.f + __expf(-ga));
                    const float vb = o[mt][1][e] * rs * ng1 * gb * __builtin_amdgcn_rcpf(1.f + __expf(-gb));
                    const unsigned pv = pkbf(va, vb);
                    gp[0] = (bf16)(pv & 0xffffu); gp[16] = (bf16)(pv >> 16);
                }
            __syncthreads();
#pragma unroll
            for (int i = 0; i < 4; ++i) { const int c = tid + 512 * i, row = c >> 5, c16 = c & 31;
                *(u32x4*)(mix + (size_t)(t0 + row) * MIXLD + 512 + h * 256 + c16 * 8) = *(const LAS u32x4*)(lds + G_GT + row * 528 + c16 * 16); }
        }
        __syncthreads();
    }
    if (!OUT) {
#pragma unroll
        for (int mt = 0; mt < 8; ++mt)
#pragma unroll
            for (int nt = 0; nt < 2; ++nt)
#pragma unroll
                for (int i = 0; i < 4; ++i) Eu[((mt * 2 + nt) * 4 + i) * 64] = S[mt][nt][i];
        if (seg == 0) DEC[unit * 128 + k] = __expf(bsum);
    }
}

__device__ __forceinline__ void shortconv(const bf16* z, const float* wsc, bf16* mix, int gtid, int gthreads) {
    for (int idx = gtid; idx < T * 256; idx += gthreads) {
        const int t = idx >> 8, c = (idx & 255) * 2;
        float a0 = 0.f, a1 = 0.f;
#pragma unroll
        for (int j = 0; j < 3; ++j) { const int tt = t - 2 + j;
            if (tt >= 0) { const bf16* zr = z + (size_t)tt * ZLD; const unsigned x2 = *(const unsigned*)(zr + ZSX + c), c2 = *(const unsigned*)(zr + ZSC + c);
                const f32x2 wj = *(const f32x2*)(wsc + j * 512 + c);
                a0 += wj.x * (bf2f(x2 & 0xffffu) * bf2f(c2 & 0xffffu)); a1 += wj.y * (bf2f(x2 >> 16) * bf2f(c2 >> 16)); } }
        const unsigned b2 = *(const unsigned*)(z + (size_t)t * ZLD + ZSB + c);
        *(unsigned*)(mix + (size_t)t * MIXLD + c) = pkbf(bf2f(b2 & 0xffffu) * a0, bf2f(b2 >> 16) * a1);
    }
}

__device__ __forceinline__ void gla_scan(float* E, const float* DEC, int gtid, int gthreads) {
    for (int e = gtid; e < 4 * 32768; e += gthreads) {
        const int h = e >> 15, rem = e & 32767, rr = (rem >> 6) & 63, ln = rem & 63;
        const int k = 16 * (rr >> 3) + 4 * (ln >> 4) + (rr & 3);
        float s = 0.f;
#pragma unroll 8
        for (int g = 0; g < 64; ++g) { float* p = E + (size_t)(g * 4 + h) * 32768 + rem; const float tmp = *p; *p = s; s = DEC[(g * 4 + h) * 128 + k] * s + tmp; }
    }
}

__device__ __forceinline__ void conv_phase(const bf16* u, const float* wdw, const float* bdw, const float* lng, const float* lnb, bf16* dout, LAS unsigned char* lds, int G, int bid) {
    const int tid = tid_l(), lane = tid & 63, w = tid >> 6;
    LAS unsigned* UL = (LAS unsigned*)lds;
    LAS f32x2* RED = (LAS f32x2*)(lds + 126976);
    LAS f32x2* STAT = (LAS f32x2*)(lds + 126976 + 2048);
    float w0[31], w1[31];
#pragma unroll
    for (int j = 0; j < 31; ++j) { const f32x2 t = *(const f32x2*)(wdw + j * 1024 + 2 * tid); w0[j] = t.x; w1[j] = t.y; }
    const f32x2 bd = *(const f32x2*)(bdw + 2 * tid), lg = *(const f32x2*)(lng + 2 * tid), lb = *(const f32x2*)(lnb + 2 * tid);
    for (int tile = bid; tile < T / 32; tile += G) {
        const int t0 = tile * 32;
        for (int i = tid; i < 62 * 128; i += NTHR) { const int rr = i >> 7, cc = i & 127, t = t0 - 30 + rr;
            u32x4 v = (u32x4){0u, 0u, 0u, 0u}; if (t >= 0) v = *(const u32x4*)(u + (size_t)t * D + cc * 8);
            *(LAS u32x4*)(lds + rr * 2048 + cc * 16) = v; }
        __syncthreads();
#pragma unroll 1
        for (int sub = 0; sub < 2; ++sub) {
            float d0[16], d1[16];
#pragma unroll
            for (int tt = 0; tt < 16; ++tt) { d0[tt] = bd.x; d1[tt] = bd.y; }
            const LAS unsigned* ULs = UL + sub * 16 * 512 + tid;
#pragma unroll
            for (int rr = 0; rr < 46; ++rr) {
                const unsigned uu = ULs[rr * 512]; const float ua = bf2f(uu & 0xffffu), ub = bf2f(uu >> 16);
#pragma unroll
                for (int tt = 0; tt < 16; ++tt) { if (rr - tt >= 0 && rr - tt <= 30) { d0[tt] += w0[rr - tt] * ua; d1[tt] += w1[rr - tt] * ub; } }
                if ((rr & 7) == 7) __builtin_amdgcn_sched_barrier(0);
            }
#pragma unroll
            for (int tt = 0; tt < 16; ++tt) {
                float s1 = d0[tt] + d1[tt], s2 = d0[tt] * d0[tt] + d1[tt] * d1[tt];
                s1 = wave_sum(s1); s2 = wave_sum(s2);
                if (lane == 0) RED[tt * 8 + w] = (f32x2){s1, s2};
            }
            __syncthreads();
            if (tid < 16) { float s1 = 0.f, s2 = 0.f;
#pragma unroll
                for (int i = 0; i < 8; ++i) { const f32x2 t = RED[tid * 8 + i]; s1 += t.x; s2 += t.y; }
                const float mean = s1 * (1.f / D); const float var = fmaxf(s2 * (1.f / D) - mean * mean, 0.f);
                STAT[tid] = (f32x2){mean, 1.f / sqrtf(var + EPS)}; }
            __syncthreads();
#pragma unroll
            for (int tt = 0; tt < 16; ++tt) {
                const f32x2 st = STAT[tt];
                const float a = (d0[tt] - st.x) * st.y * lg.x + lb.x, b = (d1[tt] - st.x) * st.y * lg.y + lb.y;
                const float sa = a * __builtin_amdgcn_rcpf(1.f + __expf(-a)), sb = b * __builtin_amdgcn_rcpf(1.f + __expf(-b));
                *(unsigned*)(dout + (size_t)(t0 + sub * 16 + tt) * D + 2 * tid) = pkbf(sa, sb);
            }
        }
        __syncthreads();
    }
}

#define XB_TMO      128
#define XB_XCNT(j)  (256  + 64 * (j))
#define XB_XSUB(j)  (1280 + 64 * (j))
#define XB_XGEN(j)  (2304 + 64 * (j))
#define XB_TOP      3328
#define XB_TOPGEN   3392
#define XCD_BAR_WORDS 3456
#define XB_SPIN_CAP (1u << 18)

__device__ __forceinline__ unsigned xb_ld(unsigned* p)              { return __hip_atomic_load(p, __ATOMIC_RELAXED, __HIP_MEMORY_SCOPE_AGENT); }
__device__ __forceinline__ unsigned xb_add(unsigned* p, unsigned v) { return __hip_atomic_fetch_add(p, v, __ATOMIC_RELAXED, __HIP_MEMORY_SCOPE_AGENT); }
__device__ __forceinline__ unsigned xb_xcc_id() { return (unsigned)__builtin_amdgcn_s_getreg((3 << 11) | 20) & 0xFu; }
#define XB_SPIN(cond, bar) do { unsigned _sp = 0; while (cond) { __builtin_amdgcn_s_sleep(1); \
    if ((++_sp & 255u) == 0u) { if (xb_ld(&(bar)[XB_TMO])) break; if (_sp > XB_SPIN_CAP) { atomicAdd(&(bar)[XB_TMO], 1u); break; } } } } while (0)

struct XcdBarrier {
    unsigned* bar; unsigned x;
    volatile LAS unsigned* st;
};

__device__ __forceinline__ XcdBarrier xcd_barrier_post(unsigned* bar, volatile LAS unsigned* st) {
    XcdBarrier b; b.bar = bar; b.x = xb_xcc_id(); b.st = st;
    if (threadIdx.x == 0) (void)xb_add(&bar[XB_XCNT(b.x)], 1u);
    return b;
}
__device__ __forceinline__ void xcd_barrier_complete(unsigned* bar, unsigned x, unsigned& nloc, unsigned& nx) {
    const unsigned G = gridDim.x * gridDim.y * gridDim.z;
    unsigned sum, cnt, mine, sp = 0u;
    for (;;) {
        sum = 0u; cnt = 0u; mine = 0u;
#pragma unroll
        for (unsigned j = 0; j < 16; ++j) { const unsigned c = xb_ld(&bar[XB_XCNT(j)]); sum += c; cnt += (c > 0u) ? 1u : 0u; mine = (j == x) ? c : mine; }
        if (sum == G) break;
        __builtin_amdgcn_s_sleep(1);
        if ((++sp & 255u) == 0u) { if (xb_ld(&bar[XB_TMO])) break; if (sp > XB_SPIN_CAP) { atomicAdd(&bar[XB_TMO], 1u); break; } }
    }
    nloc = mine > 0u ? mine : 1u; nx = cnt > 0u ? cnt : 1u;
}

__device__ __forceinline__ void xcd_barrier(const XcdBarrier& b) {
    asm volatile("s_waitcnt vmcnt(0)" ::: "memory");
    __syncthreads();
    if (threadIdx.x == 0) {
        unsigned* bar = b.bar;
        __builtin_amdgcn_s_waitcnt(0);
        unsigned nloc = b.st[0], nx = b.st[1];
        if (nloc == 0u) { xcd_barrier_complete(bar, b.x, nloc, nx); b.st[0] = nloc; b.st[1] = nx; }
        const unsigned old = xb_add(&bar[XB_XSUB(b.x)], 1u);
        const unsigned gen = old / nloc;
        if (old + 1u == (gen + 1u) * nloc) {
            __builtin_amdgcn_fence(__ATOMIC_RELEASE, "agent");
            asm volatile("s_waitcnt vmcnt(0)" ::: "memory");
            const unsigned og = xb_add(&bar[XB_TOP], 1u);
            const unsigned tg = og / nx;
            if (og + 1u == (tg + 1u) * nx) xb_add(&bar[XB_TOPGEN], 1u);
            else XB_SPIN(xb_ld(&bar[XB_TOPGEN]) == tg, bar);
            __builtin_amdgcn_fence(__ATOMIC_ACQUIRE, "agent");
            xb_add(&bar[XB_XGEN(b.x)], 1u);
            asm volatile("s_waitcnt vmcnt(0)" ::: "memory");
        } else {
            XB_SPIN(xb_ld(&bar[XB_XGEN(b.x)]) == gen, bar);
            __builtin_amdgcn_fence(__ATOMIC_ACQUIRE, "agent");
            asm volatile("s_waitcnt vmcnt(0)" ::: "memory");
        }
    }
    __syncthreads();
}

__global__ void __launch_bounds__(NTHR, 2) trunk_fwd(Args a) {
    extern __shared__ __attribute__((aligned(16))) unsigned char lds_raw[];
    LAS unsigned char* lds = (LAS unsigned char*)lds_raw;
    cg::grid_group grid = cg::this_grid();
    { volatile LAS unsigned* st0 = (volatile LAS unsigned*)(lds + LDS_BYTES - 16); if (threadIdx.x < 4) st0[threadIdx.x] = 0u; }
    __syncthreads();
    const XcdBarrier xbar = xcd_barrier_post((unsigned*)(a.ws + WS_BAR), (volatile LAS unsigned*)(lds + LDS_BYTES - 16));
    const int G0 = gridDim.x;
#define IDS int bid = blockIdx.x; asm volatile("" : "+s"(bid)); const int tid = tid_l(), lane = tid & 63, wave = __builtin_amdgcn_readfirstlane(tid >> 6), gw = bid * NWAVES + wave, gtid = bid * NTHR + tid; (void)lane; (void)gw; (void)gtid;
    unsigned char* ws = a.ws; float* const xout = a.out;
#define Wb ((bf16*)(wsl + WS_W))
#define Hb ((bf16*)(wsl + WS_H))
#define Eb ((float*)(wsl + WS_H))
#define DEC ((float*)(wsl + WS_DEC))
#define GK ((float*)(wsl + WS_GK))
#define EBLG ((float*)(wsl + WS_EBL))
#define big (wsl + WS_BIG)
#define Z ((bf16*)big)
#define MIX ((bf16*)(big + 144 * MiB))
#define U ((bf16*)big)
#define Dd ((bf16*)(big + 32 * MiB))
#define Ab ((bf16*)big)
#define ymlp ((float*)(big + 128 * MiB))
#define ymix ((float*)(big + ((l & 1) ? 64 * MiB : 0)))
#ifndef PH_LO
#define PH_LO 0
#endif
#ifndef PH_HI
#define PH_HI 25
#endif
    constexpr int lo = PH_LO, hi = PH_HI;
    int ph = 0;
#define PH_BEGIN if (ph >= lo && ph < hi) { IDS unsigned char* wsl = ws; asm volatile("" : "+s"(wsl)); int G = G0; asm volatile("" : "+s"(G)); const int NGW = G * NWAVES, gthreads = G * NTHR; (void)NGW; (void)gthreads;
#define PH_END   if (ph + 1 < hi) { if (ph == lo) grid.sync(); else xcd_barrier(xbar); } } ++ph;

    PH_BEGIN
        convert_layer<0>(wsl, 0, lds, gw, NGW, wave, lane);
        norm_rows<false, false, true>(nullptr, inp(0), nullptr, nullptr, inp(1), Hb, gw, NGW, lane);
    PH_END

#define STATS(bank) pg8::RmsStats{(float*)(wsl + (((bank) & 1) ? WS_X2 : WS_X1)), (unsigned*)(wsl + WS_CNT) + (size_t)(bank) * 4096}
    for (int l = 0; l < DEPTH; ++l) {
        const int i2 = l >> 1;
        const bool first = (l == 0);
        if ((l & 1) == 0) {
            PH_BEGIN
                pg8::Gemm g{Hb, Wb + WO_MIX1, T, ZN, D}; pg8::StaticOrder S; S.init(T, ZN, G, bid);
                pg8::EpiZ E{Z, GK};
                pg8::gemm_phase<pg8::EpiZ, pg8::StaticOrder, true, true>(lds, g, S, E);
            PH_END
            PH_BEGIN
                for (int un = bid; un < 256; un += G)
                    gla_unit<false>(un, Z, GK, inp(6) + (size_t)i2 * 16 * 512, inp(7) + (size_t)i2 * 512, inp(9) + (size_t)i2 * 256, Eb, DEC, EBLG, MIX, lds);
                shortconv(Z, inp(8) + (size_t)i2 * 3 * 512, MIX, gtid, gthreads);
            PH_END
            PH_BEGIN
                gla_scan(Eb, DEC, gtid, gthreads);
                convert_layer<1>(wsl, l, lds, gw, NGW, wave, lane);
            PH_END
            PH_BEGIN
                for (int un = bid; un < 256; un += G)
                    gla_unit<true>(un, Z, GK, inp(6) + (size_t)i2 * 16 * 512, inp(7) + (size_t)i2 * 512, inp(9) + (size_t)i2 * 256, Eb, DEC, EBLG, MIX, lds);
            PH_END
            PH_BEGIN
                pg8::Gemm g{MIX, Wb + WO_MIX2_E, T, D, MIXLD}; pg8::StaticOrder S; S.init(T, D, G, bid);
                pg8::EpiNorm<false, true> E{first ? inp(0) : xout, xout, Hb, nullptr, inp(2) + (size_t)l * D, inp(3) + (size_t)l * D, STATS(l * 4 + 0), STATS(l * 4 + 1)};
                pg8::gemm_phase<pg8::EpiNorm<false, true>, pg8::StaticOrder, false, true>(lds, g, S, E);
            PH_END
        } else {
            PH_BEGIN
                pg8::Gemm g{Hb, Wb + WO_MIX1, T, 2048, D}; pg8::StaticOrder S; S.init(T, 2048, G, bid);
                pg8::EpiGLU E{U, inp(12) + (size_t)i2 * 2048};
                pg8::gemm_phase<pg8::EpiGLU, pg8::StaticOrder, true, true>(lds, g, S, E);
            PH_END
            PH_BEGIN
                convert_layer<1>(wsl, l, lds, gw, NGW, wave, lane);
                __syncthreads();
                conv_phase(U, inp(13) + (size_t)i2 * 31 * D, inp(14) + (size_t)i2 * D, inp(15) + (size_t)i2 * D, inp(16) + (size_t)i2 * D, Dd, lds, G, bid);
            PH_END
            PH_BEGIN
                pg8::Gemm g{Dd, Wb + WO_MIX2_O, T, D, D}; pg8::StaticOrder S; S.init(T, D, G, bid);
                pg8::EpiNorm<true, true> E{xout, xout, Hb, inp(18) + (size_t)i2 * D, inp(2) + (size_t)l * D, inp(3) + (size_t)l * D, STATS(l * 4 + 0), STATS(l * 4 + 1)};
                pg8::gemm_phase<pg8::EpiNorm<true, true>, pg8::StaticOrder, false, true>(lds, g, S, E);
            PH_END
        }
        PH_BEGIN
            if (l + 1 < DEPTH) { convert_layer<0>(wsl, l + 1, lds, gw, NGW, wave, lane); __syncthreads(); }
            pg8::Gemm g{Hb, Wb + WO_W1, T, FF, D}; pg8::StaticOrder S; S.init(T, FF, G, bid);
            pg8::EpiRelu2 E{Ab, FF};
            pg8::gemm_phase<pg8::EpiRelu2, pg8::StaticOrder, true, true>(lds, g, S, E);
        PH_END
        PH_BEGIN
            pg8::Gemm g{Ab, Wb + WO_W2, T, D, FF}; pg8::StaticOrder S; S.init(T, D, G, bid);
            if (l + 1 < DEPTH) { pg8::EpiNorm<false, true> E{xout, xout, Hb, nullptr, inp(4) + (size_t)l * D, inp(1) + (size_t)(l + 1) * D, STATS(l * 4 + 2), STATS(l * 4 + 3)};
                pg8::gemm_phase<pg8::EpiNorm<false, true>, pg8::StaticOrder, false, true>(lds, g, S, E); }
            else { pg8::EpiNorm<false, false> E{xout, xout, Hb, nullptr, inp(4) + (size_t)l * D, nullptr, STATS(l * 4 + 2), STATS(l * 4 + 3)};
                pg8::gemm_phase<pg8::EpiNorm<false, false>, pg8::StaticOrder, false, true>(lds, g, S, E); }
        PH_END
    }
}

extern "C" void kernel_launch(void* const* d_in, const int* in_sizes, int n_in, void* d_out, int out_size, void* d_ws, size_t ws_size, hipStream_t stream) {
    static int grid = 0;
    if (grid == 0) {
        if (n_in != 21 || out_size != T * D || ws_size < WS_END) { fprintf(stderr, "kernel_launch: unexpected shapes (n_in %d out %d ws %zu)\n", n_in, out_size, ws_size); grid = -1; return; }
        int dev = 0, cus = 0, per_cu = 0;
        hipGetDevice(&dev); hipDeviceGetAttribute(&cus, hipDeviceAttributeMultiprocessorCount, dev);
        if (hipFuncSetAttribute((const void*)trunk_fwd, hipFuncAttributeMaxDynamicSharedMemorySize, LDS_BYTES) != hipSuccess) { fprintf(stderr, "kernel_launch: hipFuncSetAttribute failed\n"); grid = -1; return; }
        if (hipOccupancyMaxActiveBlocksPerMultiprocessor(&per_cu, (const void*)trunk_fwd, NTHR, LDS_BYTES) != hipSuccess || per_cu < 1) { fprintf(stderr, "kernel_launch: occupancy query failed (%d)\n", per_cu); (void)hipGetLastError(); per_cu = 1; }
        grid = cus * per_cu; if (grid > 256) grid = 256;
        if (grid != 256) { fprintf(stderr, "kernel_launch: this kernel needs exactly 256 co-resident workgroups (got %d)\n", grid); grid = -1; return; }
    }
    if (grid < 0) return;
    Args a{};
    for (int i = 0; i < 21; ++i) a.in[i] = (const float*)d_in[i];
    a.out = (float*)d_out; a.ws = (unsigned char*)d_ws; a.ph_lo = 0; a.ph_hi = 25;
    if (hipMemsetAsync(d_ws, 0, 1u << 20, stream) != hipSuccess) { fprintf(stderr, "kernel_launch: memset failed\n"); return; }
    void* args[] = {&a};
    hipError_t e = hipLaunchCooperativeKernel((const void*)trunk_fwd, dim3(grid), dim3(NTHR), args, LDS_BYTES, stream);
    if (e != hipSuccess) fprintf(stderr, "cooperative launch failed: %s (grid %d)\n", hipGetErrorString(e), grid);
}
```

```cpp
#include <hip/hip_runtime.h>
#include <cstdio>
#include <cstdint>
namespace pg8 {
#define PG8_LAS __attribute__((address_space(3)))
typedef unsigned short bf16_t;
typedef short bf16x8 __attribute__((ext_vector_type(8)));
typedef float f32x4 __attribute__((ext_vector_type(4)));
typedef unsigned u32x4 __attribute__((ext_vector_type(4)));
constexpr int BM = 256, BK = 64, HALF = 128, HTB = HALF * BK * 2  , STAGE_BYTES = 8 * HTB, NXCD = 8, WGM = 4;

__host__ __device__ __forceinline__ int lds_byte(int r, int c) { const int st = (r >> 4) * 2 + (c >> 5), rr = r & 15, cc = c & 31, ob = rr * 64 + cc * 2; return st * 1024 + (ob ^ (((ob >> 9) & 1) << 5)); }
__host__ __device__ __forceinline__ void stage_rc(int b, int& R, int& C) { const int st = b / 1024, sb = b % 1024, swz = sb ^ (((sb >> 9) & 1) << 5); R = (st >> 1) * 16 + swz / 64; C = (st & 1) * 32 + (swz % 64) / 2; }
__host__ __device__ __forceinline__ int perm32(int rho) { const int n = rho >> 4, i = rho & 15; return 8 * (i >> 2) + 4 * n + (i & 3); }

struct Unit { int pm, pn; };
struct Gemm { const bf16_t* A; const bf16_t* Bt; int M, N, K; };

struct StaticOrder {
    int nM, nN, nwg, G, c, wgm;
    __host__ __device__ void init(int M, int N, int G_, int c_, int wgm_ = WGM) { nM = M / BM; nN = N / BM; nwg = nM * nN; G = G_; c = c_; wgm = wgm_; }
    __host__ __device__ bool next(int i, Unit& u) const {
        const long L = (long)i * G + c; if (L >= nwg) return false;
        int wgid = (int)L; { const int q = nwg / NXCD, r = nwg % NXCD, xcd = wgid % NXCD, off = wgid / NXCD; wgid = (xcd < r ? xcd * (q + 1) : r * (q + 1) + (xcd - r) * q) + off; }
        const int nig = wgm * nN, gid = wgid / nig, fm = gid * wgm, gsz = (nM - fm) < wgm ? (nM - fm) : wgm;
        u.pm = fm + ((wgid % nig) % gsz); u.pn = (wgid % nig) / gsz; return true;
    }
    __device__ __forceinline__ void a_ready(const Unit&) const {}
    __device__ __forceinline__ void done(const Unit&) const {}
};
__device__ __forceinline__ unsigned cvt_pk_bf16(float lo, float hi) { unsigned r; asm volatile("v_cvt_pk_bf16_f32 %0, %1, %2" : "=v"(r) : "v"(lo), "v"(hi)); return r; }
typedef float f32x2 __attribute__((ext_vector_type(2)));
}
namespace pg8 {
__device__ __forceinline__ float row_rstd(const float* ssp, int row) {
    const f32x4 a = *(const f32x4*)(ssp + (size_t)row * 4);
    return __builtin_amdgcn_rsqf(((a[0] + a[1]) + (a[2] + a[3])) * (1.0f / 1024.0f) + 1e-6f);
}
struct EpiZ {
    static constexpr bool PERM = true, AFTER_DRAIN = false;
    bf16_t* Z; float* GK; const PG8_LAS float* tab;
    __device__ __forceinline__ void operator()(const f32x4 (&acc)[2][2][4][2], const Unit& u, int wr, int wc, int fr, int fq) const {
        const int row0 = u.pm * BM + wr * 64 + fr;
        float rsv[2][4];
#pragma unroll
        for (int ai = 0; ai < 2; ++ai)
#pragma unroll
            for (int m = 0; m < 4; ++m) rsv[ai][m] = tab[(u.pm & 7) * 256 + wr * 64 + fr + ai * HALF + m * 16];
        if (u.pn < 18) {
            const int col0 = u.pn * BM + wc * 32 + 8 * fq;
#pragma unroll
            for (int ai = 0; ai < 2; ++ai)
#pragma unroll
                for (int m = 0; m < 4; ++m) { bf16_t* rowp = Z + (size_t)(row0 + ai * HALF + m * 16) * 4608 + col0;
#pragma unroll
                    for (int bj = 0; bj < 2; ++bj) { const f32x4 v0 = acc[ai][bj][m][0] * rsv[ai][m], v1 = acc[ai][bj][m][1] * rsv[ai][m];
                        u32x4 w; w.x = cvt_pk_bf16(v0[0], v0[1]); w.y = cvt_pk_bf16(v0[2], v0[3]); w.z = cvt_pk_bf16(v1[0], v1[1]); w.w = cvt_pk_bf16(v1[2], v1[3]);
                        *(u32x4*)(rowp + bj * HALF) = w; } }
        } else if (wc == 0 && fq < 2) {
#pragma unroll
            for (int ai = 0; ai < 2; ++ai)
#pragma unroll
                for (int m = 0; m < 4; ++m) { float* rp = GK + (size_t)(row0 + ai * HALF + m * 16) * 16 + 8 * fq;
                    *(f32x4*)rp = acc[ai][0][m][0] * rsv[ai][m]; *(f32x4*)(rp + 4) = acc[ai][0][m][1] * rsv[ai][m]; }
        }
    }
};
template <bool HAS_BIAS> struct EpiF32 {
    static constexpr bool PERM = false, AFTER_DRAIN = false;
    float* C; int ldc; const float* bias;
    __device__ __forceinline__ void operator()(const f32x4 (&acc)[2][2][4][2], const Unit& u, int wr, int wc, int fr, int fq) const {
        const int row0 = u.pm * BM + wr * 64 + fr, col0 = u.pn * BM + wc * 32 + 4 * fq;
        f32x4 bv[2][2];
#pragma unroll
        for (int bj = 0; bj < 2; ++bj)
#pragma unroll
            for (int n = 0; n < 2; ++n) bv[bj][n] = HAS_BIAS ? *(const f32x4*)(bias + col0 + bj * HALF + n * 16) : (f32x4){0.f, 0.f, 0.f, 0.f};
#pragma unroll
        for (int ai = 0; ai < 2; ++ai)
#pragma unroll
            for (int m = 0; m < 4; ++m) { float* rowp = C + (size_t)(row0 + ai * HALF + m * 16) * ldc + col0;
#pragma unroll
                for (int bj = 0; bj < 2; ++bj)
#pragma unroll
                    for (int n = 0; n < 2; ++n) *(f32x4*)(rowp + bj * HALF + n * 16) = acc[ai][bj][m][n] + bv[bj][n]; }
    }
};
struct EpiRelu2 {
    static constexpr bool PERM = true, AFTER_DRAIN = false;
    bf16_t* O; int ldc; const PG8_LAS float* tab;
    __device__ __forceinline__ void operator()(const f32x4 (&acc)[2][2][4][2], const Unit& u, int wr, int wc, int fr, int fq) const {
        const int row0 = u.pm * BM + wr * 64 + fr, col0 = u.pn * BM + wc * 32 + 8 * fq;
#pragma unroll
        for (int ai = 0; ai < 2; ++ai)
#pragma unroll
            for (int m = 0; m < 4; ++m) { bf16_t* rowp = O + (size_t)(row0 + ai * HALF + m * 16) * ldc + col0; const float rs = tab[(u.pm & 7) * 256 + wr * 64 + fr + ai * HALF + m * 16];
#pragma unroll
                for (int bj = 0; bj < 2; ++bj) { f32x4 v0 = acc[ai][bj][m][0] * rs, v1 = acc[ai][bj][m][1] * rs;
#pragma unroll
                    for (int j = 0; j < 4; ++j) { const float a = fmaxf(v0[j], 0.f), b = fmaxf(v1[j], 0.f); v0[j] = a * a; v1[j] = b * b; }
                    u32x4 w; w.x = cvt_pk_bf16(v0[0], v0[1]); w.y = cvt_pk_bf16(v0[2], v0[3]); w.z = cvt_pk_bf16(v1[0], v1[1]); w.w = cvt_pk_bf16(v1[2], v1[3]);
                    *(u32x4*)(rowp + bj * HALF) = w; } }
    }
};
struct EpiGLU {
    static constexpr bool PERM = true, AFTER_DRAIN = false;
    bf16_t* U; const float* bias; const PG8_LAS float* tab;
    __device__ __forceinline__ void operator()(const f32x4 (&acc)[2][2][4][2], const Unit& u, int wr, int wc, int fr, int fq) const {
        const int row0 = u.pm * BM + wr * 64 + fr, col0 = u.pn * HALF + wc * 32 + 8 * fq;
        f32x4 b1[2], b2[2];
#pragma unroll
        for (int n = 0; n < 2; ++n) { b1[n] = *(const f32x4*)(bias + col0 + 4 * n); b2[n] = *(const f32x4*)(bias + 1024 + col0 + 4 * n); }
#pragma unroll
        for (int ai = 0; ai < 2; ++ai)
#pragma unroll
            for (int m = 0; m < 4; ++m) { bf16_t* rowp = U + (size_t)(row0 + ai * HALF + m * 16) * 1024 + col0; const float rs = tab[(u.pm & 7) * 256 + wr * 64 + fr + ai * HALF + m * 16];
                f32x4 o[2];
#pragma unroll
                for (int n = 0; n < 2; ++n) { const f32x4 a = acc[ai][0][m][n] * rs + b1[n], g = acc[ai][1][m][n] * rs + b2[n];
#pragma unroll
                    for (int j = 0; j < 4; ++j) o[n][j] = a[j] * __builtin_amdgcn_rcpf(1.f + __expf(-g[j])); }
                u32x4 w; w.x = cvt_pk_bf16(o[0][0], o[0][1]); w.y = cvt_pk_bf16(o[0][2], o[0][3]); w.z = cvt_pk_bf16(o[1][0], o[1][1]); w.w = cvt_pk_bf16(o[1][2], o[1][3]);
                *(u32x4*)rowp = w; }
    }
};

struct RmsStats {
    float* xbuf;
    unsigned* cnt;
    __device__ __forceinline__ void run(const f32x4 (&v)[2][2][4][2], const Unit& u, int wr, int wc, int fr, int fq, PG8_LAS unsigned char* lds, int wid, int lane) const {
        PG8_LAS float* P = (PG8_LAS float*)lds;
        PG8_LAS float* S = (PG8_LAS float*)(lds + 4096);
#pragma unroll
        for (int ai = 0; ai < 2; ++ai)
#pragma unroll
            for (int m = 0; m < 4; ++m) {
                float s = 0.f;
#pragma unroll
                for (int bj = 0; bj < 2; ++bj)
#pragma unroll
                    for (int n = 0; n < 2; ++n) { const f32x4 x = v[ai][bj][m][n]; s += (x[0] * x[0] + x[1] * x[1]) + (x[2] * x[2] + x[3] * x[3]); }
                s += __shfl_xor(s, 16); s += __shfl_xor(s, 32);
                if (fq == 0) P[(ai * HALF + wr * 64 + m * 16 + fr) * 4 + wc] = s;
            }
        asm volatile("s_waitcnt lgkmcnt(0)" ::: "memory"); __builtin_amdgcn_s_barrier(); asm volatile("" ::: "memory");
        const int row = wid * 32 + (lane & 31);
        if (lane < 32) { const f32x4 p = *(const PG8_LAS f32x4*)(P + row * 4); const float t = (p[0] + p[1]) + (p[2] + p[3]);
            __hip_atomic_store(xbuf + ((size_t)(u.pm * BM + row) * 4 + u.pn), t, __ATOMIC_RELAXED, __HIP_MEMORY_SCOPE_AGENT); }
        asm volatile("s_waitcnt vmcnt(0)" ::: "memory");
        if (lane == 0) __hip_atomic_fetch_add(cnt + 64 * u.pm, 1u, __ATOMIC_RELAXED, __HIP_MEMORY_SCOPE_AGENT);
        if (wid == 0) {
            unsigned sp = 0u;
            while ((unsigned)__builtin_amdgcn_readfirstlane(__hip_atomic_load(cnt + 64 * u.pm, __ATOMIC_RELAXED, __HIP_MEMORY_SCOPE_AGENT)) < 32u) { __builtin_amdgcn_s_sleep(2); if (++sp > (1u << 22)) break; }
        }
        asm volatile("s_waitcnt vmcnt(0) lgkmcnt(0)" ::: "memory"); __builtin_amdgcn_s_barrier(); asm volatile("" ::: "memory");
        if (lane < 32) { const float* slot = xbuf + (size_t)(u.pm * BM + row) * 4; float t = 0.f;
#pragma unroll
            for (int i = 0; i < 4; ++i) t += __hip_atomic_load(slot + i, __ATOMIC_RELAXED, __HIP_MEMORY_SCOPE_AGENT);
            S[row] = __builtin_amdgcn_rsqf(t * (1.0f / 1024.0f) + 1e-6f); }
        asm volatile("s_waitcnt lgkmcnt(0)" ::: "memory"); __builtin_amdgcn_s_barrier(); asm volatile("" ::: "memory");
    }
};
template <bool HAS_BIAS, bool HAS_PRE, bool XS_BF16, bool XD_BF16> struct EpiNorm {
    static constexpr bool PERM = false, AFTER_DRAIN = true;
    const void* xs; void* xd; float* ssq_out; const float* bias; const float* gpost; RmsStats st1;
    __device__ __forceinline__ void fused(f32x4 (&acc)[2][2][4][2], const Unit& u, int wr, int wc, int fr, int fq, PG8_LAS unsigned char* lds, int wid, int lane) const {
        typedef unsigned u32x2v __attribute__((ext_vector_type(2)));
        const PG8_LAS float* S = (const PG8_LAS float*)(lds + 4096);
        const int col0 = u.pn * BM + wc * 32 + 4 * fq;
        if (HAS_BIAS) {
#pragma unroll
            for (int bj = 0; bj < 2; ++bj)
#pragma unroll
                for (int n = 0; n < 2; ++n) { const f32x4 bv = *(const f32x4*)(bias + col0 + bj * HALF + n * 16);
#pragma unroll
                    for (int ai = 0; ai < 2; ++ai)
#pragma unroll
                        for (int m = 0; m < 4; ++m) acc[ai][bj][m][n] += bv; }
        }
        f32x4 gv[2][2];
#pragma unroll
        for (int bj = 0; bj < 2; ++bj)
#pragma unroll
            for (int n = 0; n < 2; ++n) gv[bj][n] = *(const f32x4*)(gpost + col0 + bj * HALF + n * 16);
        st1.run(acc, u, wr, wc, fr, fq, lds, wid, lane);
#pragma unroll
        for (int ai = 0; ai < 2; ++ai)
#pragma unroll
        for (int mp = 0; mp < 2; ++mp) {
            f32x4 xv[2][2][2];
#pragma unroll
            for (int mm = 0; mm < 2; ++mm) { const size_t off = (size_t)(u.pm * BM + ai * HALF + wr * 64 + (2 * mp + mm) * 16 + fr) * 1024 + col0;
#pragma unroll
                for (int bj = 0; bj < 2; ++bj)
#pragma unroll
                    for (int n = 0; n < 2; ++n) {
                        if (XS_BF16) { const u32x2v p = *(const u32x2v*)((const bf16_t*)xs + off + bj * HALF + n * 16);
                            xv[mm][bj][n] = (f32x4){__uint_as_float(p.x << 16), __uint_as_float(p.x & 0xffff0000u), __uint_as_float(p.y << 16), __uint_as_float(p.y & 0xffff0000u)}; }
                        else xv[mm][bj][n] = *(const f32x4*)((const float*)xs + off + bj * HALF + n * 16); } }
#pragma unroll
            for (int mm = 0; mm < 2; ++mm) asm volatile("" : "+v"(xv[mm][0][0]), "+v"(xv[mm][0][1]), "+v"(xv[mm][1][0]), "+v"(xv[mm][1][1]));
#pragma unroll
            for (int mm = 0; mm < 2; ++mm) { const int m = 2 * mp + mm; const int r = ai * HALF + wr * 64 + m * 16 + fr; const float rs = S[r]; const size_t off = (size_t)(u.pm * BM + r) * 1024 + col0;
#pragma unroll
                for (int bj = 0; bj < 2; ++bj)
#pragma unroll
                    for (int n = 0; n < 2; ++n) { f32x4 o = xv[mm][bj][n] + acc[ai][bj][m][n] * rs * gv[bj][n];
                        if (XD_BF16) { u32x2v w; w.x = cvt_pk_bf16(o[0], o[1]); w.y = cvt_pk_bf16(o[2], o[3]); *(u32x2v*)((bf16_t*)xd + off + bj * HALF + n * 16) = w;
                            o = (f32x4){__uint_as_float(w.x << 16), __uint_as_float(w.x & 0xffff0000u), __uint_as_float(w.y << 16), __uint_as_float(w.y & 0xffff0000u)}; }
                        else *(f32x4*)((float*)xd + off + bj * HALF + n * 16) = o;
                        acc[ai][bj][m][n] = o; } }
        }
        if (HAS_PRE) {
            PG8_LAS float* P = (PG8_LAS float*)lds;
            P += 2048;
#pragma unroll
            for (int ai = 0; ai < 2; ++ai)
#pragma unroll
                for (int m = 0; m < 4; ++m) {
                    float s = 0.f;
#pragma unroll
                    for (int bj = 0; bj < 2; ++bj)
#pragma unroll
                        for (int n = 0; n < 2; ++n) { const f32x4 x = acc[ai][bj][m][n]; s += (x[0] * x[0] + x[1] * x[1]) + (x[2] * x[2] + x[3] * x[3]); }
                    s += __shfl_xor(s, 16); s += __shfl_xor(s, 32);
                    if (fq == 0) P[(ai * HALF + wr * 64 + m * 16 + fr) * 4 + wc] = s;
                }
            asm volatile("s_waitcnt lgkmcnt(0)" ::: "memory"); __builtin_amdgcn_s_barrier(); asm volatile("" ::: "memory");
            if (lane < 32) { const int row = wid * 32 + lane; const f32x4 p = *(const PG8_LAS f32x4*)(P + row * 4);
                ssq_out[(size_t)(u.pm * BM + row) * 4 + u.pn] = (p[0] + p[1]) + (p[2] + p[3]); }
        }
    }
};
}
namespace pg8 {
template <class Epi, class Sched, bool ALIGN_EPI = false, bool SP2 = false>
__device__ __forceinline__ void gemm_phase(PG8_LAS unsigned char* lds, const Gemm g, const Sched& S, const Epi& E) {
    int tid = threadIdx.x; asm volatile("" : "+v"(tid)); const int wid = __builtin_amdgcn_readfirstlane(tid >> 6), lane = tid & 63, wr = wid >> 2, wc = wid & 3, fr = lane & 15, fq = lane >> 4;
    const int K = g.K, nt = K / BK;
    unsigned voffA[2], voffB[2];
#pragma unroll
    for (int i = 0; i < 2; ++i) { int R, C; stage_rc(tid * 16 + i * 8192, R, C); const int Rb = Epi::PERM ? ((R & ~31) + perm32(R & 31)) : R;
        voffA[i] = (unsigned)(R * K + C) * 2u; voffB[i] = (unsigned)(Rb * K + C) * 2u; }
    const size_t kstep = (size_t)(BK * 2);
    const size_t hstep = (size_t)HALF * K * 2;
    const size_t tstep = 2 * hstep;
    const unsigned ldsw = (unsigned)wid * 1024u;
    const int aoff = lds_byte(wr * 64 + fr, fq * 8), boff = lds_byte(wc * 32 + fr, fq * 8);
#define PG8_SA(b, h) (((b) * 2 + (h)) * HTB)
#define PG8_SB(b, h) ((4 + (b) * 2 + (h)) * HTB)
#define PG8_STAGE(bufoff, gbase, voff) do { _Pragma("unroll") for (int _i = 0; _i < 2; ++_i) \
        __builtin_amdgcn_global_load_lds((const unsigned*)((const char*)(gbase) + (voff)[_i]), (PG8_LAS unsigned*)(lds + (bufoff) + ldsw + _i * 8192), 16, 0, 0); } while (0)
#define PG8_LDA(dst, b, h) do { _Pragma("unroll") for (int m = 0; m < 4; ++m) _Pragma("unroll") for (int k = 0; k < 2; ++k) dst[m][k] = *(const PG8_LAS bf16x8*)(lds + PG8_SA(b, h) + aoff + m * 2048 + k * 1024); } while (0)
#define PG8_LDB(dst, b, h) do { _Pragma("unroll") for (int n = 0; n < 2; ++n) _Pragma("unroll") for (int k = 0; k < 2; ++k) dst[n][k] = *(const PG8_LAS bf16x8*)(lds + PG8_SB(b, h) + boff + n * 2048 + k * 1024); } while (0)
#define PG8_MMA(ai, bj, At, Bt) do { __builtin_amdgcn_s_setprio(1); _Pragma("unroll") for (int m = 0; m < 4; ++m) _Pragma("unroll") for (int n = 0; n < 2; ++n) _Pragma("unroll") for (int k = 0; k < 2; ++k) \
        acc[ai][bj][m][n] = __builtin_amdgcn_mfma_f32_16x16x32_bf16(Bt[n][k], At[m][k], acc[ai][bj][m][n], 0, 0, 0); __builtin_amdgcn_s_setprio(0); } while (0)
#define PG8_WAIT_V(n) asm volatile("s_waitcnt vmcnt(" #n ")" ::: "memory")
#define PG8_WAIT_L(n) asm volatile("s_waitcnt lgkmcnt(" #n ")" ::: "memory")
#define PG8_BAR __builtin_amdgcn_s_barrier()
#define PG8_SCHED __builtin_amdgcn_sched_barrier(0)
    Unit cur, nxt; int ui = 0;
    if (!S.next(0, cur)) return;
    f32x4 acc[2][2][4][2];
#pragma unroll
    for (int a = 0; a < 2; ++a)
#pragma unroll
        for (int b = 0; b < 2; ++b)
#pragma unroll
            for (int m = 0; m < 4; ++m)
#pragma unroll
                for (int n = 0; n < 2; ++n) acc[a][b][m][n] = (f32x4){0.f, 0.f, 0.f, 0.f};
    bf16x8 At[4][2], B0[2][2], B1[2][2];
    const char* cA = (const char*)g.A + (size_t)cur.pm * tstep; const char* cB = (const char*)g.Bt + (size_t)cur.pn * tstep;
    S.a_ready(cur);
    if constexpr (SP2) {
        PG8_STAGE(PG8_SB(0, 0), cB, voffB); PG8_STAGE(PG8_SB(0, 1), cB + hstep, voffB); PG8_STAGE(PG8_SA(0, 0), cA, voffA); PG8_STAGE(PG8_SA(0, 1), cA + hstep, voffA);
        if (wr == 1) PG8_BAR;
        PG8_WAIT_V(2); PG8_BAR;
        PG8_STAGE(PG8_SB(1, 0), cB + kstep, voffB); PG8_STAGE(PG8_SA(1, 0), cA + kstep, voffA); PG8_STAGE(PG8_SB(1, 1), cB + hstep + kstep, voffB);
        PG8_WAIT_V(6); PG8_BAR;
    } else {
        PG8_STAGE(PG8_SB(0, 0), cB, voffB); PG8_STAGE(PG8_SA(0, 0), cA, voffA); PG8_STAGE(PG8_SB(0, 1), cB + hstep, voffB); PG8_STAGE(PG8_SA(0, 1), cA + hstep, voffA);
        if (wr == 1) PG8_BAR;
        PG8_WAIT_V(4); PG8_BAR;
        PG8_STAGE(PG8_SB(1, 0), cB + kstep, voffB); PG8_STAGE(PG8_SA(1, 0), cA + kstep, voffA); PG8_STAGE(PG8_SB(1, 1), cB + hstep + kstep, voffB);
        PG8_WAIT_V(6); PG8_BAR;
    }
    for (;;) {
        const bool has_next = S.next(ui + 1, nxt);
        const char* nA = has_next ? (const char*)g.A + (size_t)nxt.pm * tstep : cA; const char* nB = has_next ? (const char*)g.Bt + (size_t)nxt.pn * tstep : cB;
        for (int t = 0; t < nt; t += 2) {
            const bool last = (t == nt - 2);
            const char* a1 = cA + (size_t)(t + 1) * kstep;
            const char* a2 = last ? nA : cA + (size_t)(t + 2) * kstep; const char* b2 = last ? nB : cB + (size_t)(t + 2) * kstep;
            const char* a3 = a2 + kstep; const char* b3 = b2 + kstep;
            if (last && has_next) S.a_ready(nxt);
            if constexpr (SP2) {
            PG8_LDB(B0, 0, 0); PG8_LDB(B1, 0, 1); PG8_SCHED; PG8_LDA(At, 0, 0); PG8_STAGE(PG8_SA(1, 1), a1 + hstep, voffA);
            PG8_WAIT_V(8); PG8_WAIT_L(0); PG8_BAR; PG8_MMA(0, 0, At, B0); PG8_MMA(0, 1, At, B1); PG8_BAR; PG8_SCHED;
            PG8_LDA(At, 0, 1); PG8_STAGE(PG8_SB(0, 0), b2, voffB); PG8_STAGE(PG8_SB(0, 1), b2 + hstep, voffB); PG8_STAGE(PG8_SA(0, 0), a2, voffA);
            PG8_WAIT_V(8); PG8_WAIT_L(0); PG8_BAR; PG8_MMA(1, 0, At, B0); PG8_MMA(1, 1, At, B1); PG8_BAR; PG8_SCHED;
            PG8_LDB(B0, 1, 0); PG8_LDB(B1, 1, 1); PG8_SCHED; PG8_LDA(At, 1, 0); PG8_STAGE(PG8_SA(0, 1), a2 + hstep, voffA);
            PG8_WAIT_V(8); PG8_WAIT_L(0); PG8_BAR; PG8_MMA(0, 0, At, B0); PG8_MMA(0, 1, At, B1); PG8_BAR; PG8_SCHED;
            PG8_LDA(At, 1, 1); PG8_STAGE(PG8_SB(1, 0), b3, voffB); PG8_STAGE(PG8_SB(1, 1), b3 + hstep, voffB); PG8_STAGE(PG8_SA(1, 0), a3, voffA);
            PG8_WAIT_V(8); PG8_WAIT_L(0); PG8_BAR; PG8_MMA(1, 0, At, B0); PG8_MMA(1, 1, At, B1); PG8_BAR; PG8_SCHED;
            } else {
            PG8_LDB(B0, 0, 0); PG8_SCHED; PG8_LDA(At, 0, 0); PG8_STAGE(PG8_SA(1, 1), a1 + hstep, voffA);
            PG8_WAIT_L(8); PG8_BAR; PG8_WAIT_L(0); PG8_MMA(0, 0, At, B0); PG8_BAR; PG8_SCHED;
            PG8_LDB(B1, 0, 1); PG8_STAGE(PG8_SB(0, 0), b2, voffB);
            PG8_BAR; PG8_WAIT_L(0); PG8_MMA(0, 1, At, B1); PG8_BAR;
            PG8_LDA(At, 0, 1); PG8_STAGE(PG8_SA(0, 0), a2, voffA);
            PG8_BAR; PG8_WAIT_L(0); PG8_MMA(1, 0, At, B0); PG8_BAR; PG8_SCHED;
            PG8_STAGE(PG8_SB(0, 1), b2 + hstep, voffB);
            PG8_WAIT_V(6); PG8_BAR; PG8_MMA(1, 1, At, B1); PG8_BAR;
            PG8_LDB(B0, 1, 0); PG8_SCHED; PG8_LDA(At, 1, 0); PG8_STAGE(PG8_SA(0, 1), a2 + hstep, voffA);
            PG8_WAIT_L(8); PG8_BAR; PG8_WAIT_L(0); PG8_MMA(0, 0, At, B0); PG8_BAR; PG8_SCHED;
            PG8_LDB(B1, 1, 1); PG8_STAGE(PG8_SB(1, 0), b3, voffB);
            PG8_BAR; PG8_WAIT_L(0); PG8_MMA(0, 1, At, B1); PG8_BAR;
            PG8_LDA(At, 1, 1); PG8_STAGE(PG8_SA(1, 0), a3, voffA);
            PG8_BAR; PG8_WAIT_L(0); PG8_MMA(1, 0, At, B0); PG8_BAR; PG8_SCHED;
            PG8_STAGE(PG8_SB(1, 1), b3 + hstep, voffB);
            PG8_WAIT_V(6); PG8_BAR; PG8_MMA(1, 1, At, B1); PG8_BAR;
            }
        }
        if constexpr (ALIGN_EPI) { if (wr == 0) PG8_BAR; }
        if constexpr (!Epi::AFTER_DRAIN) { E(acc, cur, wr, wc, fr, fq); S.done(cur); }
        if (!has_next) break;
#pragma unroll
        for (int a = 0; a < 2; ++a)
#pragma unroll
            for (int b = 0; b < 2; ++b)
#pragma unroll
                for (int m = 0; m < 4; ++m)
#pragma unroll
                    for (int n = 0; n < 2; ++n) acc[a][b][m][n] = (f32x4){0.f, 0.f, 0.f, 0.f};
        cur = nxt; cA = nA; cB = nB; ++ui;
        if constexpr (ALIGN_EPI) { if (wr == 1) PG8_BAR; }
    }
    PG8_WAIT_V(0);
    if constexpr (!ALIGN_EPI) { if (wr == 0) PG8_BAR; }
    PG8_BAR;
    if constexpr (Epi::AFTER_DRAIN) { E.fused(acc, cur, wr, wc, fr, fq, lds, wid, lane); S.done(cur); }
#undef PG8_SA
#undef PG8_SB
#undef PG8_STAGE
#undef PG8_LDA
#undef PG8_LDB
#undef PG8_MMA
#undef PG8_WAIT_V
#undef PG8_WAIT_L
#undef PG8_BAR
#undef PG8_SCHED
}
}
#include <hip/hip_cooperative_groups.h>
namespace cg = cooperative_groups;
#define LAS __attribute__((address_space(3)))
#define GAS __attribute__((address_space(1)))
typedef unsigned short bf16;
typedef float f32x4 __attribute__((ext_vector_type(4)));
typedef float f32x2 __attribute__((ext_vector_type(2)));
typedef short bf16x8 __attribute__((ext_vector_type(8)));
typedef unsigned u32x4 __attribute__((ext_vector_type(4)));
typedef unsigned u32x2 __attribute__((ext_vector_type(2)));

constexpr int T = 16384, D = 1024, DEPTH = 4, FF = 4096;
constexpr int ZLD = 4608, ZN = 4864, ABIN = 4624, MIXLD = 1536;
constexpr int ZSX = 0, ZSB = 512, ZSC = 1024, ZQ = 1536, ZK = 2048, ZV = 2560, ZG = 3584;
constexpr float EPS = 1e-6f;
constexpr int NWAVES = 8, NTHR = 512;
constexpr int LDS_BYTES = 147456;
constexpr size_t MiB = 1u << 20;
constexpr size_t WS_DEC = 256 * 1024;
constexpr size_t WS_BAR = 0;
constexpr size_t WS_EBL = 512 * 1024;
constexpr size_t WS_CNT = 16 * 1024;
constexpr size_t WS_X1 = 255 * MiB;
constexpr size_t WS_W = 1536 * 1024;
constexpr size_t WS_H = 30 * MiB;
constexpr size_t WS_BIG = 62 * MiB;
constexpr size_t WS_GK = 254 * MiB;
constexpr size_t WS_END = 255 * MiB + 256 * 1024;
constexpr size_t WO_MIX1 = 0;
constexpr size_t WO_MIX2_E = (size_t)ZN * D;
constexpr size_t WO_MIX2_O = (size_t)2048 * D;
constexpr size_t WO_W1 = (size_t)ZN * D + (size_t)D * MIXLD;
constexpr size_t WO_W2 = WO_W1 + (size_t)FF * D;
static_assert(WS_W + (WO_W2 + (size_t)FF * D) * 2 <= WS_H, "weights fit");

__device__ __forceinline__ int tid_l() { int t = threadIdx.x; asm volatile("" : "+v"(t)); return t; }
__device__ __forceinline__ float bf2f(unsigned b) { return __uint_as_float(b << 16); }
__device__ __forceinline__ unsigned pkbf(float lo, float hi) { return pg8::cvt_pk_bf16(lo, hi); }
template <int CTRL> __device__ __forceinline__ float dppf(float v) { return __builtin_bit_cast(float, __builtin_amdgcn_update_dpp(0, __builtin_bit_cast(int, v), CTRL, 0xf, 0xf, true)); }
__device__ __forceinline__ float row16_sum(float v) { v += dppf<0xB1>(v); v += dppf<0x4E>(v); v += dppf<0x141>(v); v += dppf<0x140>(v); return v; }
__device__ __forceinline__ float wave_sum(float v) {
    v = row16_sum(v);
    const int iv = __builtin_bit_cast(int, v);
    return (__builtin_bit_cast(float, __builtin_amdgcn_readlane(iv, 0)) + __builtin_bit_cast(float, __builtin_amdgcn_readlane(iv, 16))) + (__builtin_bit_cast(float, __builtin_amdgcn_readlane(iv, 32)) + __builtin_bit_cast(float, __builtin_amdgcn_readlane(iv, 48)));
}

template <int MODE, bool GAIN>
__device__ __forceinline__ void transpose_item(const float* W, int K, int N, bf16* WT, LAS float* scr, int item, int lane, const float* gain) {
    const int nblk = (N + 31) / 32, kb = item / nblk, nb = item % nblk, k0 = 64 * kb, n0 = 32 * nb;
    const bool ok = (n0 + (lane & 31)) < N;
    float tv[32];
#pragma unroll
    for (int i = 0; i < 32; ++i) { const int kk = 2 * i + (lane >> 5); tv[i] = ok ? W[(size_t)(k0 + kk) * N + n0 + (lane & 31)] : 0.f; }
#pragma unroll
    for (int i = 0; i < 32; ++i) { const int kk = 2 * i + (lane >> 5); scr[kk * 33 + (lane & 31)] = tv[i]; }
    asm volatile("s_waitcnt lgkmcnt(0)" ::: "memory");
    int d0 = n0;
    if (MODE == 1) { const int half = n0 >> 10, c0 = n0 & 1023; d0 = ((c0 >> 7) << 8) + (half << 7) + (c0 & 127); }
    const int c = lane & 7;
    f32x4 ga = (f32x4){1.f, 1.f, 1.f, 1.f}, gb = ga;
    if (GAIN) { ga = *(const f32x4*)(gain + k0 + 8 * c); gb = *(const f32x4*)(gain + k0 + 8 * c + 4); }
#pragma unroll
    for (int j = 0; j < 4; ++j) { const int n = (lane >> 3) + 8 * j; const LAS float* s = scr + (8 * c) * 33 + n;
        u32x4 o; o.x = pkbf(s[0 * 33] * ga.x, s[1 * 33] * ga.y); o.y = pkbf(s[2 * 33] * ga.z, s[3 * 33] * ga.w); o.z = pkbf(s[4 * 33] * gb.x, s[5 * 33] * gb.y); o.w = pkbf(s[6 * 33] * gb.z, s[7 * 33] * gb.w);
        *(u32x4*)(WT + (size_t)(d0 + n) * K + k0 + 8 * c) = o; }
    asm volatile("s_waitcnt lgkmcnt(0)" ::: "memory");
}

struct Args { const float* in[21]; float* out; unsigned char* ws; int ph_lo, ph_hi; };
__device__ __forceinline__ const float* inp(int i) { const __attribute__((address_space(4))) char* kp = (const __attribute__((address_space(4))) char*)__builtin_amdgcn_kernarg_segment_ptr(); asm volatile("" : "+s"(kp)); const float* p = *(const float* const __attribute__((address_space(4)))*)(kp + 8 * i); return (const float*)(const __attribute__((address_space(1))) float*)p; }

template <int PART>
__device__ __forceinline__ void convert_layer(unsigned char* wsp, int l, LAS unsigned char* lds, int gw, int NGW, int wave, int lane) {
    LAS float* scr = (LAS float*)(lds + wave * 8704);
    bf16* Wb_ = (bf16*)(wsp + WS_W);
    const int i2 = l >> 1;
    if (PART == 1) {
        const float* w1 = inp(19) + (size_t)l * D * FF; const float* w2 = inp(20) + (size_t)l * FF * D;
        constexpr int I_W1 = (D / 64) * (FF / 32), I_W2 = (FF / 64) * (D / 32);
        for (int it = gw; it < I_W1 + I_W2; it += NGW) {
            if (it < I_W1) transpose_item<0, true>(w1, D, FF, Wb_ + WO_W1, scr, it, lane, inp(3) + (size_t)l * D);
            else transpose_item<0, false>(w2, FF, D, Wb_ + WO_W2, scr, it - I_W1, lane, nullptr); }
    } else if ((l & 1) == 0) {
        const float* win = inp(5) + (size_t)i2 * D * ABIN; const float* wout = inp(10) + (size_t)i2 * MIXLD * D;
        constexpr int I_IN = (D / 64) * ((ABIN + 31) / 32), I_OUT = (MIXLD / 64) * (D / 32);
        for (int it = gw; it < I_IN + I_OUT; it += NGW) {
            if (it < I_IN) transpose_item<0, true>(win, D, ABIN, Wb_ + WO_MIX1, scr, it, lane, inp(1) + (size_t)l * D);
            else transpose_item<0, false>(wout, MIXLD, D, Wb_ + WO_MIX2_E, scr, it - I_IN, lane, nullptr); }
        u32x4* pz = (u32x4*)(Wb_ + WO_MIX1 + (size_t)4640 * D); const int nz = (ZN - 4640) * D / 8;
        for (int i = gw * 64 + lane; i < nz; i += NGW * 64) pz[i] = (u32x4){0u, 0u, 0u, 0u};
    } else {
        const float* pw1 = inp(11) + (size_t)i2 * D * 2048; const float* pw2 = inp(17) + (size_t)i2 * D * D;
        constexpr int I_P1 = (D / 64) * (2048 / 32), I_P2 = (D / 64) * (D / 32);
        for (int it = gw; it < I_P1 + I_P2; it += NGW) {
            if (it < I_P1) transpose_item<1, true>(pw1, D, 2048, Wb_ + WO_MIX1, scr, it, lane, inp(1) + (size_t)l * D);
            else transpose_item<0, false>(pw2, D, D, Wb_ + WO_MIX2_O, scr, it - I_P1, lane, nullptr); }
    }
}

__device__ __forceinline__ void prologue_rows(const float* xs, bf16* xb, float* ssx, int gw, int NGW, int lane) {
    for (int row = gw; row < T; row += 2 * NGW) {
        const int row2 = row + NGW;
        const f32x4* xa = (const f32x4*)(xs + (size_t)row * D) + lane; const f32x4* xc = (const f32x4*)(xs + (size_t)row2 * D) + lane;
        f32x4 va[4], vb[4];
#pragma unroll
        for (int j = 0; j < 4; ++j) { va[j] = xa[64 * j]; vb[j] = xc[64 * j]; }
        float sa = 0.f, sb = 0.f;
#pragma unroll
        for (int j = 0; j < 4; ++j) { sa += (va[j].x * va[j].x + va[j].y * va[j].y) + (va[j].z * va[j].z + va[j].w * va[j].w); sb += (vb[j].x * vb[j].x + vb[j].y * vb[j].y) + (vb[j].z * vb[j].z + vb[j].w * vb[j].w); }
        sa = wave_sum(sa); sb = wave_sum(sb);
        if (lane < 4) { ssx[(size_t)row * 4 + lane] = lane == 0 ? sa : 0.f; ssx[(size_t)row2 * 4 + lane] = lane == 0 ? sb : 0.f; }
        u32x2* ha = (u32x2*)(xb + (size_t)row * D) + lane; u32x2* hb = (u32x2*)(xb + (size_t)row2 * D) + lane;
#pragma unroll
        for (int j = 0; j < 4; ++j) { u32x2 wa, wb; wa.x = pkbf(va[j].x, va[j].y); wa.y = pkbf(va[j].z, va[j].w); wb.x = pkbf(vb[j].x, vb[j].y); wb.y = pkbf(vb[j].z, vb[j].w); ha[64 * j] = wa; hb[64 * j] = wb; }
    }
}

constexpr int G_QD = 0, G_KD = 17408, G_KLT = 34816, G_VT = 53248, G_P = 90112, G_SEG = 99328, G_EBL = 101376, G_SS = 101888, G_GT = 103936;
#define MFMA16(a, b, c) __builtin_amdgcn_mfma_f32_16x16x32_bf16(a, b, c, 0, 0, 0)
template <bool OUT>
__device__ __forceinline__ void gla_unit(int unit, bf16* z, const float* gklr, const float* wgk2, const float* bgk2, const float* normg, float* E, float* DEC, float* EBLG, bf16* mix, LAS unsigned char* lds) {
    const int tid = tid_l(), lane = tid & 63, w = __builtin_amdgcn_readfirstlane(tid >> 6), r = lane & 15, q = lane >> 4;
    const int g = unit >> 2, h = unit & 3;
    const int seg = w >> 1, k = (w & 1) * 64 + lane, hk = h * 128 + k;
    f32x4 S[8][2];
    GAS float* Eu = (GAS float*)E + (size_t)unit * 32768 + (size_t)w * 4096 + lane;
    if (OUT) {
#pragma unroll
        for (int mt = 0; mt < 8; ++mt)
#pragma unroll
            for (int nt = 0; nt < 2; ++nt)
#pragma unroll
                for (int i = 0; i < 4; ++i) S[mt][nt][i] = Eu[((mt * 2 + nt) * 4 + i) * 64];
    } else {
#pragma unroll
        for (int mt = 0; mt < 8; ++mt)
#pragma unroll
            for (int nt = 0; nt < 2; ++nt) S[mt][nt] = (f32x4){0.f, 0.f, 0.f, 0.f};
    }
    float bsum = 0.f;
    LAS float* SEG = (LAS float*)(lds + G_SEG); LAS float* EBL = (LAS float*)(lds + G_EBL); LAS float* SSQ = (LAS float*)(lds + G_SS);
    u32x4 qv4[2], kv4[2];
#define P3_LOAD(t0_) do { int tp_ = tid; asm volatile("" : "+v"(tp_)); \
        _Pragma("unroll") for (int i = 0; i < 2; ++i) { const int c = tp_ + 512 * i, row = c >> 4, c16 = c & 15; const GAS bf16* zr_ = (const GAS bf16*)z + (size_t)((t0_) + row) * ZLD + h * 128 + c16 * 8; \
            qv4[i] = *(const GAS u32x4*)(zr_ + ZQ); kv4[i] = *(const GAS u32x4*)(zr_ + ZK); } } while (0)
    if (OUT) P3_LOAD(g * 256);
    for (int ch = 0; ch < 4; ++ch) {
        const int t0 = g * 256 + ch * 64, cgl = g * 4 + ch;
        int tl = tid; asm volatile("" : "+v"(tl));
        if (!OUT) {
            GAS bf16* zq = (GAS bf16*)z + (size_t)(t0 + seg * 16) * ZLD + hk;
            unsigned short qraw[16], kraw[16];
#pragma unroll
            for (int jj = 0; jj < 16; ++jj) { qraw[jj] = zq[(size_t)jj * ZLD + ZQ]; kraw[jj] = zq[(size_t)jj * ZLD + ZK]; }
            float w2r[16];
#pragma unroll
            for (int i = 0; i < 16; ++i) w2r[i] = ((const GAS float*)wgk2)[i * 512 + hk];
            const float bias = ((const GAS float*)bgk2)[hk];
            if (tid < 256) *(LAS f32x4*)(lds + G_QD + tid * 16) = *(const GAS f32x4*)((const GAS float*)gklr + (size_t)t0 * 16 + tid * 4);
            __syncthreads();
            float b[16]; float run = 0.f;
#pragma unroll
            for (int jj = 0; jj < 16; ++jj) {
                const LAS f32x4* gp = (const LAS f32x4*)(lds + G_QD + (seg * 16 + jj) * 64);
                const f32x4 g0 = gp[0], g1 = gp[1], g2 = gp[2], g3 = gp[3];
                float gv = bias;
                gv += g0.x * w2r[0] + g0.y * w2r[1] + g0.z * w2r[2] + g0.w * w2r[3];
                gv += g1.x * w2r[4] + g1.y * w2r[5] + g1.z * w2r[6] + g1.w * w2r[7];
                gv += g2.x * w2r[8] + g2.y * w2r[9] + g2.z * w2r[10] + g2.w * w2r[11];
                gv += g3.x * w2r[12] + g3.y * w2r[13] + g3.z * w2r[14] + g3.w * w2r[15];
                const float ls = -(fmaxf(-gv, 0.f) + __logf(1.f + __expf(-fabsf(gv)))) * (1.f / 16.f);
                run += ls; b[jj] = run;
            }
            SEG[seg * 128 + k] = run;
            __syncthreads();
            float pre = 0.f, tot = 0.f;
#pragma unroll
            for (int s = 0; s < 4; ++s) { const float v = SEG[s * 128 + k]; tot += v; pre += (s < seg) ? v : 0.f; }
            if (seg == 0) { const float eb = __expf(tot); EBL[k] = eb; ((GAS float*)EBLG)[cgl * 512 + hk] = eb; bsum += tot; }
#pragma unroll
            for (int jj = 0; jj < 16; ++jj) {
                const int j = seg * 16 + jj; const float bb = b[jj] + pre;
                const float kv = bf2f(kraw[jj]), qv = bf2f(qraw[jj]);
                *(LAS bf16*)(lds + G_QD + (j * 136 + k) * 2) = (bf16)(pkbf(qv * 0.08838834764831845f * __expf(bb), 0.f) & 0xffffu);
                *(LAS bf16*)(lds + G_KD + (j * 136 + k) * 2) = (bf16)(pkbf(kv * __expf(-bb), 0.f) & 0xffffu);
            }
        } else {
            u32x4 gtv[4];
#pragma unroll
            for (int i = 0; i < 4; ++i) { const int c = tl + 512 * i, row = c >> 5, c16 = c & 31; gtv[i] = *(const GAS u32x4*)((const GAS bf16*)z + (size_t)(t0 + row) * ZLD + ZG + h * 256 + c16 * 8); }
            const float eb = ((const GAS float*)EBLG)[cgl * 512 + hk];
            asm volatile("" : "+v"(gtv[0]), "+v"(gtv[1]), "+v"(gtv[2]), "+v"(gtv[3]), "+v"(qv4[0]), "+v"(qv4[1]), "+v"(kv4[0]), "+v"(kv4[1]));
#pragma unroll
            for (int i = 0; i < 4; ++i) { const int c = tl + 512 * i, row = c >> 5, c16 = c & 31; *(LAS u32x4*)(lds + G_GT + row * 528 + c16 * 16) = gtv[i]; }
#pragma unroll
            for (int i = 0; i < 2; ++i) { const int c = tl + 512 * i, row = c >> 4, c16 = c & 15;
                *(LAS u32x4*)(lds + G_QD + row * 272 + c16 * 16) = qv4[i]; *(LAS u32x4*)(lds + G_KD + row * 272 + c16 * 16) = kv4[i]; }
            if (seg == 0) EBL[k] = eb;
        }
        u32x4 vv4[4];
#pragma unroll
        for (int i = 0; i < 4; ++i) { const int c = tl + 512 * i, row = c >> 5, c16 = c & 31; vv4[i] = *(const GAS u32x4*)((const GAS bf16*)z + (size_t)(t0 + row) * ZLD + ZV + h * 256 + c16 * 8); }
        asm volatile("" : "+v"(vv4[0]), "+v"(vv4[1]), "+v"(vv4[2]), "+v"(vv4[3]));
#pragma unroll
        for (int i = 0; i < 4; ++i) { const int c = tl + 512 * i, row = c >> 5, c16 = c & 31; *(LAS u32x4*)(lds + G_VT + row * 544 + c16 * 16) = vv4[i]; }
        __syncthreads();
        if (!OUT) {
#pragma unroll
            for (int i = 0; i < 2; ++i) { const int c = tl + 512 * i, row = c >> 4, c16 = c & 15; GAS bf16* zr = (GAS bf16*)z + (size_t)(t0 + row) * ZLD + h * 128 + c16 * 8;
                *(GAS u32x4*)(zr + ZQ) = *(const LAS u32x4*)(lds + G_QD + row * 272 + c16 * 16); *(GAS u32x4*)(zr + ZK) = *(const LAS u32x4*)(lds + G_KD + row * 272 + c16 * 16); }
        }
        if (OUT) {
            const int jt = w >> 1;
#pragma unroll
            for (int ii = 0; ii < 2; ++ii) {
                const int it = (w & 1) * 2 + ii;
                f32x4 pa = (f32x4){0.f, 0.f, 0.f, 0.f};
                if (jt <= it) {
#pragma unroll
                    for (int s = 0; s < 4; ++s) {
                        const bf16x8 A = *(const LAS bf16x8*)(lds + G_KD + ((16 * jt + r) * 136 + 32 * s + 8 * q) * 2);
                        const bf16x8 B = *(const LAS bf16x8*)(lds + G_QD + ((16 * it + r) * 136 + 32 * s + 8 * q) * 2);
                        pa = MFMA16(A, B, pa);
                    }
                    const int i_ = 16 * it + r;
#pragma unroll
                    for (int e = 0; e < 4; ++e) { const int j_ = 16 * jt + 4 * q + e; if (j_ > i_) pa[e] = 0.f; }
                }
                u32x2 pw; pw.x = pkbf(pa[0], pa[1]); pw.y = pkbf(pa[2], pa[3]);
                *(LAS u32x2*)(lds + G_P + ((16 * it + r) * 72 + 16 * jt + 4 * q) * 2) = pw;
            }
            __syncthreads();
        }
        bf16x8 Bv[2][2];
#pragma unroll
        for (int s2 = 0; s2 < 2; ++s2)
#pragma unroll
            for (int nt = 0; nt < 2; ++nt) {
                typedef short s16x4 __attribute__((ext_vector_type(4)));
                LAS unsigned char* ta = lds + G_VT + (32 * s2 + 8 * q + ((lane & 15) >> 2)) * 544 + (32 * w + 16 * nt + 4 * (lane & 3)) * 2;
                const s16x4 lo = __builtin_amdgcn_ds_read_tr16_b64_v4i16((LAS s16x4*)ta), hi = __builtin_amdgcn_ds_read_tr16_b64_v4i16((LAS s16x4*)(ta + 4 * 544));
                Bv[s2][nt] = (bf16x8){lo[0], lo[1], lo[2], lo[3], hi[0], hi[1], hi[2], hi[3]};
            }
        f32x4 o[4][2];
        if (OUT) {
#pragma unroll
            for (int mt = 0; mt < 4; ++mt)
#pragma unroll
                for (int nt = 0; nt < 2; ++nt) o[mt][nt] = (f32x4){0.f, 0.f, 0.f, 0.f};
#pragma unroll
            for (int s = 0; s < 4; ++s) {
                bf16x8 Sb[2];
#pragma unroll
                for (int nt = 0; nt < 2; ++nt) {
                    u32x4 t; t.x = pkbf(S[2 * s][nt][0], S[2 * s][nt][1]); t.y = pkbf(S[2 * s][nt][2], S[2 * s][nt][3]);
                    t.z = pkbf(S[2 * s + 1][nt][0], S[2 * s + 1][nt][1]); t.w = pkbf(S[2 * s + 1][nt][2], S[2 * s + 1][nt][3]);
                    Sb[nt] = __builtin_bit_cast(bf16x8, t);
                }
                u32x2 alo[4], ahi[4];
#pragma unroll
                for (int mt = 0; mt < 4; ++mt) {
                    alo[mt] = *(const LAS u32x2*)(lds + G_QD + ((16 * mt + r) * 136 + 32 * s + 4 * q) * 2);
                    ahi[mt] = *(const LAS u32x2*)(lds + G_QD + ((16 * mt + r) * 136 + 32 * s + 16 + 4 * q) * 2); }
#pragma unroll
                for (int mt = 0; mt < 4; ++mt) {
                    const bf16x8 A = __builtin_bit_cast(bf16x8, (u32x4){alo[mt].x, alo[mt].y, ahi[mt].x, ahi[mt].y});
#pragma unroll
                    for (int nt = 0; nt < 2; ++nt) o[mt][nt] = MFMA16(A, Sb[nt], o[mt][nt]);
                }
            }
#pragma unroll
            for (int s2 = 0; s2 < 2; ++s2) {
                bf16x8 Ap[4];
#pragma unroll
                for (int mt = 0; mt < 4; ++mt) Ap[mt] = *(const LAS bf16x8*)(lds + G_P + ((16 * mt + r) * 72 + 32 * s2 + 8 * q) * 2);
#pragma unroll
                for (int mt = 0; mt < 4; ++mt)
#pragma unroll
                    for (int nt = 0; nt < 2; ++nt) o[mt][nt] = MFMA16(Ap[mt], Bv[s2][nt], o[mt][nt]);
            }
        }
#pragma unroll
        for (int mt = 0; mt < 8; ++mt) {
            bf16x8 Ak[2]; const f32x4 ebv = *(const LAS f32x4*)(lds + G_EBL + (16 * mt + 4 * q) * 4);
#pragma unroll
            for (int s2 = 0; s2 < 2; ++s2) { typedef short s16x4 __attribute__((ext_vector_type(4)));
                LAS unsigned char* ta = lds + G_KD + (32 * s2 + 8 * q + ((lane & 15) >> 2)) * 272 + (16 * mt + 4 * (lane & 3)) * 2;
                const s16x4 lo = __builtin_amdgcn_ds_read_tr16_b64_v4i16((LAS s16x4*)ta), hi = __builtin_amdgcn_ds_read_tr16_b64_v4i16((LAS s16x4*)(ta + 4 * 272));
                Ak[s2] = (bf16x8){lo[0], lo[1], lo[2], lo[3], hi[0], hi[1], hi[2], hi[3]}; }
#pragma unroll
            for (int s2 = 0; s2 < 2; ++s2)
#pragma unroll
                for (int nt = 0; nt < 2; ++nt) S[mt][nt] = MFMA16(Ak[s2], Bv[s2][nt], S[mt][nt]);
#pragma unroll
            for (int nt = 0; nt < 2; ++nt) S[mt][nt] = S[mt][nt] * ebv;
        }
        if (OUT && ch < 3) P3_LOAD(t0 + 64);
        if (OUT) {
#pragma unroll
            for (int mt = 0; mt < 4; ++mt)
#pragma unroll
                for (int e = 0; e < 4; ++e) {
                    float s = o[mt][0][e] * o[mt][0][e] + o[mt][1][e] * o[mt][1][e];
                    s = row16_sum(s);
                    if (r == 0) SSQ[(16 * mt + 4 * q + e) * 8 + w] = s;
                }
            __syncthreads();
            const float ng0 = ((const GAS float*)normg)[32 * w + r], ng1 = ((const GAS float*)normg)[32 * w + 16 + r];
#pragma unroll
            for (int mt = 0; mt < 4; ++mt)
#pragma unroll
                for (int e = 0; e < 4; ++e) {
                    const int i_ = 16 * mt + 4 * q + e;
                    const f32x4 sa = *(const LAS f32x4*)(lds + G_SS + i_ * 32), sb = *(const LAS f32x4*)(lds + G_SS + i_ * 32 + 16);
                    const float tot2 = ((sa.x + sa.y) + (sa.z + sa.w)) + ((sb.x + sb.y) + (sb.z + sb.w));
                    const float rs = __builtin_amdgcn_rsqf(tot2 * (1.f / 256.f) + EPS);
                    LAS bf16* gp = (LAS bf16*)(lds + G_GT + i_ * 528 + (32 * w + r) * 2);
                    const float ga = bf2f(gp[0]), gb = bf2f(gp[16]);
                    const float va = o[mt][0][e] * rs * ng0 * ga * __builtin_amdgcn_rcpf(1.f + __expf(-ga));
                    const float vb = o[mt][1][e] * rs * ng1 * gb * __builtin_amdgcn_rcpf(1.f + __expf(-gb));
                    const unsigned pv = pkbf(va, vb);
                    gp[0] = (bf16)(pv & 0xffffu); gp[16] = (bf16)(pv >> 16);
                }
            __syncthreads();
#pragma unroll
            for (int i = 0; i < 4; ++i) { const int c = tl + 512 * i, row = c >> 5, c16 = c & 31;
                *(GAS u32x4*)((GAS bf16*)mix + (size_t)(t0 + row) * MIXLD + 512 + h * 256 + c16 * 8) = *(const LAS u32x4*)(lds + G_GT + row * 528 + c16 * 16); }
        }
        __syncthreads();
    }
    if (!OUT) {
#pragma unroll
        for (int mt = 0; mt < 8; ++mt)
#pragma unroll
            for (int nt = 0; nt < 2; ++nt)
#pragma unroll
                for (int i = 0; i < 4; ++i) Eu[((mt * 2 + nt) * 4 + i) * 64] = S[mt][nt][i];
        if (seg == 0) DEC[unit * 128 + k] = __expf(bsum);
    }
}
#undef P3_LOAD

__device__ __forceinline__ void shortconv(const bf16* z, const float* wsc, bf16* mix, int gtid, int gthreads) {
    for (int idx = gtid; idx < (T / 8) * 256; idx += gthreads) {
        const int tb = (idx >> 8) * 8, c = (idx & 255) * 2;
        unsigned x2[10], c2[10], b2[8];
#pragma unroll
        for (int r = 0; r < 10; ++r) { const int tt = tb - 2 + r, tc = tt < 0 ? 0 : tt; const bf16* zr = z + (size_t)tc * ZLD + c; x2[r] = *(const unsigned*)(zr + ZSX); c2[r] = *(const unsigned*)(zr + ZSC); }
#pragma unroll
        for (int o = 0; o < 8; ++o) b2[o] = *(const unsigned*)(z + (size_t)(tb + o) * ZLD + ZSB + c);
        f32x2 wj[3];
#pragma unroll
        for (int j = 0; j < 3; ++j) wj[j] = *(const f32x2*)(wsc + j * 512 + c);
        float m0[10], m1[10];
#pragma unroll
        for (int r = 0; r < 10; ++r) { const bool ok = (tb - 2 + r) >= 0; m0[r] = ok ? bf2f(x2[r] & 0xffffu) * bf2f(c2[r] & 0xffffu) : 0.f; m1[r] = ok ? bf2f(x2[r] >> 16) * bf2f(c2[r] >> 16) : 0.f; }
#pragma unroll
        for (int o = 0; o < 8; ++o) {
            const float a0 = wj[0].x * m0[o] + wj[1].x * m0[o + 1] + wj[2].x * m0[o + 2], a1 = wj[0].y * m1[o] + wj[1].y * m1[o + 1] + wj[2].y * m1[o + 2];
            *(unsigned*)(mix + (size_t)(tb + o) * MIXLD + c) = pkbf(bf2f(b2[o] & 0xffffu) * a0, bf2f(b2[o] >> 16) * a1);
        }
    }
}

__device__ __forceinline__ void gla_scan(float* E, const float* DEC, int gtid, int gthreads) {
    for (int e = gtid; e < 4 * 32768; e += gthreads) {
        const int h = e >> 15, rem = e & 32767, rr = (rem >> 6) & 63, ln = rem & 63;
        const int k = 16 * (rr >> 3) + 4 * (ln >> 4) + (rr & 3);
        float* p = E + (size_t)h * 32768 + rem; const float* dp = DEC + h * 128 + k;
        float s = 0.f;
#pragma unroll 1
        for (int gb = 0; gb < 64; gb += 16) {
            float tv[16], dv[16];
#pragma unroll
            for (int i = 0; i < 16; ++i) { tv[i] = p[(size_t)(gb + i) * 4 * 32768]; dv[i] = dp[(gb + i) * 512]; }
#pragma unroll
            for (int i = 0; i < 16; ++i) { p[(size_t)(gb + i) * 4 * 32768] = s; s = dv[i] * s + tv[i]; }
        }
    }
}

__device__ __forceinline__ void conv_phase(const bf16* u, const float* wdw, const float* bdw, const float* lng, const float* lnb, bf16* dout, LAS unsigned char* lds, int G, int bid) {
    const int tid = tid_l(), lane = tid & 63, w = tid >> 6;
    LAS unsigned* UL = (LAS unsigned*)lds;
    LAS f32x2* RED = (LAS f32x2*)(lds + 126976);
    LAS f32x2* STAT = (LAS f32x2*)(lds + 126976 + 2048);
    f32x2 wv[31];
#pragma unroll
    for (int j = 0; j < 31; ++j) wv[j] = *(const f32x2*)(wdw + j * 1024 + 2 * tid);
    const f32x2 bd = *(const f32x2*)(bdw + 2 * tid), lg = *(const f32x2*)(lng + 2 * tid), lb = *(const f32x2*)(lnb + 2 * tid);
    for (int tile = bid; tile < T / 32; tile += G) {
        const int t0 = tile * 32;
#pragma unroll 1
        for (int hb = 0; hb < 2; ++hb) {
            u32x4 sv[8];
#pragma unroll
            for (int it = 0; it < 8; ++it) { const int i = tid + (hb * 8 + it) * NTHR; int rr = i >> 7; rr = rr > 61 ? 61 : rr; const int cc = i & 127, t = t0 - 30 + rr, tc = t < 0 ? 0 : t;
                sv[it] = *(const u32x4*)(u + (size_t)tc * D + cc * 8); if (t < 0) sv[it] = (u32x4){0u, 0u, 0u, 0u}; }
#pragma unroll
            for (int it = 0; it < 8; ++it) { const int i = tid + (hb * 8 + it) * NTHR, rr = i >> 7, cc = i & 127; if (i < 62 * 128) *(LAS u32x4*)(lds + rr * 2048 + cc * 16) = sv[it]; }
        }
        __syncthreads();
#pragma unroll 1
        for (int sub = 0; sub < 2; ++sub) {
            f32x2 dv[16];
#pragma unroll
            for (int tt = 0; tt < 16; ++tt) dv[tt] = bd;
            const LAS unsigned* ULs = UL + sub * 16 * 512 + tid;
#pragma unroll
            for (int rb = 0; rb < 48; rb += 8) {
                unsigned ub[8];
#pragma unroll
                for (int i = 0; i < 8; ++i) ub[i] = (rb + i < 46) ? ULs[(rb + i) * 512] : 0u;
                asm volatile("" : "+v"(ub[0]), "+v"(ub[1]), "+v"(ub[2]), "+v"(ub[3]), "+v"(ub[4]), "+v"(ub[5]), "+v"(ub[6]), "+v"(ub[7]));
#pragma unroll
                for (int i = 0; i < 8; ++i) { const int rr = rb + i; if (rr < 46) { const f32x2 u2 = (f32x2){bf2f(ub[i] & 0xffffu), bf2f(ub[i] >> 16)};
#pragma unroll
                    for (int tt = 0; tt < 16; ++tt) { if (rr - tt >= 0 && rr - tt <= 30) dv[tt] = __builtin_elementwise_fma(wv[rr - tt], u2, dv[tt]); } } }
            }
#pragma unroll
            for (int tt = 0; tt < 16; ++tt) {
                float s1 = dv[tt].x + dv[tt].y, s2 = dv[tt].x * dv[tt].x + dv[tt].y * dv[tt].y;
                s1 = wave_sum(s1); s2 = wave_sum(s2);
                if (lane == 0) RED[tt * 8 + w] = (f32x2){s1, s2};
            }
            __syncthreads();
            if (tid < 16) { float s1 = 0.f, s2 = 0.f;
#pragma unroll
                for (int i = 0; i < 8; ++i) { const f32x2 t = RED[tid * 8 + i]; s1 += t.x; s2 += t.y; }
                const float mean = s1 * (1.f / D); const float var = fmaxf(s2 * (1.f / D) - mean * mean, 0.f);
                STAT[tid] = (f32x2){mean, __builtin_amdgcn_rsqf(var + EPS)}; }
            __syncthreads();
#pragma unroll
            for (int tt = 0; tt < 16; ++tt) {
                const f32x2 st = STAT[tt];
                const float a = (dv[tt].x - st.x) * st.y * lg.x + lb.x, b = (dv[tt].y - st.x) * st.y * lg.y + lb.y;
                const float sa = a * __builtin_amdgcn_rcpf(1.f + __expf(-a)), sb = b * __builtin_amdgcn_rcpf(1.f + __expf(-b));
                *(unsigned*)(dout + (size_t)(t0 + sub * 16 + tt) * D + 2 * tid) = pkbf(sa, sb);
            }
        }
        __syncthreads();
    }
}

#define XB_TMO      128
#define XB_XCNT(j)  (256  + 64 * (j))
#define XB_XSUB(j)  (1280 + 64 * (j))
#define XB_XGEN(j)  (2304 + 64 * (j))
#define XB_TOP      3328
#define XB_TOPGEN   3392
#define XCD_BAR_WORDS 3456
#define XB_SPIN_CAP (1u << 18)

__device__ __forceinline__ unsigned xb_ld(unsigned* p)              { return __hip_atomic_load(p, __ATOMIC_RELAXED, __HIP_MEMORY_SCOPE_AGENT); }
__device__ __forceinline__ unsigned xb_add(unsigned* p, unsigned v) { return __hip_atomic_fetch_add(p, v, __ATOMIC_RELAXED, __HIP_MEMORY_SCOPE_AGENT); }
__device__ __forceinline__ unsigned xb_xcc_id() { return (unsigned)__builtin_amdgcn_s_getreg((3 << 11) | 20) & 0xFu; }
#define XB_SPIN(cond, bar) do { unsigned _sp = 0; while (cond) { __builtin_amdgcn_s_sleep(1); \
    if ((++_sp & 255u) == 0u) { if (xb_ld(&(bar)[XB_TMO])) break; if (_sp > XB_SPIN_CAP) { atomicAdd(&(bar)[XB_TMO], 1u); break; } } } } while (0)

struct XcdBarrier {
    unsigned* bar; unsigned x;
    volatile LAS unsigned* st;
};

__device__ __forceinline__ XcdBarrier xcd_barrier_post(unsigned* bar, volatile LAS unsigned* st) {
    XcdBarrier b; b.bar = bar; b.x = xb_xcc_id(); b.st = st;
    if (threadIdx.x == 0) (void)xb_add(&bar[XB_XCNT(b.x)], 1u);
    return b;
}
__device__ __forceinline__ void xcd_barrier_complete(unsigned* bar, unsigned x, unsigned& nloc, unsigned& nx) {
    const unsigned G = gridDim.x * gridDim.y * gridDim.z;
    unsigned sum, cnt, mine, sp = 0u;
    for (;;) {
        sum = 0u; cnt = 0u; mine = 0u;
#pragma unroll
        for (unsigned j = 0; j < 16; ++j) { const unsigned c = xb_ld(&bar[XB_XCNT(j)]); sum += c; cnt += (c > 0u) ? 1u : 0u; mine = (j == x) ? c : mine; }
        if (sum == G) break;
        __builtin_amdgcn_s_sleep(1);
        if ((++sp & 255u) == 0u) { if (xb_ld(&bar[XB_TMO])) break; if (sp > XB_SPIN_CAP) { atomicAdd(&bar[XB_TMO], 1u); break; } }
    }
    nloc = mine > 0u ? mine : 1u; nx = cnt > 0u ? cnt : 1u;
}

__device__ __forceinline__ void xcd_barrier(const XcdBarrier& b) {
    asm volatile("s_waitcnt vmcnt(0)" ::: "memory");
    __syncthreads();
    if (threadIdx.x == 0) {
        unsigned* bar = b.bar; asm volatile("" : "+s"(bar));
        unsigned bx = (unsigned)__builtin_amdgcn_readfirstlane((int)b.x); asm volatile("" : "+s"(bx));
        __builtin_amdgcn_s_waitcnt(0);
        unsigned nloc = b.st[0], nx = b.st[1];
        if (nloc == 0u) { xcd_barrier_complete(bar, bx, nloc, nx); b.st[0] = nloc; b.st[1] = nx; }
        const unsigned old = xb_add(&bar[XB_XSUB(bx)], 1u);
        const unsigned gen = old / nloc;
        if (old + 1u == (gen + 1u) * nloc) {
            __builtin_amdgcn_fence(__ATOMIC_RELEASE, "agent");
            asm volatile("s_waitcnt vmcnt(0)" ::: "memory");
            const unsigned og = xb_add(&bar[XB_TOP], 1u);
            const unsigned tg = og / nx;
            if (og + 1u == (tg + 1u) * nx) xb_add(&bar[XB_TOPGEN], 1u);
            else XB_SPIN(xb_ld(&bar[XB_TOPGEN]) == tg, bar);
            __builtin_amdgcn_fence(__ATOMIC_ACQUIRE, "agent");
            xb_add(&bar[XB_XGEN(bx)], 1u);
            asm volatile("s_waitcnt vmcnt(0)" ::: "memory");
        } else {
            XB_SPIN(xb_ld(&bar[XB_XGEN(bx)]) == gen, bar);
            __builtin_amdgcn_fence(__ATOMIC_ACQUIRE, "agent");
            asm volatile("s_waitcnt vmcnt(0)" ::: "memory");
        }
    }
    __syncthreads();
}

__global__ void __launch_bounds__(NTHR, 2) trunk_fwd(Args a) {
    extern __shared__ __attribute__((aligned(16))) unsigned char lds_raw[];
    LAS unsigned char* lds = (LAS unsigned char*)lds_raw;
    cg::grid_group grid = cg::this_grid();
    { volatile LAS unsigned* st0 = (volatile LAS unsigned*)(lds + LDS_BYTES - 16); if (threadIdx.x < 4) st0[threadIdx.x] = 0u; }
    __syncthreads();
    const XcdBarrier xbar = xcd_barrier_post((unsigned*)(a.ws + WS_BAR), (volatile LAS unsigned*)(lds + LDS_BYTES - 16));
    const int G0 = gridDim.x;
    if (a.ph_lo == 0x7fffffff) grid.sync();
#define IDS int bid = blockIdx.x; asm volatile("" : "+s"(bid)); const int tid = tid_l(), lane = tid & 63, wave = __builtin_amdgcn_readfirstlane(tid >> 6), gw = bid * NWAVES + wave, gtid = bid * NTHR + tid; (void)lane; (void)gw; (void)gtid;
    unsigned char* ws = a.ws; float* const xout = a.out;
#define Wb ((bf16*)(wsl + WS_W))
#define Eb ((float*)(wsl + WS_H))
#define DEC ((float*)(wsl + WS_DEC))
#define GK ((float*)(wsl + WS_GK))
#define EBLG ((float*)(wsl + WS_EBL))
#define big (wsl + WS_BIG)
#define Z ((bf16*)big)
#define MIX ((bf16*)(big + 144 * MiB))
#define U ((bf16*)big)
#define Dd ((bf16*)(big + 32 * MiB))
#define Ab ((bf16*)big)
#define ymlp ((float*)(big + 128 * MiB))
#define XB ((bf16*)xout)
#define XB2 ((bf16*)(big + 128 * MiB))
#define ymix ((float*)(big + ((l & 1) ? 64 * MiB : 0)))
#ifndef WGM_G1
#define WGM_G1 4
#endif
#ifndef WGM_G5
#define WGM_G5 4
#endif
#ifndef WGM_G3
#define WGM_G3 4
#endif
#ifndef PH_LO
#define PH_LO 0
#endif
#ifndef PH_HI
#define PH_HI 25
#endif
    constexpr int lo = PH_LO, hi = PH_HI;
#ifndef PROBE_MASK
#define PROBE_MASK 0u
#endif
#ifndef PROBE_MUL
#define PROBE_MUL 1
#endif
    unsigned long long pr_prev = PROBE_MASK ? __builtin_amdgcn_s_memrealtime() : 0ull, pr_acc = 0ull;
#define PR_STAMP() do { if (PROBE_MASK) { const unsigned long long t_ = __builtin_amdgcn_s_memrealtime(); if ((PROBE_MASK >> ph) & 1u) pr_acc += t_ - pr_prev; pr_prev = t_; } } while (0)
    int ph = 0;
#define PH_BEGIN if (ph >= lo && ph < hi) { IDS size_t wzo = 0; asm volatile("" : "+s"(wzo)); unsigned char* wsl = ws + wzo; int G = G0; asm volatile("" : "+s"(G)); const int NGW = G * NWAVES, gthreads = G * NTHR; (void)NGW; (void)gthreads;
#define PH_END   if (ph + 1 < hi) xcd_barrier(xbar); } PR_STAMP(); ++ph;

#define STATS(bank) pg8::RmsStats{(float*)(wsl + WS_X1), (unsigned*)(wsl + WS_CNT) + (size_t)(bank) * 4096}
#define SSX(i) ((float*)(wsl + WS_H))
#define RSTD_TAB_OFF 131072
#define FILL_RSTD_TAB(ssx_) do { LAS float* tab_ = (LAS float*)(lds + RSTD_TAB_OFF); const int rb_ = (bid & 7) * 2048; \
        for (int i_ = tid; i_ < 2048; i_ += NTHR) tab_[i_] = pg8::row_rstd((ssx_), rb_ + i_); __syncthreads(); } while (0)
    PH_BEGIN
        convert_layer<0>(wsl, 0, lds, gw, NGW, wave, lane);
        prologue_rows(inp(0), XB, SSX(0), gw, NGW, lane);
    PH_END

    for (int l = 0; l < DEPTH; ++l) {
        const int i2 = l >> 1;
        const bool first = (l == 0);
        if ((l & 1) == 0) {
            PH_BEGIN
                if (bid >= 192) { convert_layer<1>(wsl, l, lds, (bid - 192) * NWAVES + wave, 64 * NWAVES, wave, lane); __syncthreads(); }
                pg8::Gemm g{XB, Wb + WO_MIX1, T, ZN, D}; pg8::StaticOrder S; S.init(T, ZN, G, bid, WGM_G1);
                FILL_RSTD_TAB(SSX(2 * l));
                pg8::EpiZ E{Z, GK, (const LAS float*)(lds + RSTD_TAB_OFF)};
                pg8::gemm_phase<pg8::EpiZ, pg8::StaticOrder, true, true>(lds, g, S, E);
            PH_END
            PH_BEGIN
                for (int un = bid; un < 256; un += G)
                    gla_unit<false>(un, Z, GK, inp(6) + (size_t)i2 * 16 * 512, inp(7) + (size_t)i2 * 512, inp(9) + (size_t)i2 * 256, Eb, DEC, EBLG, MIX, lds);
                shortconv(Z, inp(8) + (size_t)i2 * 3 * 512, MIX, gtid, gthreads);
            PH_END
            PH_BEGIN
                gla_scan(Eb, DEC, gtid, gthreads);
            PH_END
            PH_BEGIN
                for (int un = bid; un < 256; un += G)
                    gla_unit<true>(un, Z, GK, inp(6) + (size_t)i2 * 16 * 512, inp(7) + (size_t)i2 * 512, inp(9) + (size_t)i2 * 256, Eb, DEC, EBLG, MIX, lds);
            PH_END
            PH_BEGIN
                pg8::Gemm g{MIX, Wb + WO_MIX2_E, T, D, MIXLD}; pg8::StaticOrder S; S.init(T, D, G, bid);
                if (first) { pg8::EpiNorm<false, true, false, true> E{inp(0), XB, SSX(2 * l + 1), nullptr, inp(2) + (size_t)l * D, STATS(2 * l)};
                    pg8::gemm_phase<pg8::EpiNorm<false, true, false, true>, pg8::StaticOrder, false, true>(lds, g, S, E); }
                else { pg8::EpiNorm<false, true, true, true> E{XB, XB, SSX(2 * l + 1), nullptr, inp(2) + (size_t)l * D, STATS(2 * l)};
                    pg8::gemm_phase<pg8::EpiNorm<false, true, true, true>, pg8::StaticOrder, false, true>(lds, g, S, E); }
            PH_END
        } else {
            PH_BEGIN
                pg8::Gemm g{XB, Wb + WO_MIX1, T, 2048, D}; pg8::StaticOrder S; S.init(T, 2048, G, bid, WGM_G5);
                FILL_RSTD_TAB(SSX(2 * l));
                pg8::EpiGLU E{U, inp(12) + (size_t)i2 * 2048, (const LAS float*)(lds + RSTD_TAB_OFF)};
                pg8::gemm_phase<pg8::EpiGLU, pg8::StaticOrder, true, true>(lds, g, S, E);
            PH_END
            PH_BEGIN
                convert_layer<1>(wsl, l, lds, gw, NGW, wave, lane);
                __syncthreads();
                conv_phase(U, inp(13) + (size_t)i2 * 31 * D, inp(14) + (size_t)i2 * D, inp(15) + (size_t)i2 * D, inp(16) + (size_t)i2 * D, Dd, lds, G, bid);
            PH_END
            PH_BEGIN
                pg8::Gemm g{Dd, Wb + WO_MIX2_O, T, D, D}; pg8::StaticOrder S; S.init(T, D, G, bid);
                pg8::EpiNorm<true, true, true, true> E{XB, (l + 1 < DEPTH) ? (void*)XB : (void*)XB2, SSX(2 * l + 1), inp(18) + (size_t)i2 * D, inp(2) + (size_t)l * D, STATS(2 * l)};
                pg8::gemm_phase<pg8::EpiNorm<true, true, true, true>, pg8::StaticOrder, false, true>(lds, g, S, E);
            PH_END
        }
        PH_BEGIN
            if (l + 1 < DEPTH) { convert_layer<0>(wsl, l + 1, lds, gw, NGW, wave, lane); __syncthreads(); }
            pg8::Gemm g{(l + 1 < DEPTH) ? XB : XB2, Wb + WO_W1, T, FF, D}; pg8::StaticOrder S; S.init(T, FF, G, bid, WGM_G3);
            FILL_RSTD_TAB(SSX(2 * l + 1));
            pg8::EpiRelu2 E{Ab, FF, (const LAS float*)(lds + RSTD_TAB_OFF)};
            pg8::gemm_phase<pg8::EpiRelu2, pg8::StaticOrder, true, true>(lds, g, S, E);
        PH_END
        PH_BEGIN
            pg8::Gemm g{Ab, Wb + WO_W2, T, D, FF}; pg8::StaticOrder S; S.init(T, D, G, bid);
            if (l + 1 < DEPTH) { pg8::EpiNorm<false, true, true, true> E{XB, XB, SSX(2 * l + 2), nullptr, inp(4) + (size_t)l * D, STATS(2 * l + 1)};
                pg8::gemm_phase<pg8::EpiNorm<false, true, true, true>, pg8::StaticOrder, false, true>(lds, g, S, E); }
            else { pg8::EpiNorm<false, false, true, false> E{XB2, xout, nullptr, nullptr, inp(4) + (size_t)l * D, STATS(2 * l + 1)};
                pg8::gemm_phase<pg8::EpiNorm<false, false, true, false>, pg8::StaticOrder, false, true>(lds, g, S, E); }
        PH_END
    }
    if (PROBE_MASK) { if (blockIdx.x == 0) { const unsigned long long t_end = __builtin_amdgcn_s_memrealtime(); while (__builtin_amdgcn_s_memrealtime() - t_end < pr_acc * PROBE_MUL) __builtin_amdgcn_s_sleep(8); } }
}

extern "C" void kernel_launch(void* const* d_in, const int* in_sizes, int n_in, void* d_out, int out_size, void* d_ws, size_t ws_size, hipStream_t stream) {
    static int grid = 0;
    if (grid == 0) {
        if (n_in != 21 || out_size != T * D || ws_size < WS_END) { fprintf(stderr, "kernel_launch: unexpected shapes (n_in %d out %d ws %zu)\n", n_in, out_size, ws_size); grid = -1; return; }
        int dev = 0, cus = 0, per_cu = 0;
        hipGetDevice(&dev); hipDeviceGetAttribute(&cus, hipDeviceAttributeMultiprocessorCount, dev);
        if (hipFuncSetAttribute((const void*)trunk_fwd, hipFuncAttributeMaxDynamicSharedMemorySize, LDS_BYTES) != hipSuccess) { fprintf(stderr, "kernel_launch: hipFuncSetAttribute failed\n"); grid = -1; return; }
        if (hipOccupancyMaxActiveBlocksPerMultiprocessor(&per_cu, (const void*)trunk_fwd, NTHR, LDS_BYTES) != hipSuccess || per_cu < 1) { fprintf(stderr, "kernel_launch: occupancy query failed (%d)\n", per_cu); (void)hipGetLastError(); per_cu = 1; }
        grid = cus * per_cu; if (grid > 256) grid = 256;
        if (grid != 256) { fprintf(stderr, "kernel_launch: this kernel needs exactly 256 co-resident workgroups (got %d)\n", grid); grid = -1; return; }
    }
    if (grid < 0) return;
    Args a{};
    for (int i = 0; i < 21; ++i) a.in[i] = (const float*)d_in[i];
    a.out = (float*)d_out; a.ws = (unsigned char*)d_ws; a.ph_lo = 0; a.ph_hi = 25;
    if (hipMemsetAsync(d_ws, 0, 144u * 1024u, stream) != hipSuccess) { fprintf(stderr, "kernel_launch: memset failed\n"); return; }
    void* args[] = {&a};
    hipError_t e = hipLaunchCooperativeKernel((const void*)trunk_fwd, dim3(grid), dim3(NTHR), args, LDS_BYTES, stream);
    if (e != hipSuccess) fprintf(stderr, "cooperative launch failed: %s (grid %d)\n", hipGetErrorString(e), grid);
}
```

```cpp
#include <hip/hip_runtime.h>
#include <cstdio>
#include <cstdint>
namespace pg8 {
#define PG8_LAS __attribute__((address_space(3)))
typedef unsigned short bf16_t;
typedef short bf16x8 __attribute__((ext_vector_type(8)));
typedef float f32x4 __attribute__((ext_vector_type(4)));
typedef unsigned u32x4 __attribute__((ext_vector_type(4)));
constexpr int BM = 256, BK = 64, HALF = 128, HTB = HALF * BK * 2  , STAGE_BYTES = 8 * HTB, NXCD = 8, WGM = 4;

__host__ __device__ __forceinline__ int lds_byte(int r, int c) { const int st = (r >> 4) * 2 + (c >> 5), rr = r & 15, cc = c & 31, ob = rr * 64 + cc * 2; return st * 1024 + (ob ^ (((ob >> 9) & 1) << 5)); }
__host__ __device__ __forceinline__ void stage_rc(int b, int& R, int& C) { const int st = b / 1024, sb = b % 1024, swz = sb ^ (((sb >> 9) & 1) << 5); R = (st >> 1) * 16 + swz / 64; C = (st & 1) * 32 + (swz % 64) / 2; }
__host__ __device__ __forceinline__ int perm32(int rho) { const int n = rho >> 4, i = rho & 15; return 8 * (i >> 2) + 4 * n + (i & 3); }

struct Unit { int pm, pn; };
struct Gemm { const bf16_t* A; const bf16_t* Bt; int M, N, K; };

struct StaticOrder {
    int nM, nN, nwg, G, c, wgm;
    __host__ __device__ void init(int M, int N, int G_, int c_, int wgm_ = WGM) { nM = M / BM; nN = N / BM; nwg = nM * nN; G = G_; c = c_; wgm = wgm_; }
    __host__ __device__ bool next(int i, Unit& u) const {
        const long L = (long)i * G + c; if (L >= nwg) return false;
        int wgid = (int)L; { const int q = nwg / NXCD, r = nwg % NXCD, xcd = wgid % NXCD, off = wgid / NXCD; wgid = (xcd < r ? xcd * (q + 1) : r * (q + 1) + (xcd - r) * q) + off; }
        const int nig = wgm * nN, gid = wgid / nig, fm = gid * wgm, gsz = (nM - fm) < wgm ? (nM - fm) : wgm;
        u.pm = fm + ((wgid % nig) % gsz); u.pn = (wgid % nig) / gsz; return true;
    }
    __device__ __forceinline__ void a_ready(const Unit&) const {}
    __device__ __forceinline__ void done(const Unit&) const {}
};
__device__ __forceinline__ unsigned cvt_pk_bf16(float lo, float hi) { unsigned r; asm volatile("v_cvt_pk_bf16_f32 %0, %1, %2" : "=v"(r) : "v"(lo), "v"(hi)); return r; }
typedef float f32x2 __attribute__((ext_vector_type(2)));
}
namespace pg8 {
__device__ __forceinline__ float row_rstd(const float* ssp, int row) {
    const f32x4 a = *(const f32x4*)(ssp + (size_t)row * 4);
    return __builtin_amdgcn_rsqf(((a[0] + a[1]) + (a[2] + a[3])) * (1.0f / 1024.0f) + 1e-6f);
}
struct EpiZ {
    static constexpr bool PERM = true, AFTER_DRAIN = false;
    bf16_t* Z; float* GK; const PG8_LAS float* tab;
    __device__ __forceinline__ void operator()(const f32x4 (&acc)[2][2][4][2], const Unit& u, int wr, int wc, int fr, int fq) const {
        const int row0 = u.pm * BM + wr * 64 + fr;
        float rsv[2][4];
#pragma unroll
        for (int ai = 0; ai < 2; ++ai)
#pragma unroll
            for (int m = 0; m < 4; ++m) rsv[ai][m] = tab[(u.pm & 7) * 256 + wr * 64 + fr + ai * HALF + m * 16];
        if (u.pn < 18) {
            const int col0 = u.pn * BM + wc * 32 + 8 * fq;
#pragma unroll
            for (int ai = 0; ai < 2; ++ai)
#pragma unroll
                for (int m = 0; m < 4; ++m) { bf16_t* rowp = Z + (size_t)(row0 + ai * HALF + m * 16) * 4608 + col0;
#pragma unroll
                    for (int bj = 0; bj < 2; ++bj) { const f32x4 v0 = acc[ai][bj][m][0] * rsv[ai][m], v1 = acc[ai][bj][m][1] * rsv[ai][m];
                        u32x4 w; w.x = cvt_pk_bf16(v0[0], v0[1]); w.y = cvt_pk_bf16(v0[2], v0[3]); w.z = cvt_pk_bf16(v1[0], v1[1]); w.w = cvt_pk_bf16(v1[2], v1[3]);
                        *(u32x4*)(rowp + bj * HALF) = w; } }
        } else if (wc == 0 && fq < 2) {
#pragma unroll
            for (int ai = 0; ai < 2; ++ai)
#pragma unroll
                for (int m = 0; m < 4; ++m) { float* rp = GK + (size_t)(row0 + ai * HALF + m * 16) * 16 + 8 * fq;
                    *(f32x4*)rp = acc[ai][0][m][0] * rsv[ai][m]; *(f32x4*)(rp + 4) = acc[ai][0][m][1] * rsv[ai][m]; }
        }
    }
};
template <bool HAS_BIAS> struct EpiF32 {
    static constexpr bool PERM = false, AFTER_DRAIN = false;
    float* C; int ldc; const float* bias;
    __device__ __forceinline__ void operator()(const f32x4 (&acc)[2][2][4][2], const Unit& u, int wr, int wc, int fr, int fq) const {
        const int row0 = u.pm * BM + wr * 64 + fr, col0 = u.pn * BM + wc * 32 + 4 * fq;
        f32x4 bv[2][2];
#pragma unroll
        for (int bj = 0; bj < 2; ++bj)
#pragma unroll
            for (int n = 0; n < 2; ++n) bv[bj][n] = HAS_BIAS ? *(const f32x4*)(bias + col0 + bj * HALF + n * 16) : (f32x4){0.f, 0.f, 0.f, 0.f};
#pragma unroll
        for (int ai = 0; ai < 2; ++ai)
#pragma unroll
            for (int m = 0; m < 4; ++m) { float* rowp = C + (size_t)(row0 + ai * HALF + m * 16) * ldc + col0;
#pragma unroll
                for (int bj = 0; bj < 2; ++bj)
#pragma unroll
                    for (int n = 0; n < 2; ++n) *(f32x4*)(rowp + bj * HALF + n * 16) = acc[ai][bj][m][n] + bv[bj][n]; }
    }
};
struct EpiRelu2 {
    static constexpr bool PERM = true, AFTER_DRAIN = false;
    bf16_t* O; int ldc; const PG8_LAS float* tab;
    __device__ __forceinline__ void operator()(const f32x4 (&acc)[2][2][4][2], const Unit& u, int wr, int wc, int fr, int fq) const {
        const int row0 = u.pm * BM + wr * 64 + fr, col0 = u.pn * BM + wc * 32 + 8 * fq;
#pragma unroll
        for (int ai = 0; ai < 2; ++ai)
#pragma unroll
            for (int m = 0; m < 4; ++m) { bf16_t* rowp = O + (size_t)(row0 + ai * HALF + m * 16) * ldc + col0; const float rs = tab[(u.pm & 7) * 256 + wr * 64 + fr + ai * HALF + m * 16];
#pragma unroll
                for (int bj = 0; bj < 2; ++bj) { f32x4 v0 = acc[ai][bj][m][0] * rs, v1 = acc[ai][bj][m][1] * rs;
#pragma unroll
                    for (int j = 0; j < 4; ++j) { const float a = fmaxf(v0[j], 0.f), b = fmaxf(v1[j], 0.f); v0[j] = a * a; v1[j] = b * b; }
                    u32x4 w; w.x = cvt_pk_bf16(v0[0], v0[1]); w.y = cvt_pk_bf16(v0[2], v0[3]); w.z = cvt_pk_bf16(v1[0], v1[1]); w.w = cvt_pk_bf16(v1[2], v1[3]);
                    *(u32x4*)(rowp + bj * HALF) = w; } }
    }
};
struct EpiGLU {
    static constexpr bool PERM = true, AFTER_DRAIN = false;
    bf16_t* U; const float* bias; const PG8_LAS float* tab;
    __device__ __forceinline__ void operator()(const f32x4 (&acc)[2][2][4][2], const Unit& u, int wr, int wc, int fr, int fq) const {
        const int row0 = u.pm * BM + wr * 64 + fr, col0 = u.pn * HALF + wc * 32 + 8 * fq;
        f32x4 b1[2], b2[2];
#pragma unroll
        for (int n = 0; n < 2; ++n) { b1[n] = *(const f32x4*)(bias + col0 + 4 * n); b2[n] = *(const f32x4*)(bias + 1024 + col0 + 4 * n); }
#pragma unroll
        for (int ai = 0; ai < 2; ++ai)
#pragma unroll
            for (int m = 0; m < 4; ++m) { bf16_t* rowp = U + (size_t)(row0 + ai * HALF + m * 16) * 1024 + col0; const float rs = tab[(u.pm & 7) * 256 + wr * 64 + fr + ai * HALF + m * 16];
                f32x4 o[2];
#pragma unroll
                for (int n = 0; n < 2; ++n) { const f32x4 a = acc[ai][0][m][n] * rs + b1[n], g = acc[ai][1][m][n] * rs + b2[n];
#pragma unroll
                    for (int j = 0; j < 4; ++j) o[n][j] = a[j] * __builtin_amdgcn_rcpf(1.f + __expf(-g[j])); }
                u32x4 w; w.x = cvt_pk_bf16(o[0][0], o[0][1]); w.y = cvt_pk_bf16(o[0][2], o[0][3]); w.z = cvt_pk_bf16(o[1][0], o[1][1]); w.w = cvt_pk_bf16(o[1][2], o[1][3]);
                *(u32x4*)rowp = w; }
    }
};

struct RmsStats {
    float* xbuf;
    unsigned* cnt;
    __device__ __forceinline__ void run(const f32x4 (&v)[2][2][4][2], const Unit& u, int wr, int wc, int fr, int fq, PG8_LAS unsigned char* lds, int wid, int lane) const {
        PG8_LAS float* P = (PG8_LAS float*)lds;
        PG8_LAS float* S = (PG8_LAS float*)(lds + 4096);
#pragma unroll
        for (int ai = 0; ai < 2; ++ai)
#pragma unroll
            for (int m = 0; m < 4; ++m) {
                float s = 0.f;
#pragma unroll
                for (int bj = 0; bj < 2; ++bj)
#pragma unroll
                    for (int n = 0; n < 2; ++n) { const f32x4 x = v[ai][bj][m][n]; s += (x[0] * x[0] + x[1] * x[1]) + (x[2] * x[2] + x[3] * x[3]); }
                s += __shfl_xor(s, 16); s += __shfl_xor(s, 32);
                if (fq == 0) P[(ai * HALF + wr * 64 + m * 16 + fr) * 4 + wc] = s;
            }
        asm volatile("s_waitcnt lgkmcnt(0)" ::: "memory"); __builtin_amdgcn_s_barrier(); asm volatile("" ::: "memory");
        const int row = wid * 32 + (lane & 31);
        if (lane < 32) { const f32x4 p = *(const PG8_LAS f32x4*)(P + row * 4); const float t = (p[0] + p[1]) + (p[2] + p[3]);
            __hip_atomic_store(xbuf + ((size_t)(u.pm * BM + row) * 4 + u.pn), t, __ATOMIC_RELAXED, __HIP_MEMORY_SCOPE_AGENT); }
        asm volatile("s_waitcnt vmcnt(0)" ::: "memory");
        if (lane == 0) __hip_atomic_fetch_add(cnt + 64 * u.pm, 1u, __ATOMIC_RELAXED, __HIP_MEMORY_SCOPE_AGENT);
        if (wid == 0) {
            unsigned sp = 0u;
            while ((unsigned)__builtin_amdgcn_readfirstlane(__hip_atomic_load(cnt + 64 * u.pm, __ATOMIC_RELAXED, __HIP_MEMORY_SCOPE_AGENT)) < 32u) { __builtin_amdgcn_s_sleep(2); if (++sp > (1u << 22)) break; }
        }
        asm volatile("s_waitcnt vmcnt(0) lgkmcnt(0)" ::: "memory"); __builtin_amdgcn_s_barrier(); asm volatile("" ::: "memory");
        if (lane < 32) { const float* slot = xbuf + (size_t)(u.pm * BM + row) * 4; float t = 0.f;
#pragma unroll
            for (int i = 0; i < 4; ++i) t += __hip_atomic_load(slot + i, __ATOMIC_RELAXED, __HIP_MEMORY_SCOPE_AGENT);
            S[row] = __builtin_amdgcn_rsqf(t * (1.0f / 1024.0f) + 1e-6f); }
        asm volatile("s_waitcnt lgkmcnt(0)" ::: "memory"); __builtin_amdgcn_s_barrier(); asm volatile("" ::: "memory");
    }
};
template <bool HAS_BIAS, bool HAS_PRE, bool XS_BF16, bool XD_BF16> struct EpiNorm {
    static constexpr bool PERM = false, AFTER_DRAIN = true;
    const void* xs; void* xd; float* ssq_out; const float* bias; const float* gpost; RmsStats st1;
    __device__ __forceinline__ void fused(f32x4 (&acc)[2][2][4][2], const Unit& u, int wr, int wc, int fr, int fq, PG8_LAS unsigned char* lds, int wid, int lane) const {
        typedef unsigned u32x2v __attribute__((ext_vector_type(2)));
        const PG8_LAS float* S = (const PG8_LAS float*)(lds + 4096);
        const int col0 = u.pn * BM + wc * 32 + 4 * fq;
        if (HAS_BIAS) {
#pragma unroll
            for (int bj = 0; bj < 2; ++bj)
#pragma unroll
                for (int n = 0; n < 2; ++n) { const f32x4 bv = *(const f32x4*)(bias + col0 + bj * HALF + n * 16);
#pragma unroll
                    for (int ai = 0; ai < 2; ++ai)
#pragma unroll
                        for (int m = 0; m < 4; ++m) acc[ai][bj][m][n] += bv; }
        }
        f32x4 gv[2][2];
#pragma unroll
        for (int bj = 0; bj < 2; ++bj)
#pragma unroll
            for (int n = 0; n < 2; ++n) gv[bj][n] = *(const f32x4*)(gpost + col0 + bj * HALF + n * 16);
        st1.run(acc, u, wr, wc, fr, fq, lds, wid, lane);
#pragma unroll
        for (int ai = 0; ai < 2; ++ai) {
            f32x4 xv[4][2][2];
#pragma unroll
            for (int mm = 0; mm < 4; ++mm) { const size_t off = (size_t)(u.pm * BM + ai * HALF + wr * 64 + mm * 16 + fr) * 1024 + col0;
#pragma unroll
                for (int bj = 0; bj < 2; ++bj)
#pragma unroll
                    for (int n = 0; n < 2; ++n) {
                        if (XS_BF16) { const u32x2v p = *(const u32x2v*)((const bf16_t*)xs + off + bj * HALF + n * 16);
                            xv[mm][bj][n] = (f32x4){__uint_as_float(p.x << 16), __uint_as_float(p.x & 0xffff0000u), __uint_as_float(p.y << 16), __uint_as_float(p.y & 0xffff0000u)}; }
                        else xv[mm][bj][n] = *(const f32x4*)((const float*)xs + off + bj * HALF + n * 16); } }
#pragma unroll
            for (int mm = 0; mm < 4; ++mm) asm volatile("" : "+v"(xv[mm][0][0]), "+v"(xv[mm][0][1]), "+v"(xv[mm][1][0]), "+v"(xv[mm][1][1]));
#pragma unroll
            for (int m = 0; m < 4; ++m) { const int r = ai * HALF + wr * 64 + m * 16 + fr; const float rs = S[r]; const size_t off = (size_t)(u.pm * BM + r) * 1024 + col0;
#pragma unroll
                for (int bj = 0; bj < 2; ++bj)
#pragma unroll
                    for (int n = 0; n < 2; ++n) { f32x4 o = xv[m][bj][n] + acc[ai][bj][m][n] * rs * gv[bj][n];
                        if (XD_BF16) { u32x2v w; w.x = cvt_pk_bf16(o[0], o[1]); w.y = cvt_pk_bf16(o[2], o[3]); *(u32x2v*)((bf16_t*)xd + off + bj * HALF + n * 16) = w;
                            o = (f32x4){__uint_as_float(w.x << 16), __uint_as_float(w.x & 0xffff0000u), __uint_as_float(w.y << 16), __uint_as_float(w.y & 0xffff0000u)}; }
                        else *(f32x4*)((float*)xd + off + bj * HALF + n * 16) = o;
                        acc[ai][bj][m][n] = o; } }
        }
        if (HAS_PRE) {
            PG8_LAS float* P = (PG8_LAS float*)lds;
            P += 2048;
#pragma unroll
            for (int ai = 0; ai < 2; ++ai)
#pragma unroll
                for (int m = 0; m < 4; ++m) {
                    float s = 0.f;
#pragma unroll
                    for (int bj = 0; bj < 2; ++bj)
#pragma unroll
                        for (int n = 0; n < 2; ++n) { const f32x4 x = acc[ai][bj][m][n]; s += (x[0] * x[0] + x[1] * x[1]) + (x[2] * x[2] + x[3] * x[3]); }
                    s += __shfl_xor(s, 16); s += __shfl_xor(s, 32);
                    if (fq == 0) P[(ai * HALF + wr * 64 + m * 16 + fr) * 4 + wc] = s;
                }
            asm volatile("s_waitcnt lgkmcnt(0)" ::: "memory"); __builtin_amdgcn_s_barrier(); asm volatile("" ::: "memory");
            if (lane < 32) { const int row = wid * 32 + lane; const f32x4 p = *(const PG8_LAS f32x4*)(P + row * 4);
                ssq_out[(size_t)(u.pm * BM + row) * 4 + u.pn] = (p[0] + p[1]) + (p[2] + p[3]); }
        }
    }
};
}
namespace pg8 {
template <class Epi, class Sched, bool ALIGN_EPI = false, bool SP2 = false>
__device__ __forceinline__ void gemm_phase(PG8_LAS unsigned char* lds, const Gemm g, const Sched& S, const Epi& E) {
    int tid = threadIdx.x; asm volatile("" : "+v"(tid)); const int wid = __builtin_amdgcn_readfirstlane(tid >> 6), lane = tid & 63, wr = wid >> 2, wc = wid & 3, fr = lane & 15, fq = lane >> 4;
    const int K = g.K, nt = K / BK;
    unsigned voffA[2], voffB[2];
#pragma unroll
    for (int i = 0; i < 2; ++i) { int R, C; stage_rc(tid * 16 + i * 8192, R, C); const int Rb = Epi::PERM ? ((R & ~31) + perm32(R & 31)) : R;
        voffA[i] = (unsigned)(R * K + C) * 2u; voffB[i] = (unsigned)(Rb * K + C) * 2u; }
    const size_t kstep = (size_t)(BK * 2);
    const size_t hstep = (size_t)HALF * K * 2;
    const size_t tstep = 2 * hstep;
    const unsigned ldsw = (unsigned)wid * 1024u;
    const int aoff = lds_byte(wr * 64 + fr, fq * 8), boff = lds_byte(wc * 32 + fr, fq * 8);
#define PG8_SA(b, h) (((b) * 2 + (h)) * HTB)
#define PG8_SB(b, h) ((4 + (b) * 2 + (h)) * HTB)
#define PG8_STAGE(bufoff, gbase, voff) do { _Pragma("unroll") for (int _i = 0; _i < 2; ++_i) \
        __builtin_amdgcn_global_load_lds((const unsigned*)((const char*)(gbase) + (voff)[_i]), (PG8_LAS unsigned*)(lds + (bufoff) + ldsw + _i * 8192), 16, 0, 0); } while (0)
#define PG8_LDA(dst, b, h) do { _Pragma("unroll") for (int m = 0; m < 4; ++m) _Pragma("unroll") for (int k = 0; k < 2; ++k) dst[m][k] = *(const PG8_LAS bf16x8*)(lds + PG8_SA(b, h) + aoff + m * 2048 + k * 1024); } while (0)
#define PG8_LDB(dst, b, h) do { _Pragma("unroll") for (int n = 0; n < 2; ++n) _Pragma("unroll") for (int k = 0; k < 2; ++k) dst[n][k] = *(const PG8_LAS bf16x8*)(lds + PG8_SB(b, h) + boff + n * 2048 + k * 1024); } while (0)
#define PG8_MMA(ai, bj, At, Bt) do { __builtin_amdgcn_s_setprio(1); _Pragma("unroll") for (int m = 0; m < 4; ++m) _Pragma("unroll") for (int n = 0; n < 2; ++n) _Pragma("unroll") for (int k = 0; k < 2; ++k) \
        acc[ai][bj][m][n] = __builtin_amdgcn_mfma_f32_16x16x32_bf16(Bt[n][k], At[m][k], acc[ai][bj][m][n], 0, 0, 0); __builtin_amdgcn_s_setprio(0); } while (0)
#define PG8_WAIT_V(n) asm volatile("s_waitcnt vmcnt(" #n ")" ::: "memory")
#define PG8_WAIT_L(n) asm volatile("s_waitcnt lgkmcnt(" #n ")" ::: "memory")
#define PG8_BAR __builtin_amdgcn_s_barrier()
#define PG8_SCHED __builtin_amdgcn_sched_barrier(0)
    Unit cur, nxt; int ui = 0;
    if (!S.next(0, cur)) return;
    f32x4 acc[2][2][4][2];
#pragma unroll
    for (int a = 0; a < 2; ++a)
#pragma unroll
        for (int b = 0; b < 2; ++b)
#pragma unroll
            for (int m = 0; m < 4; ++m)
#pragma unroll
                for (int n = 0; n < 2; ++n) acc[a][b][m][n] = (f32x4){0.f, 0.f, 0.f, 0.f};
    bf16x8 At[4][2], B0[2][2], B1[2][2];
    const char* cA = (const char*)g.A + (size_t)cur.pm * tstep; const char* cB = (const char*)g.Bt + (size_t)cur.pn * tstep;
    S.a_ready(cur);
    if constexpr (SP2) {
        PG8_STAGE(PG8_SB(0, 0), cB, voffB); PG8_STAGE(PG8_SB(0, 1), cB + hstep, voffB); PG8_STAGE(PG8_SA(0, 0), cA, voffA); PG8_STAGE(PG8_SA(0, 1), cA + hstep, voffA);
        if (wr == 1) PG8_BAR;
        PG8_WAIT_V(2); PG8_BAR;
        PG8_STAGE(PG8_SB(1, 0), cB + kstep, voffB); PG8_STAGE(PG8_SA(1, 0), cA + kstep, voffA); PG8_STAGE(PG8_SB(1, 1), cB + hstep + kstep, voffB);
        PG8_WAIT_V(6); PG8_BAR;
    } else {
        PG8_STAGE(PG8_SB(0, 0), cB, voffB); PG8_STAGE(PG8_SA(0, 0), cA, voffA); PG8_STAGE(PG8_SB(0, 1), cB + hstep, voffB); PG8_STAGE(PG8_SA(0, 1), cA + hstep, voffA);
        if (wr == 1) PG8_BAR;
        PG8_WAIT_V(4); PG8_BAR;
        PG8_STAGE(PG8_SB(1, 0), cB + kstep, voffB); PG8_STAGE(PG8_SA(1, 0), cA + kstep, voffA); PG8_STAGE(PG8_SB(1, 1), cB + hstep + kstep, voffB);
        PG8_WAIT_V(6); PG8_BAR;
    }
    for (;;) {
        const bool has_next = S.next(ui + 1, nxt);
        const char* nA = has_next ? (const char*)g.A + (size_t)nxt.pm * tstep : cA; const char* nB = has_next ? (const char*)g.Bt + (size_t)nxt.pn * tstep : cB;
        for (int t = 0; t < nt; t += 2) {
            const bool last = (t == nt - 2);
            const char* a1 = cA + (size_t)(t + 1) * kstep;
            const char* a2 = last ? nA : cA + (size_t)(t + 2) * kstep; const char* b2 = last ? nB : cB + (size_t)(t + 2) * kstep;
            const char* a3 = a2 + kstep; const char* b3 = b2 + kstep;
            if (last && has_next) S.a_ready(nxt);
            if constexpr (SP2) {
            PG8_LDB(B0, 0, 0); PG8_LDB(B1, 0, 1); PG8_SCHED; PG8_LDA(At, 0, 0); PG8_STAGE(PG8_SA(1, 1), a1 + hstep, voffA);
            PG8_WAIT_V(8); PG8_WAIT_L(0); PG8_BAR; PG8_MMA(0, 0, At, B0); PG8_MMA(0, 1, At, B1); PG8_BAR; PG8_SCHED;
            PG8_LDA(At, 0, 1); PG8_STAGE(PG8_SB(0, 0), b2, voffB); PG8_STAGE(PG8_SB(0, 1), b2 + hstep, voffB); PG8_STAGE(PG8_SA(0, 0), a2, voffA);
            PG8_WAIT_V(8); PG8_WAIT_L(0); PG8_BAR; PG8_MMA(1, 0, At, B0); PG8_MMA(1, 1, At, B1); PG8_BAR; PG8_SCHED;
            PG8_LDB(B0, 1, 0); PG8_LDB(B1, 1, 1); PG8_SCHED; PG8_LDA(At, 1, 0); PG8_STAGE(PG8_SA(0, 1), a2 + hstep, voffA);
            PG8_WAIT_V(8); PG8_WAIT_L(0); PG8_BAR; PG8_MMA(0, 0, At, B0); PG8_MMA(0, 1, At, B1); PG8_BAR; PG8_SCHED;
            PG8_LDA(At, 1, 1); PG8_STAGE(PG8_SB(1, 0), b3, voffB); PG8_STAGE(PG8_SB(1, 1), b3 + hstep, voffB); PG8_STAGE(PG8_SA(1, 0), a3, voffA);
            PG8_WAIT_V(8); PG8_WAIT_L(0); PG8_BAR; PG8_MMA(1, 0, At, B0); PG8_MMA(1, 1, At, B1); PG8_BAR; PG8_SCHED;
            } else {
            PG8_LDB(B0, 0, 0); PG8_SCHED; PG8_LDA(At, 0, 0); PG8_STAGE(PG8_SA(1, 1), a1 + hstep, voffA);
            PG8_WAIT_L(8); PG8_BAR; PG8_WAIT_L(0); PG8_MMA(0, 0, At, B0); PG8_BAR; PG8_SCHED;
            PG8_LDB(B1, 0, 1); PG8_STAGE(PG8_SB(0, 0), b2, voffB);
            PG8_BAR; PG8_WAIT_L(0); PG8_MMA(0, 1, At, B1); PG8_BAR;
            PG8_LDA(At, 0, 1); PG8_STAGE(PG8_SA(0, 0), a2, voffA);
            PG8_BAR; PG8_WAIT_L(0); PG8_MMA(1, 0, At, B0); PG8_BAR; PG8_SCHED;
            PG8_STAGE(PG8_SB(0, 1), b2 + hstep, voffB);
            PG8_WAIT_V(6); PG8_BAR; PG8_MMA(1, 1, At, B1); PG8_BAR;
            PG8_LDB(B0, 1, 0); PG8_SCHED; PG8_LDA(At, 1, 0); PG8_STAGE(PG8_SA(0, 1), a2 + hstep, voffA);
            PG8_WAIT_L(8); PG8_BAR; PG8_WAIT_L(0); PG8_MMA(0, 0, At, B0); PG8_BAR; PG8_SCHED;
            PG8_LDB(B1, 1, 1); PG8_STAGE(PG8_SB(1, 0), b3, voffB);
            PG8_BAR; PG8_WAIT_L(0); PG8_MMA(0, 1, At, B1); PG8_BAR;
            PG8_LDA(At, 1, 1); PG8_STAGE(PG8_SA(1, 0), a3, voffA);
            PG8_BAR; PG8_WAIT_L(0); PG8_MMA(1, 0, At, B0); PG8_BAR; PG8_SCHED;
            PG8_STAGE(PG8_SB(1, 1), b3 + hstep, voffB);
            PG8_WAIT_V(6); PG8_BAR; PG8_MMA(1, 1, At, B1); PG8_BAR;
            }
        }
        if constexpr (ALIGN_EPI) { if (wr == 0) PG8_BAR; }
        if constexpr (!Epi::AFTER_DRAIN) { E(acc, cur, wr, wc, fr, fq); S.done(cur); }
        if (!has_next) break;
#pragma unroll
        for (int a = 0; a < 2; ++a)
#pragma unroll
            for (int b = 0; b < 2; ++b)
#pragma unroll
                for (int m = 0; m < 4; ++m)
#pragma unroll
                    for (int n = 0; n < 2; ++n) acc[a][b][m][n] = (f32x4){0.f, 0.f, 0.f, 0.f};
        cur = nxt; cA = nA; cB = nB; ++ui;
        if constexpr (ALIGN_EPI) { if (wr == 1) PG8_BAR; }
    }
    PG8_WAIT_V(0);
    if constexpr (!ALIGN_EPI) { if (wr == 0) PG8_BAR; }
    PG8_BAR;
    if constexpr (Epi::AFTER_DRAIN) { E.fused(acc, cur, wr, wc, fr, fq, lds, wid, lane); S.done(cur); }
#undef PG8_SA
#undef PG8_SB
#undef PG8_STAGE
#undef PG8_LDA
#undef PG8_LDB
#undef PG8_MMA
#undef PG8_WAIT_V
#undef PG8_WAIT_L
#undef PG8_BAR
#undef PG8_SCHED
}
}
#include <hip/hip_cooperative_groups.h>
namespace cg = cooperative_groups;
#define LAS __attribute__((address_space(3)))
#define GAS __attribute__((address_space(1)))
typedef unsigned short bf16;
typedef float f32x4 __attribute__((ext_vector_type(4)));
typedef float f32x2 __attribute__((ext_vector_type(2)));
typedef short bf16x8 __attribute__((ext_vector_type(8)));
typedef unsigned u32x4 __attribute__((ext_vector_type(4)));
typedef unsigned u32x2 __attribute__((ext_vector_type(2)));

constexpr int T = 16384, D = 1024, DEPTH = 4, FF = 4096;
constexpr int ZLD = 4608, ZN = 4864, ABIN = 4624, MIXLD = 1536;
constexpr int ZSX = 0, ZSB = 512, ZSC = 1024, ZQ = 1536, ZK = 2048, ZV = 2560, ZG = 3584;
constexpr float EPS = 1e-6f;
constexpr int NWAVES = 8, NTHR = 512;
constexpr int LDS_BYTES = 147456;
constexpr size_t MiB = 1u << 20;
constexpr size_t WS_DEC = 256 * 1024;
constexpr size_t WS_BAR = 0;
constexpr size_t WS_EBL = 512 * 1024;
constexpr size_t WS_CNT = 16 * 1024;
constexpr size_t WS_X1 = 255 * MiB;
constexpr size_t WS_W = 1536 * 1024;
constexpr size_t WS_H = 30 * MiB;
constexpr size_t WS_BIG = 62 * MiB;
constexpr size_t WS_GK = 254 * MiB;
constexpr size_t WS_END = 255 * MiB + 256 * 1024;
constexpr size_t WO_MIX1 = 0;
constexpr size_t WO_MIX2_E = (size_t)ZN * D;
constexpr size_t WO_MIX2_O = (size_t)2048 * D;
constexpr size_t WO_W1 = (size_t)ZN * D + (size_t)D * MIXLD;
constexpr size_t WO_W2 = WO_W1 + (size_t)FF * D;
static_assert(WS_W + (WO_W2 + (size_t)FF * D) * 2 <= WS_H, "weights fit");

__device__ __forceinline__ int tid_l() { int t = threadIdx.x; asm volatile("" : "+v"(t)); return t; }
__device__ __forceinline__ float bf2f(unsigned b) { return __uint_as_float(b << 16); }
__device__ __forceinline__ unsigned pkbf(float lo, float hi) { return pg8::cvt_pk_bf16(lo, hi); }
template <int CTRL> __device__ __forceinline__ float dppf(float v) { return __builtin_bit_cast(float, __builtin_amdgcn_update_dpp(0, __builtin_bit_cast(int, v), CTRL, 0xf, 0xf, true)); }
__device__ __forceinline__ float row16_sum(float v) { v += dppf<0xB1>(v); v += dppf<0x4E>(v); v += dppf<0x141>(v); v += dppf<0x140>(v); return v; }
__device__ __forceinline__ float wave_sum(float v) {
    v = row16_sum(v);
    const int iv = __builtin_bit_cast(int, v);
    return (__builtin_bit_cast(float, __builtin_amdgcn_readlane(iv, 0)) + __builtin_bit_cast(float, __builtin_amdgcn_readlane(iv, 16))) + (__builtin_bit_cast(float, __builtin_amdgcn_readlane(iv, 32)) + __builtin_bit_cast(float, __builtin_amdgcn_readlane(iv, 48)));
}

template <int MODE, bool GAIN>
__device__ __forceinline__ void transpose_item(const float* W, int K, int N, bf16* WT, LAS float* scr, int item, int lane, const float* gain) {
    const int nblk = (N + 31) / 32, kb = item / nblk, nb = item % nblk, k0 = 64 * kb, n0 = 32 * nb;
    const bool ok = (n0 + (lane & 31)) < N;
    float tv[32];
#pragma unroll
    for (int i = 0; i < 32; ++i) { const int kk = 2 * i + (lane >> 5); tv[i] = ok ? W[(size_t)(k0 + kk) * N + n0 + (lane & 31)] : 0.f; }
#pragma unroll
    for (int i = 0; i < 32; ++i) { const int kk = 2 * i + (lane >> 5); scr[kk * 33 + (lane & 31)] = tv[i]; }
    asm volatile("s_waitcnt lgkmcnt(0)" ::: "memory");
    int d0 = n0;
    if (MODE == 1) { const int half = n0 >> 10, c0 = n0 & 1023; d0 = ((c0 >> 7) << 8) + (half << 7) + (c0 & 127); }
    const int c = lane & 7;
    f32x4 ga = (f32x4){1.f, 1.f, 1.f, 1.f}, gb = ga;
    if (GAIN) { ga = *(const f32x4*)(gain + k0 + 8 * c); gb = *(const f32x4*)(gain + k0 + 8 * c + 4); }
#pragma unroll
    for (int j = 0; j < 4; ++j) { const int n = (lane >> 3) + 8 * j; const LAS float* s = scr + (8 * c) * 33 + n;
        u32x4 o; o.x = pkbf(s[0 * 33] * ga.x, s[1 * 33] * ga.y); o.y = pkbf(s[2 * 33] * ga.z, s[3 * 33] * ga.w); o.z = pkbf(s[4 * 33] * gb.x, s[5 * 33] * gb.y); o.w = pkbf(s[6 * 33] * gb.z, s[7 * 33] * gb.w);
        *(u32x4*)(WT + (size_t)(d0 + n) * K + k0 + 8 * c) = o; }
    asm volatile("s_waitcnt lgkmcnt(0)" ::: "memory");
}

struct Args { const float* in[21]; float* out; unsigned char* ws; int ph_lo, ph_hi; };
__device__ __forceinline__ const float* inp(int i) { const __attribute__((address_space(4))) char* kp = (const __attribute__((address_space(4))) char*)__builtin_amdgcn_kernarg_segment_ptr(); asm volatile("" : "+s"(kp)); const float* p = *(const float* const __attribute__((address_space(4)))*)(kp + 8 * i); return (const float*)(const __attribute__((address_space(1))) float*)p; }

template <int PART>
__device__ __forceinline__ void convert_layer(unsigned char* wsp, int l, LAS unsigned char* lds, int gw, int NGW, int wave, int lane) {
    LAS float* scr = (LAS float*)(lds + wave * 8704);
    bf16* Wb_ = (bf16*)(wsp + WS_W);
    const int i2 = l >> 1;
    if (PART == 1) {
        const float* w1 = inp(19) + (size_t)l * D * FF; const float* w2 = inp(20) + (size_t)l * FF * D;
        constexpr int I_W1 = (D / 64) * (FF / 32), I_W2 = (FF / 64) * (D / 32);
        for (int it = gw; it < I_W1 + I_W2; it += NGW) {
            if (it < I_W1) transpose_item<0, true>(w1, D, FF, Wb_ + WO_W1, scr, it, lane, inp(3) + (size_t)l * D);
            else transpose_item<0, false>(w2, FF, D, Wb_ + WO_W2, scr, it - I_W1, lane, nullptr); }
    } else if ((l & 1) == 0) {
        const float* win = inp(5) + (size_t)i2 * D * ABIN; const float* wout = inp(10) + (size_t)i2 * MIXLD * D;
        constexpr int I_IN = (D / 64) * ((ABIN + 31) / 32), I_OUT = (MIXLD / 64) * (D / 32);
        for (int it = gw; it < I_IN + I_OUT; it += NGW) {
            if (it < I_IN) transpose_item<0, true>(win, D, ABIN, Wb_ + WO_MIX1, scr, it, lane, inp(1) + (size_t)l * D);
            else transpose_item<0, false>(wout, MIXLD, D, Wb_ + WO_MIX2_E, scr, it - I_IN, lane, nullptr); }
        u32x4* pz = (u32x4*)(Wb_ + WO_MIX1 + (size_t)4640 * D); const int nz = (ZN - 4640) * D / 8;
        for (int i = gw * 64 + lane; i < nz; i += NGW * 64) pz[i] = (u32x4){0u, 0u, 0u, 0u};
    } else {
        const float* pw1 = inp(11) + (size_t)i2 * D * 2048; const float* pw2 = inp(17) + (size_t)i2 * D * D;
        constexpr int I_P1 = (D / 64) * (2048 / 32), I_P2 = (D / 64) * (D / 32);
        for (int it = gw; it < I_P1 + I_P2; it += NGW) {
            if (it < I_P1) transpose_item<1, true>(pw1, D, 2048, Wb_ + WO_MIX1, scr, it, lane, inp(1) + (size_t)l * D);
            else transpose_item<0, false>(pw2, D, D, Wb_ + WO_MIX2_O, scr, it - I_P1, lane, nullptr); }
    }
}

__device__ __forceinline__ void prologue_rows(const float* xs, bf16* xb, float* ssx, int gw, int NGW, int lane) {
    for (int row = gw; row < T; row += 2 * NGW) {
        const int row2 = row + NGW;
        const f32x4* xa = (const f32x4*)(xs + (size_t)row * D) + lane; const f32x4* xc = (const f32x4*)(xs + (size_t)row2 * D) + lane;
        f32x4 va[4], vb[4];
#pragma unroll
        for (int j = 0; j < 4; ++j) { va[j] = xa[64 * j]; vb[j] = xc[64 * j]; }
        float sa = 0.f, sb = 0.f;
#pragma unroll
        for (int j = 0; j < 4; ++j) { sa += (va[j].x * va[j].x + va[j].y * va[j].y) + (va[j].z * va[j].z + va[j].w * va[j].w); sb += (vb[j].x * vb[j].x + vb[j].y * vb[j].y) + (vb[j].z * vb[j].z + vb[j].w * vb[j].w); }
        sa = wave_sum(sa); sb = wave_sum(sb);
        if (lane < 4) { ssx[(size_t)row * 4 + lane] = lane == 0 ? sa : 0.f; ssx[(size_t)row2 * 4 + lane] = lane == 0 ? sb : 0.f; }
        u32x2* ha = (u32x2*)(xb + (size_t)row * D) + lane; u32x2* hb = (u32x2*)(xb + (size_t)row2 * D) + lane;
#pragma unroll
        for (int j = 0; j < 4; ++j) { u32x2 wa, wb; wa.x = pkbf(va[j].x, va[j].y); wa.y = pkbf(va[j].z, va[j].w); wb.x = pkbf(vb[j].x, vb[j].y); wb.y = pkbf(vb[j].z, vb[j].w); ha[64 * j] = wa; hb[64 * j] = wb; }
    }
}

constexpr int G_QD = 0, G_KD = 17408, G_KLT = 34816, G_VT = 53248, G_P = 90112, G_SEG = 99328, G_EBL = 101376, G_SS = 101888, G_GT = 103936;
#define MFMA16(a, b, c) __builtin_amdgcn_mfma_f32_16x16x32_bf16(a, b, c, 0, 0, 0)
template <bool OUT>
__device__ __forceinline__ void gla_unit(int unit, bf16* z, const float* gklr, const float* wgk2, const float* bgk2, const float* normg, float* E, float* DEC, float* EBLG, bf16* mix, LAS unsigned char* lds) {
    const int tid = tid_l(), lane = tid & 63, w = __builtin_amdgcn_readfirstlane(tid >> 6), r = lane & 15, q = lane >> 4;
    const int g = unit >> 2, h = unit & 3;
    const int seg = w >> 1, k = (w & 1) * 64 + lane, hk = h * 128 + k;
    f32x4 S[8][2];
    GAS float* Eu = (GAS float*)E + (size_t)unit * 32768 + (size_t)w * 4096 + lane;
    if (OUT) {
#pragma unroll
        for (int mt = 0; mt < 8; ++mt)
#pragma unroll
            for (int nt = 0; nt < 2; ++nt)
#pragma unroll
                for (int i = 0; i < 4; ++i) S[mt][nt][i] = Eu[((mt * 2 + nt) * 4 + i) * 64];
    } else {
#pragma unroll
        for (int mt = 0; mt < 8; ++mt)
#pragma unroll
            for (int nt = 0; nt < 2; ++nt) S[mt][nt] = (f32x4){0.f, 0.f, 0.f, 0.f};
    }
    float bsum = 0.f;
    LAS float* SEG = (LAS float*)(lds + G_SEG); LAS float* EBL = (LAS float*)(lds + G_EBL); LAS float* SSQ = (LAS float*)(lds + G_SS);
    for (int ch = 0; ch < 4; ++ch) {
        const int t0 = g * 256 + ch * 64, cgl = g * 4 + ch;
        int tl = tid; asm volatile("" : "+v"(tl));
        if (!OUT) {
            GAS bf16* zq = (GAS bf16*)z + (size_t)(t0 + seg * 16) * ZLD + hk;
            unsigned short qraw[16], kraw[16];
#pragma unroll
            for (int jj = 0; jj < 16; ++jj) { qraw[jj] = zq[(size_t)jj * ZLD + ZQ]; kraw[jj] = zq[(size_t)jj * ZLD + ZK]; }
            float w2r[16];
#pragma unroll
            for (int i = 0; i < 16; ++i) w2r[i] = ((const GAS float*)wgk2)[i * 512 + hk];
            const float bias = ((const GAS float*)bgk2)[hk];
            if (tid < 256) *(LAS f32x4*)(lds + G_QD + tid * 16) = *(const GAS f32x4*)((const GAS float*)gklr + (size_t)t0 * 16 + tid * 4);
            __syncthreads();
            float b[16]; float run = 0.f;
#pragma unroll
            for (int jj = 0; jj < 16; ++jj) {
                const LAS f32x4* gp = (const LAS f32x4*)(lds + G_QD + (seg * 16 + jj) * 64);
                const f32x4 g0 = gp[0], g1 = gp[1], g2 = gp[2], g3 = gp[3];
                float gv = bias;
                gv += g0.x * w2r[0] + g0.y * w2r[1] + g0.z * w2r[2] + g0.w * w2r[3];
                gv += g1.x * w2r[4] + g1.y * w2r[5] + g1.z * w2r[6] + g1.w * w2r[7];
                gv += g2.x * w2r[8] + g2.y * w2r[9] + g2.z * w2r[10] + g2.w * w2r[11];
                gv += g3.x * w2r[12] + g3.y * w2r[13] + g3.z * w2r[14] + g3.w * w2r[15];
                const float ls = -(fmaxf(-gv, 0.f) + __logf(1.f + __expf(-fabsf(gv)))) * (1.f / 16.f);
                run += ls; b[jj] = run;
            }
            SEG[seg * 128 + k] = run;
            __syncthreads();
            float pre = 0.f, tot = 0.f;
#pragma unroll
            for (int s = 0; s < 4; ++s) { const float v = SEG[s * 128 + k]; tot += v; pre += (s < seg) ? v : 0.f; }
            if (seg == 0) { const float eb = __expf(tot); EBL[k] = eb; ((GAS float*)EBLG)[cgl * 512 + hk] = eb; bsum += tot; }
#pragma unroll
            for (int jj = 0; jj < 16; ++jj) {
                const int j = seg * 16 + jj; const float bb = b[jj] + pre;
                const float kv = bf2f(kraw[jj]), qv = bf2f(qraw[jj]);
                *(LAS bf16*)(lds + G_QD + (j * 136 + k) * 2) = (bf16)(pkbf(qv * 0.08838834764831845f * __expf(bb), 0.f) & 0xffffu);
                *(LAS bf16*)(lds + G_KD + (j * 136 + k) * 2) = (bf16)(pkbf(kv * __expf(-bb), 0.f) & 0xffffu);
            }
        } else {
            u32x4 gtv[4], qv4[2], kv4[2];
#pragma unroll
            for (int i = 0; i < 4; ++i) { const int c = tl + 512 * i, row = c >> 5, c16 = c & 31; gtv[i] = *(const GAS u32x4*)((const GAS bf16*)z + (size_t)(t0 + row) * ZLD + ZG + h * 256 + c16 * 8); }
#pragma unroll
            for (int i = 0; i < 2; ++i) { const int c = tl + 512 * i, row = c >> 4, c16 = c & 15; const GAS bf16* zr = (const GAS bf16*)z + (size_t)(t0 + row) * ZLD + h * 128 + c16 * 8;
                qv4[i] = *(const GAS u32x4*)(zr + ZQ); kv4[i] = *(const GAS u32x4*)(zr + ZK); }
            const float eb = ((const GAS float*)EBLG)[cgl * 512 + hk];
            asm volatile("" : "+v"(gtv[0]), "+v"(gtv[1]), "+v"(gtv[2]), "+v"(gtv[3]), "+v"(qv4[0]), "+v"(qv4[1]), "+v"(kv4[0]), "+v"(kv4[1]));
#pragma unroll
            for (int i = 0; i < 4; ++i) { const int c = tl + 512 * i, row = c >> 5, c16 = c & 31; *(LAS u32x4*)(lds + G_GT + row * 528 + c16 * 16) = gtv[i]; }
#pragma unroll
            for (int i = 0; i < 2; ++i) { const int c = tl + 512 * i, row = c >> 4, c16 = c & 15;
                *(LAS u32x4*)(lds + G_QD + row * 272 + c16 * 16) = qv4[i]; *(LAS u32x4*)(lds + G_KD + row * 272 + c16 * 16) = kv4[i]; }
            if (seg == 0) EBL[k] = eb;
        }
        u32x4 vv4[4];
#pragma unroll
        for (int i = 0; i < 4; ++i) { const int c = tl + 512 * i, row = c >> 5, c16 = c & 31; vv4[i] = *(const GAS u32x4*)((const GAS bf16*)z + (size_t)(t0 + row) * ZLD + ZV + h * 256 + c16 * 8); }
        asm volatile("" : "+v"(vv4[0]), "+v"(vv4[1]), "+v"(vv4[2]), "+v"(vv4[3]));
#pragma unroll
        for (int i = 0; i < 4; ++i) { const int c = tl + 512 * i, row = c >> 5, c16 = c & 31; *(LAS u32x4*)(lds + G_VT + row * 544 + c16 * 16) = vv4[i]; }
        __syncthreads();
        if (!OUT) {
#pragma unroll
            for (int i = 0; i < 2; ++i) { const int c = tl + 512 * i, row = c >> 4, c16 = c & 15; GAS bf16* zr = (GAS bf16*)z + (size_t)(t0 + row) * ZLD + h * 128 + c16 * 8;
                *(GAS u32x4*)(zr + ZQ) = *(const LAS u32x4*)(lds + G_QD + row * 272 + c16 * 16); *(GAS u32x4*)(zr + ZK) = *(const LAS u32x4*)(lds + G_KD + row * 272 + c16 * 16); }
        }
        if (OUT) {
            const int jt = w >> 1;
#pragma unroll
            for (int ii = 0; ii < 2; ++ii) {
                const int it = (w & 1) * 2 + ii;
                f32x4 pa = (f32x4){0.f, 0.f, 0.f, 0.f};
                if (jt <= it) {
#pragma unroll
                    for (int s = 0; s < 4; ++s) {
                        const bf16x8 A = *(const LAS bf16x8*)(lds + G_KD + ((16 * jt + r) * 136 + 32 * s + 8 * q) * 2);
                        const bf16x8 B = *(const LAS bf16x8*)(lds + G_QD + ((16 * it + r) * 136 + 32 * s + 8 * q) * 2);
                        pa = MFMA16(A, B, pa);
                    }
                    const int i_ = 16 * it + r;
#pragma unroll
                    for (int e = 0; e < 4; ++e) { const int j_ = 16 * jt + 4 * q + e; if (j_ > i_) pa[e] = 0.f; }
                }
                u32x2 pw; pw.x = pkbf(pa[0], pa[1]); pw.y = pkbf(pa[2], pa[3]);
                *(LAS u32x2*)(lds + G_P + ((16 * it + r) * 72 + 16 * jt + 4 * q) * 2) = pw;
            }
            __syncthreads();
        }
        bf16x8 Bv[2][2];
#pragma unroll
        for (int s2 = 0; s2 < 2; ++s2)
#pragma unroll
            for (int nt = 0; nt < 2; ++nt) {
                typedef short s16x4 __attribute__((ext_vector_type(4)));
                LAS unsigned char* ta = lds + G_VT + (32 * s2 + 8 * q + ((lane & 15) >> 2)) * 544 + (32 * w + 16 * nt + 4 * (lane & 3)) * 2;
                const s16x4 lo = __builtin_amdgcn_ds_read_tr16_b64_v4i16((LAS s16x4*)ta), hi = __builtin_amdgcn_ds_read_tr16_b64_v4i16((LAS s16x4*)(ta + 4 * 544));
                Bv[s2][nt] = (bf16x8){lo[0], lo[1], lo[2], lo[3], hi[0], hi[1], hi[2], hi[3]};
            }
        f32x4 o[4][2];
        if (OUT) {
#pragma unroll
            for (int mt = 0; mt < 4; ++mt)
#pragma unroll
                for (int nt = 0; nt < 2; ++nt) o[mt][nt] = (f32x4){0.f, 0.f, 0.f, 0.f};
#pragma unroll
            for (int s = 0; s < 4; ++s) {
                bf16x8 Sb[2];
#pragma unroll
                for (int nt = 0; nt < 2; ++nt) {
                    u32x4 t; t.x = pkbf(S[2 * s][nt][0], S[2 * s][nt][1]); t.y = pkbf(S[2 * s][nt][2], S[2 * s][nt][3]);
                    t.z = pkbf(S[2 * s + 1][nt][0], S[2 * s + 1][nt][1]); t.w = pkbf(S[2 * s + 1][nt][2], S[2 * s + 1][nt][3]);
                    Sb[nt] = __builtin_bit_cast(bf16x8, t);
                }
                u32x2 alo[4], ahi[4];
#pragma unroll
                for (int mt = 0; mt < 4; ++mt) {
                    alo[mt] = *(const LAS u32x2*)(lds + G_QD + ((16 * mt + r) * 136 + 32 * s + 4 * q) * 2);
                    ahi[mt] = *(const LAS u32x2*)(lds + G_QD + ((16 * mt + r) * 136 + 32 * s + 16 + 4 * q) * 2); }
#pragma unroll
                for (int mt = 0; mt < 4; ++mt) {
                    const bf16x8 A = __builtin_bit_cast(bf16x8, (u32x4){alo[mt].x, alo[mt].y, ahi[mt].x, ahi[mt].y});
#pragma unroll
                    for (int nt = 0; nt < 2; ++nt) o[mt][nt] = MFMA16(A, Sb[nt], o[mt][nt]);
                }
            }
#pragma unroll
            for (int s2 = 0; s2 < 2; ++s2) {
                bf16x8 Ap[4];
#pragma unroll
                for (int mt = 0; mt < 4; ++mt) Ap[mt] = *(const LAS bf16x8*)(lds + G_P + ((16 * mt + r) * 72 + 32 * s2 + 8 * q) * 2);
#pragma unroll
                for (int mt = 0; mt < 4; ++mt)
#pragma unroll
                    for (int nt = 0; nt < 2; ++nt) o[mt][nt] = MFMA16(Ap[mt], Bv[s2][nt], o[mt][nt]);
            }
        }
#pragma unroll
        for (int mt = 0; mt < 8; ++mt) {
            bf16x8 Ak[2]; const f32x4 ebv = *(const LAS f32x4*)(lds + G_EBL + (16 * mt + 4 * q) * 4);
#pragma unroll
            for (int s2 = 0; s2 < 2; ++s2) { typedef short s16x4 __attribute__((ext_vector_type(4)));
                LAS unsigned char* ta = lds + G_KD + (32 * s2 + 8 * q + ((lane & 15) >> 2)) * 272 + (16 * mt + 4 * (lane & 3)) * 2;
                const s16x4 lo = __builtin_amdgcn_ds_read_tr16_b64_v4i16((LAS s16x4*)ta), hi = __builtin_amdgcn_ds_read_tr16_b64_v4i16((LAS s16x4*)(ta + 4 * 272));
                Ak[s2] = (bf16x8){lo[0], lo[1], lo[2], lo[3], hi[0], hi[1], hi[2], hi[3]}; }
#pragma unroll
            for (int s2 = 0; s2 < 2; ++s2)
#pragma unroll
                for (int nt = 0; nt < 2; ++nt) S[mt][nt] = MFMA16(Ak[s2], Bv[s2][nt], S[mt][nt]);
#pragma unroll
            for (int nt = 0; nt < 2; ++nt) S[mt][nt] = S[mt][nt] * ebv;
        }
        if (OUT) {
#pragma unroll
            for (int mt = 0; mt < 4; ++mt)
#pragma unroll
                for (int e = 0; e < 4; ++e) {
                    float s = o[mt][0][e] * o[mt][0][e] + o[mt][1][e] * o[mt][1][e];
                    s = row16_sum(s);
                    if (r == 0) SSQ[(16 * mt + 4 * q + e) * 8 + w] = s;
                }
            __syncthreads();
            const float ng0 = ((const GAS float*)normg)[32 * w + r], ng1 = ((const GAS float*)normg)[32 * w + 16 + r];
#pragma unroll
            for (int mt = 0; mt < 4; ++mt)
#pragma unroll
                for (int e = 0; e < 4; ++e) {
                    const int i_ = 16 * mt + 4 * q + e;
                    const f32x4 sa = *(const LAS f32x4*)(lds + G_SS + i_ * 32), sb = *(const LAS f32x4*)(lds + G_SS + i_ * 32 + 16);
                    const float tot2 = ((sa.x + sa.y) + (sa.z + sa.w)) + ((sb.x + sb.y) + (sb.z + sb.w));
                    const float rs = __builtin_amdgcn_rsqf(tot2 * (1.f / 256.f) + EPS);
                    LAS bf16* gp = (LAS bf16*)(lds + G_GT + i_ * 528 + (32 * w + r) * 2);
                    const float ga = bf2f(gp[0]), gb = bf2f(gp[16]);
                    const float va = o[mt][0][e] * rs * ng0 * ga * __builtin_amdgcn_rcpf(1.f + __expf(-ga));
                    const float vb = o[mt][1][e] * rs * ng1 * gb * __builtin_amdgcn_rcpf(1.f + __expf(-gb));
                    const unsigned pv = pkbf(va, vb);
                    gp[0] = (bf16)(pv & 0xffffu); gp[16] = (bf16)(pv >> 16);
                }
            __syncthreads();
#pragma unroll
            for (int i = 0; i < 4; ++i) { const int c = tl + 512 * i, row = c >> 5, c16 = c & 31;
                *(GAS u32x4*)((GAS bf16*)mix + (size_t)(t0 + row) * MIXLD + 512 + h * 256 + c16 * 8) = *(const LAS u32x4*)(lds + G_GT + row * 528 + c16 * 16); }
        }
        __syncthreads();
    }
    if (!OUT) {
#pragma unroll
        for (int mt = 0; mt < 8; ++mt)
#pragma unroll
            for (int nt = 0; nt < 2; ++nt)
#pragma unroll
                for (int i = 0; i < 4; ++i) Eu[((mt * 2 + nt) * 4 + i) * 64] = S[mt][nt][i];
        if (seg == 0) DEC[unit * 128 + k] = __expf(bsum);
    }
}

__device__ __forceinline__ void shortconv(const bf16* z, const float* wsc, bf16* mix, int gtid, int gthreads) {
    for (int idx = gtid; idx < (T / 8) * 256; idx += gthreads) {
        const int tb = (idx >> 8) * 8, c = (idx & 255) * 2;
        unsigned x2[10], c2[10], b2[8];
#pragma unroll
        for (int r = 0; r < 10; ++r) { const int tt = tb - 2 + r, tc = tt < 0 ? 0 : tt; const bf16* zr = z + (size_t)tc * ZLD + c; x2[r] = *(const unsigned*)(zr + ZSX); c2[r] = *(const unsigned*)(zr + ZSC); }
#pragma unroll
        for (int o = 0; o < 8; ++o) b2[o] = *(const unsigned*)(z + (size_t)(tb + o) * ZLD + ZSB + c);
        f32x2 wj[3];
#pragma unroll
        for (int j = 0; j < 3; ++j) wj[j] = *(const f32x2*)(wsc + j * 512 + c);
        float m0[10], m1[10];
#pragma unroll
        for (int r = 0; r < 10; ++r) { const bool ok = (tb - 2 + r) >= 0; m0[r] = ok ? bf2f(x2[r] & 0xffffu) * bf2f(c2[r] & 0xffffu) : 0.f; m1[r] = ok ? bf2f(x2[r] >> 16) * bf2f(c2[r] >> 16) : 0.f; }
#pragma unroll
        for (int o = 0; o < 8; ++o) {
            const float a0 = wj[0].x * m0[o] + wj[1].x * m0[o + 1] + wj[2].x * m0[o + 2], a1 = wj[0].y * m1[o] + wj[1].y * m1[o + 1] + wj[2].y * m1[o + 2];
            *(unsigned*)(mix + (size_t)(tb + o) * MIXLD + c) = pkbf(bf2f(b2[o] & 0xffffu) * a0, bf2f(b2[o] >> 16) * a1);
        }
    }
}

__device__ __forceinline__ void gla_scan(float* E, const float* DEC, int gtid, int gthreads) {
    for (int e = gtid; e < 4 * 32768; e += gthreads) {
        const int h = e >> 15, rem = e & 32767, rr = (rem >> 6) & 63, ln = rem & 63;
        const int k = 16 * (rr >> 3) + 4 * (ln >> 4) + (rr & 3);
        float* p = E + (size_t)h * 32768 + rem; const float* dp = DEC + h * 128 + k;
        float s = 0.f;
#pragma unroll 1
        for (int gb = 0; gb < 64; gb += 16) {
            float tv[16], dv[16];
#pragma unroll
            for (int i = 0; i < 16; ++i) { tv[i] = p[(size_t)(gb + i) * 4 * 32768]; dv[i] = dp[(gb + i) * 512]; }
#pragma unroll
            for (int i = 0; i < 16; ++i) { p[(size_t)(gb + i) * 4 * 32768] = s; s = dv[i] * s + tv[i]; }
        }
    }
}

__device__ __forceinline__ void conv_phase(const bf16* u, const float* wdw, const float* bdw, const float* lng, const float* lnb, bf16* dout, LAS unsigned char* lds, int G, int bid) {
    const int tid = tid_l(), lane = tid & 63, w = tid >> 6;
    LAS unsigned* UL = (LAS unsigned*)lds;
    LAS f32x2* RED = (LAS f32x2*)(lds + 126976);
    LAS f32x2* STAT = (LAS f32x2*)(lds + 126976 + 2048);
    f32x2 wv[31];
#pragma unroll
    for (int j = 0; j < 31; ++j) wv[j] = *(const f32x2*)(wdw + j * 1024 + 2 * tid);
    const f32x2 bd = *(const f32x2*)(bdw + 2 * tid), lg = *(const f32x2*)(lng + 2 * tid), lb = *(const f32x2*)(lnb + 2 * tid);
    for (int tile = bid; tile < T / 32; tile += G) {
        const int t0 = tile * 32;
#pragma unroll 1
        for (int hb = 0; hb < 2; ++hb) {
            u32x4 sv[8];
#pragma unroll
            for (int it = 0; it < 8; ++it) { const int i = tid + (hb * 8 + it) * NTHR; int rr = i >> 7; rr = rr > 61 ? 61 : rr; const int cc = i & 127, t = t0 - 30 + rr, tc = t < 0 ? 0 : t;
                sv[it] = *(const u32x4*)(u + (size_t)tc * D + cc * 8); if (t < 0) sv[it] = (u32x4){0u, 0u, 0u, 0u}; }
#pragma unroll
            for (int it = 0; it < 8; ++it) { const int i = tid + (hb * 8 + it) * NTHR, rr = i >> 7, cc = i & 127; if (i < 62 * 128) *(LAS u32x4*)(lds + rr * 2048 + cc * 16) = sv[it]; }
        }
        __syncthreads();
#pragma unroll 1
        for (int sub = 0; sub < 2; ++sub) {
            f32x2 dv[16];
#pragma unroll
            for (int tt = 0; tt < 16; ++tt) dv[tt] = bd;
            const LAS unsigned* ULs = UL + sub * 16 * 512 + tid;
#pragma unroll
            for (int rb = 0; rb < 48; rb += 8) {
                unsigned ub[8];
#pragma unroll
                for (int i = 0; i < 8; ++i) ub[i] = (rb + i < 46) ? ULs[(rb + i) * 512] : 0u;
                asm volatile("" : "+v"(ub[0]), "+v"(ub[1]), "+v"(ub[2]), "+v"(ub[3]), "+v"(ub[4]), "+v"(ub[5]), "+v"(ub[6]), "+v"(ub[7]));
#pragma unroll
                for (int i = 0; i < 8; ++i) { const int rr = rb + i; if (rr < 46) { const f32x2 u2 = (f32x2){bf2f(ub[i] & 0xffffu), bf2f(ub[i] >> 16)};
#pragma unroll
                    for (int tt = 0; tt < 16; ++tt) { if (rr - tt >= 0 && rr - tt <= 30) dv[tt] = __builtin_elementwise_fma(wv[rr - tt], u2, dv[tt]); } } }
            }
#pragma unroll
            for (int tt = 0; tt < 16; ++tt) {
                float s1 = dv[tt].x + dv[tt].y, s2 = dv[tt].x * dv[tt].x + dv[tt].y * dv[tt].y;
                s1 = wave_sum(s1); s2 = wave_sum(s2);
                if (lane == 0) RED[tt * 8 + w] = (f32x2){s1, s2};
            }
            __syncthreads();
            if (tid < 16) { float s1 = 0.f, s2 = 0.f;
#pragma unroll
                for (int i = 0; i < 8; ++i) { const f32x2 t = RED[tid * 8 + i]; s1 += t.x; s2 += t.y; }
                const float mean = s1 * (1.f / D); const float var = fmaxf(s2 * (1.f / D) - mean * mean, 0.f);
                STAT[tid] = (f32x2){mean, __builtin_amdgcn_rsqf(var + EPS)}; }
            __syncthreads();
#pragma unroll
            for (int tt = 0; tt < 16; ++tt) {
                const f32x2 st = STAT[tt];
                const float a = (dv[tt].x - st.x) * st.y * lg.x + lb.x, b = (dv[tt].y - st.x) * st.y * lg.y + lb.y;
                const float sa = a * __builtin_amdgcn_rcpf(1.f + __expf(-a)), sb = b * __builtin_amdgcn_rcpf(1.f + __expf(-b));
                *(unsigned*)(dout + (size_t)(t0 + sub * 16 + tt) * D + 2 * tid) = pkbf(sa, sb);
            }
        }
        __syncthreads();
    }
}

#define XB_TMO      128
#define XB_XCNT(j)  (256  + 64 * (j))
#define XB_XSUB(j)  (1280 + 64 * (j))
#define XB_XGEN(j)  (2304 + 64 * (j))
#define XB_TOP      3328
#define XB_TOPGEN   3392
#define XCD_BAR_WORDS 3456
#define XB_SPIN_CAP (1u << 18)

__device__ __forceinline__ unsigned xb_ld(unsigned* p)              { return __hip_atomic_load(p, __ATOMIC_RELAXED, __HIP_MEMORY_SCOPE_AGENT); }
__device__ __forceinline__ unsigned xb_add(unsigned* p, unsigned v) { return __hip_atomic_fetch_add(p, v, __ATOMIC_RELAXED, __HIP_MEMORY_SCOPE_AGENT); }
__device__ __forceinline__ unsigned xb_xcc_id() { return (unsigned)__builtin_amdgcn_s_getreg((3 << 11) | 20) & 0xFu; }
#define XB_SPIN(cond, bar) do { unsigned _sp = 0; while (cond) { __builtin_amdgcn_s_sleep(1); \
    if ((++_sp & 255u) == 0u) { if (xb_ld(&(bar)[XB_TMO])) break; if (_sp > XB_SPIN_CAP) { atomicAdd(&(bar)[XB_TMO], 1u); break; } } } } while (0)

struct XcdBarrier {
    unsigned* bar; unsigned x;
    volatile LAS unsigned* st;
};

__device__ __forceinline__ XcdBarrier xcd_barrier_post(unsigned* bar, volatile LAS unsigned* st) {
    XcdBarrier b; b.bar = bar; b.x = xb_xcc_id(); b.st = st;
    if (threadIdx.x == 0) (void)xb_add(&bar[XB_XCNT(b.x)], 1u);
    return b;
}
__device__ __forceinline__ void xcd_barrier_complete(unsigned* bar, unsigned x, unsigned& nloc, unsigned& nx) {
    const unsigned G = gridDim.x * gridDim.y * gridDim.z;
    unsigned sum, cnt, mine, sp = 0u;
    for (;;) {
        sum = 0u; cnt = 0u; mine = 0u;
#pragma unroll
        for (unsigned j = 0; j < 16; ++j) { const unsigned c = xb_ld(&bar[XB_XCNT(j)]); sum += c; cnt += (c > 0u) ? 1u : 0u; mine = (j == x) ? c : mine; }
        if (sum == G) break;
        __builtin_amdgcn_s_sleep(1);
        if ((++sp & 255u) == 0u) { if (xb_ld(&bar[XB_TMO])) break; if (sp > XB_SPIN_CAP) { atomicAdd(&bar[XB_TMO], 1u); break; } }
    }
    nloc = mine > 0u ? mine : 1u; nx = cnt > 0u ? cnt : 1u;
}

__device__ __forceinline__ void xcd_barrier(const XcdBarrier& b) {
    asm volatile("s_waitcnt vmcnt(0)" ::: "memory");
    __syncthreads();
    if (threadIdx.x == 0) {
        unsigned* bar = b.bar; asm volatile("" : "+s"(bar));
        unsigned bx = (unsigned)__builtin_amdgcn_readfirstlane((int)b.x); asm volatile("" : "+s"(bx));
        __builtin_amdgcn_s_waitcnt(0);
        unsigned nloc = b.st[0], nx = b.st[1];
        if (nloc == 0u) { xcd_barrier_complete(bar, bx, nloc, nx); b.st[0] = nloc; b.st[1] = nx; }
        const unsigned old = xb_add(&bar[XB_XSUB(bx)], 1u);
        const unsigned gen = old / nloc;
        if (old + 1u == (gen + 1u) * nloc) {
            __builtin_amdgcn_fence(__ATOMIC_RELEASE, "agent");
            asm volatile("s_waitcnt vmcnt(0)" ::: "memory");
            const unsigned og = xb_add(&bar[XB_TOP], 1u);
            const unsigned tg = og / nx;
            if (og + 1u == (tg + 1u) * nx) xb_add(&bar[XB_TOPGEN], 1u);
            else XB_SPIN(xb_ld(&bar[XB_TOPGEN]) == tg, bar);
            __builtin_amdgcn_fence(__ATOMIC_ACQUIRE, "agent");
            xb_add(&bar[XB_XGEN(bx)], 1u);
            asm volatile("s_waitcnt vmcnt(0)" ::: "memory");
        } else {
            XB_SPIN(xb_ld(&bar[XB_XGEN(bx)]) == gen, bar);
            __builtin_amdgcn_fence(__ATOMIC_ACQUIRE, "agent");
            asm volatile("s_waitcnt vmcnt(0)" ::: "memory");
        }
    }
    __syncthreads();
}

__global__ void __launch_bounds__(NTHR, 2) trunk_fwd(Args a) {
    extern __shared__ __attribute__((aligned(16))) unsigned char lds_raw[];
    LAS unsigned char* lds = (LAS unsigned char*)lds_raw;
    cg::grid_group grid = cg::this_grid();
    { volatile LAS unsigned* st0 = (volatile LAS unsigned*)(lds + LDS_BYTES - 16); if (threadIdx.x < 4) st0[threadIdx.x] = 0u; }
    __syncthreads();
    const XcdBarrier xbar = xcd_barrier_post((unsigned*)(a.ws + WS_BAR), (volatile LAS unsigned*)(lds + LDS_BYTES - 16));
    const int G0 = gridDim.x;
    if (a.ph_lo == 0x7fffffff) grid.sync();
#define IDS int bid = blockIdx.x; asm volatile("" : "+s"(bid)); const int tid = tid_l(), lane = tid & 63, wave = __builtin_amdgcn_readfirstlane(tid >> 6), gw = bid * NWAVES + wave, gtid = bid * NTHR + tid; (void)lane; (void)gw; (void)gtid;
    unsigned char* ws = a.ws; float* const xout = a.out;
#define Wb ((bf16*)(wsl + WS_W))
#define Eb ((float*)(wsl + WS_H))
#define DEC ((float*)(wsl + WS_DEC))
#define GK ((float*)(wsl + WS_GK))
#define EBLG ((float*)(wsl + WS_EBL))
#define big (wsl + WS_BIG)
#define Z ((bf16*)big)
#define MIX ((bf16*)(big + 144 * MiB))
#define U ((bf16*)big)
#define Dd ((bf16*)(big + 32 * MiB))
#define Ab ((bf16*)big)
#define ymlp ((float*)(big + 128 * MiB))
#define XB ((bf16*)xout)
#define XB2 ((bf16*)(big + 128 * MiB))
#define ymix ((float*)(big + ((l & 1) ? 64 * MiB : 0)))
#ifndef WGM_G1
#define WGM_G1 4
#endif
#ifndef WGM_G5
#define WGM_G5 4
#endif
#ifndef WGM_G3
#define WGM_G3 4
#endif
#ifndef PH_LO
#define PH_LO 0
#endif
#ifndef PH_HI
#define PH_HI 25
#endif
    constexpr int lo = PH_LO, hi = PH_HI;
#ifndef PROBE_MASK
#define PROBE_MASK 0u
#endif
#ifndef PROBE_MUL
#define PROBE_MUL 1
#endif
    unsigned long long pr_prev = PROBE_MASK ? __builtin_amdgcn_s_memrealtime() : 0ull, pr_acc = 0ull;
#define PR_STAMP() do { if (PROBE_MASK) { const unsigned long long t_ = __builtin_amdgcn_s_memrealtime(); if ((PROBE_MASK >> ph) & 1u) pr_acc += t_ - pr_prev; pr_prev = t_; } } while (0)
    int ph = 0;
#define PH_BEGIN if (ph >= lo && ph < hi) { IDS size_t wzo = 0; asm volatile("" : "+s"(wzo)); unsigned char* wsl = ws + wzo; int G = G0; asm volatile("" : "+s"(G)); const int NGW = G * NWAVES, gthreads = G * NTHR; (void)NGW; (void)gthreads;
#define PH_END   if (ph + 1 < hi) xcd_barrier(xbar); } PR_STAMP(); ++ph;

#define STATS(bank) pg8::RmsStats{(float*)(wsl + WS_X1), (unsigned*)(wsl + WS_CNT) + (size_t)(bank) * 4096}
#define SSX(i) ((float*)(wsl + WS_H))
#define RSTD_TAB_OFF 131072
#define FILL_RSTD_TAB(ssx_) do { LAS float* tab_ = (LAS float*)(lds + RSTD_TAB_OFF); const int rb_ = (bid & 7) * 2048; \
        for (int i_ = tid; i_ < 2048; i_ += NTHR) tab_[i_] = pg8::row_rstd((ssx_), rb_ + i_); __syncthreads(); } while (0)
    PH_BEGIN
        convert_layer<0>(wsl, 0, lds, gw, NGW, wave, lane);
        prologue_rows(inp(0), XB, SSX(0), gw, NGW, lane);
    PH_END

    for (int l = 0; l < DEPTH; ++l) {
        const int i2 = l >> 1;
        const bool first = (l == 0);
        if ((l & 1) == 0) {
            PH_BEGIN
                if (bid >= 192) { convert_layer<1>(wsl, l, lds, (bid - 192) * NWAVES + wave, 64 * NWAVES, wave, lane); __syncthreads(); }
                pg8::Gemm g{XB, Wb + WO_MIX1, T, ZN, D}; pg8::StaticOrder S; S.init(T, ZN, G, bid, WGM_G1);
                FILL_RSTD_TAB(SSX(2 * l));
                pg8::EpiZ E{Z, GK, (const LAS float*)(lds + RSTD_TAB_OFF)};
                pg8::gemm_phase<pg8::EpiZ, pg8::StaticOrder, true, true>(lds, g, S, E);
            PH_END
            PH_BEGIN
                for (int un = bid; un < 256; un += G)
                    gla_unit<false>(un, Z, GK, inp(6) + (size_t)i2 * 16 * 512, inp(7) + (size_t)i2 * 512, inp(9) + (size_t)i2 * 256, Eb, DEC, EBLG, MIX, lds);
                shortconv(Z, inp(8) + (size_t)i2 * 3 * 512, MIX, gtid, gthreads);
            PH_END
            PH_BEGIN
                gla_scan(Eb, DEC, gtid, gthreads);
            PH_END
            PH_BEGIN
                for (int un = bid; un < 256; un += G)
                    gla_unit<true>(un, Z, GK, inp(6) + (size_t)i2 * 16 * 512, inp(7) + (size_t)i2 * 512, inp(9) + (size_t)i2 * 256, Eb, DEC, EBLG, MIX, lds);
            PH_END
            PH_BEGIN
                pg8::Gemm g{MIX, Wb + WO_MIX2_E, T, D, MIXLD}; pg8::StaticOrder S; S.init(T, D, G, bid);
                if (first) { pg8::EpiNorm<false, true, false, true> E{inp(0), XB, SSX(2 * l + 1), nullptr, inp(2) + (size_t)l * D, STATS(2 * l)};
                    pg8::gemm_phase<pg8::EpiNorm<false, true, false, true>, pg8::StaticOrder, false, true>(lds, g, S, E); }
                else { pg8::EpiNorm<false, true, true, true> E{XB, XB, SSX(2 * l + 1), nullptr, inp(2) + (size_t)l * D, STATS(2 * l)};
                    pg8::gemm_phase<pg8::EpiNorm<false, true, true, true>, pg8::StaticOrder, false, true>(lds, g, S, E); }
            PH_END
        } else {
            PH_BEGIN
                pg8::Gemm g{XB, Wb + WO_MIX1, T, 2048, D}; pg8::StaticOrder S; S.init(T, 2048, G, bid, WGM_G5);
                FILL_RSTD_TAB(SSX(2 * l));
                pg8::EpiGLU E{U, inp(12) + (size_t)i2 * 2048, (const LAS float*)(lds + RSTD_TAB_OFF)};
                pg8::gemm_phase<pg8::EpiGLU, pg8::StaticOrder, true, true>(lds, g, S, E);
            PH_END
            PH_BEGIN
                convert_layer<1>(wsl, l, lds, gw, NGW, wave, lane);
                __syncthreads();
                conv_phase(U, inp(13) + (size_t)i2 * 31 * D, inp(14) + (size_t)i2 * D, inp(15) + (size_t)i2 * D, inp(16) + (size_t)i2 * D, Dd, lds, G, bid);
            PH_END
            PH_BEGIN
                pg8::Gemm g{Dd, Wb + WO_MIX2_O, T, D, D}; pg8::StaticOrder S; S.init(T, D, G, bid);
                pg8::EpiNorm<true, true, true, true> E{XB, (l + 1 < DEPTH) ? (void*)XB : (void*)XB2, SSX(2 * l + 1), inp(18) + (size_t)i2 * D, inp(2) + (size_t)l * D, STATS(2 * l)};
                pg8::gemm_phase<pg8::EpiNorm<true, true, true, true>, pg8::StaticOrder, false, true>(lds, g, S, E);
            PH_END
        }
        PH_BEGIN
            if (l + 1 < DEPTH) { convert_layer<0>(wsl, l + 1, lds, gw, NGW, wave, lane); __syncthreads(); }
            pg8::Gemm g{(l + 1 < DEPTH) ? XB : XB2, Wb + WO_W1, T, FF, D}; pg8::StaticOrder S; S.init(T, FF, G, bid, WGM_G3);
            FILL_RSTD_TAB(SSX(2 * l + 1));
            pg8::EpiRelu2 E{Ab, FF, (const LAS float*)(lds + RSTD_TAB_OFF)};
            pg8::gemm_phase<pg8::EpiRelu2, pg8::StaticOrder, true, true>(lds, g, S, E);
        PH_END
        PH_BEGIN
            pg8::Gemm g{Ab, Wb + WO_W2, T, D, FF}; pg8::StaticOrder S; S.init(T, D, G, bid);
            if (l + 1 < DEPTH) { pg8::EpiNorm<false, true, true, true> E{XB, XB, SSX(2 * l + 2), nullptr, inp(4) + (size_t)l * D, STATS(2 * l + 1)};
                pg8::gemm_phase<pg8::EpiNorm<false, true, true, true>, pg8::StaticOrder, false, true>(lds, g, S, E); }
            else { pg8::EpiNorm<false, false, true, false> E{XB2, xout, nullptr, nullptr, inp(4) + (size_t)l * D, STATS(2 * l + 1)};
                pg8::gemm_phase<pg8::EpiNorm<false, false, true, false>, pg8::StaticOrder, false, true>(lds, g, S, E); }
        PH_END
    }
    if (PROBE_MASK) { if (blockIdx.x == 0) { const unsigned long long t_end = __builtin_amdgcn_s_memrealtime(); while (__builtin_amdgcn_s_memrealtime() - t_end < pr_acc * PROBE_MUL) __builtin_amdgcn_s_sleep(8); } }
}

extern "C" void kernel_launch(void* const* d_in, const int* in_sizes, int n_in, void* d_out, int out_size, void* d_ws, size_t ws_size, hipStream_t stream) {
    static int grid = 0;
    if (grid == 0) {
        if (n_in != 21 || out_size != T * D || ws_size < WS_END) { fprintf(stderr, "kernel_launch: unexpected shapes (n_in %d out %d ws %zu)\n", n_in, out_size, ws_size); grid = -1; return; }
        int dev = 0, cus = 0, per_cu = 0;
        hipGetDevice(&dev); hipDeviceGetAttribute(&cus, hipDeviceAttributeMultiprocessorCount, dev);
        if (hipFuncSetAttribute((const void*)trunk_fwd, hipFuncAttributeMaxDynamicSharedMemorySize, LDS_BYTES) != hipSuccess) { fprintf(stderr, "kernel_launch: hipFuncSetAttribute failed\n"); grid = -1; return; }
        if (hipOccupancyMaxActiveBlocksPerMultiprocessor(&per_cu, (const void*)trunk_fwd, NTHR, LDS_BYTES) != hipSuccess || per_cu < 1) { fprintf(stderr, "kernel_launch: occupancy query failed (%d)\n", per_cu); (void)hipGetLastError(); per_cu = 1; }
        grid = cus * per_cu; if (grid > 256) grid = 256;
        if (grid != 256) { fprintf(stderr, "kernel_launch: this kernel needs exactly 256 co-resident workgroups (got %d)\n", grid); grid = -1; return; }
    }
    if (grid < 0) return;
    Args a{};
    for (int i = 0; i < 21; ++i) a.in[i] = (const float*)d_in[i];
    a.out = (float*)d_out; a.ws = (unsigned char*)d_ws; a.ph_lo = 0; a.ph_hi = 25;
    if (hipMemsetAsync(d_ws, 0, 144u * 1024u, stream) != hipSuccess) { fprintf(stderr, "kernel_launch: memset failed\n"); return; }
    void* args[] = {&a};
    hipError_t e = hipLaunchCooperativeKernel((const void*)trunk_fwd, dim3(grid), dim3(NTHR), args, LDS_BYTES, stream);
    if (e != hipSuccess) fprintf(stderr, "cooperative launch failed: %s (grid %d)\n", hipGetErrorString(e), grid);
}
```

```cpp
#include <hip/hip_runtime.h>
#include <cstdio>
#include <cstdint>
namespace pg8 {
#define PG8_LAS __attribute__((address_space(3)))
typedef unsigned short bf16_t;
typedef short bf16x8 __attribute__((ext_vector_type(8)));
typedef float f32x4 __attribute__((ext_vector_type(4)));
typedef unsigned u32x4 __attribute__((ext_vector_type(4)));
constexpr int BM = 256, BK = 64, HALF = 128, HTB = HALF * BK * 2  , STAGE_BYTES = 8 * HTB, NXCD = 8, WGM = 4;

__host__ __device__ __forceinline__ int lds_byte(int r, int c) { const int st = (r >> 4) * 2 + (c >> 5), rr = r & 15, cc = c & 31, ob = rr * 64 + cc * 2; return st * 1024 + (ob ^ (((ob >> 9) & 1) << 5)); }
__host__ __device__ __forceinline__ void stage_rc(int b, int& R, int& C) { const int st = b / 1024, sb = b % 1024, swz = sb ^ (((sb >> 9) & 1) << 5); R = (st >> 1) * 16 + swz / 64; C = (st & 1) * 32 + (swz % 64) / 2; }
__host__ __device__ __forceinline__ int perm32(int rho) { const int n = rho >> 4, i = rho & 15; return 8 * (i >> 2) + 4 * n + (i & 3); }

struct Unit { int pm, pn; };
struct Gemm { const bf16_t* A; const bf16_t* Bt; int M, N, K; };

struct StaticOrder {
    int nM, nN, nwg, G, c, wgm;
    __host__ __device__ void init(int M, int N, int G_, int c_, int wgm_ = WGM) { nM = M / BM; nN = N / BM; nwg = nM * nN; G = G_; c = c_; wgm = wgm_; }
    __host__ __device__ bool next(int i, Unit& u) const {
        const long L = (long)i * G + c; if (L >= nwg) return false;
        int wgid = (int)L; { const int q = nwg / NXCD, r = nwg % NXCD, xcd = wgid % NXCD, off = wgid / NXCD; wgid = (xcd < r ? xcd * (q + 1) : r * (q + 1) + (xcd - r) * q) + off; }
        const int nig = wgm * nN, gid = wgid / nig, fm = gid * wgm, gsz = (nM - fm) < wgm ? (nM - fm) : wgm;
        u.pm = fm + ((wgid % nig) % gsz); u.pn = (wgid % nig) / gsz; return true;
    }
    __device__ __forceinline__ void a_ready(const Unit&) const {}
    __device__ __forceinline__ void done(const Unit&) const {}
};
__device__ __forceinline__ unsigned cvt_pk_bf16(float lo, float hi) { unsigned r; asm volatile("v_cvt_pk_bf16_f32 %0, %1, %2" : "=v"(r) : "v"(lo), "v"(hi)); return r; }
typedef float f32x2 __attribute__((ext_vector_type(2)));
}
namespace pg8 {
__device__ __forceinline__ float row_rstd(const float* ssp, int row) {
    const f32x4 a = *(const f32x4*)(ssp + (size_t)row * 4);
    return __builtin_amdgcn_rsqf(((a[0] + a[1]) + (a[2] + a[3])) * (1.0f / 1024.0f) + 1e-6f);
}
struct EpiZ {
    static constexpr bool PERM = true, AFTER_DRAIN = false;
    bf16_t* Z; float* GK; const PG8_LAS float* tab;
    __device__ __forceinline__ void operator()(const f32x4 (&acc)[2][2][4][2], const Unit& u, int wr, int wc, int fr, int fq) const {
        const int row0 = u.pm * BM + wr * 64 + fr;
        float rsv[2][4];
#pragma unroll
        for (int ai = 0; ai < 2; ++ai)
#pragma unroll
            for (int m = 0; m < 4; ++m) rsv[ai][m] = tab[(u.pm & 7) * 256 + wr * 64 + fr + ai * HALF + m * 16];
        if (u.pn < 18) {
            const int col0 = u.pn * BM + wc * 32 + 8 * fq;
#pragma unroll
            for (int ai = 0; ai < 2; ++ai)
#pragma unroll
                for (int m = 0; m < 4; ++m) { bf16_t* rowp = Z + (size_t)(row0 + ai * HALF + m * 16) * 4608 + col0;
#pragma unroll
                    for (int bj = 0; bj < 2; ++bj) { const f32x4 v0 = acc[ai][bj][m][0] * rsv[ai][m], v1 = acc[ai][bj][m][1] * rsv[ai][m];
                        u32x4 w; w.x = cvt_pk_bf16(v0[0], v0[1]); w.y = cvt_pk_bf16(v0[2], v0[3]); w.z = cvt_pk_bf16(v1[0], v1[1]); w.w = cvt_pk_bf16(v1[2], v1[3]);
                        *(u32x4*)(rowp + bj * HALF) = w; } }
        } else if (wc == 0 && fq < 2) {
#pragma unroll
            for (int ai = 0; ai < 2; ++ai)
#pragma unroll
                for (int m = 0; m < 4; ++m) { float* rp = GK + (size_t)(row0 + ai * HALF + m * 16) * 16 + 8 * fq;
                    *(f32x4*)rp = acc[ai][0][m][0] * rsv[ai][m]; *(f32x4*)(rp + 4) = acc[ai][0][m][1] * rsv[ai][m]; }
        }
    }
};
template <bool HAS_BIAS> struct EpiF32 {
    static constexpr bool PERM = false, AFTER_DRAIN = false;
    float* C; int ldc; const float* bias;
    __device__ __forceinline__ void operator()(const f32x4 (&acc)[2][2][4][2], const Unit& u, int wr, int wc, int fr, int fq) const {
        const int row0 = u.pm * BM + wr * 64 + fr, col0 = u.pn * BM + wc * 32 + 4 * fq;
        f32x4 bv[2][2];
#pragma unroll
        for (int bj = 0; bj < 2; ++bj)
#pragma unroll
            for (int n = 0; n < 2; ++n) bv[bj][n] = HAS_BIAS ? *(const f32x4*)(bias + col0 + bj * HALF + n * 16) : (f32x4){0.f, 0.f, 0.f, 0.f};
#pragma unroll
        for (int ai = 0; ai < 2; ++ai)
#pragma unroll
            for (int m = 0; m < 4; ++m) { float* rowp = C + (size_t)(row0 + ai * HALF + m * 16) * ldc + col0;
#pragma unroll
                for (int bj = 0; bj < 2; ++bj)
#pragma unroll
                    for (int n = 0; n < 2; ++n) *(f32x4*)(rowp + bj * HALF + n * 16) = acc[ai][bj][m][n] + bv[bj][n]; }
    }
};
struct EpiRelu2 {
    static constexpr bool PERM = true, AFTER_DRAIN = false;
    bf16_t* O; int ldc; const PG8_LAS float* tab;
    __device__ __forceinline__ void operator()(const f32x4 (&acc)[2][2][4][2], const Unit& u, int wr, int wc, int fr, int fq) const {
        const int row0 = u.pm * BM + wr * 64 + fr, col0 = u.pn * BM + wc * 32 + 8 * fq;
#pragma unroll
        for (int ai = 0; ai < 2; ++ai)
#pragma unroll
            for (int m = 0; m < 4; ++m) { bf16_t* rowp = O + (size_t)(row0 + ai * HALF + m * 16) * ldc + col0; const float rs = tab[(u.pm & 7) * 256 + wr * 64 + fr + ai * HALF + m * 16];
#pragma unroll
                for (int bj = 0; bj < 2; ++bj) { f32x4 v0 = acc[ai][bj][m][0] * rs, v1 = acc[ai][bj][m][1] * rs;
#pragma unroll
                    for (int j = 0; j < 4; ++j) { const float a = fmaxf(v0[j], 0.f), b = fmaxf(v1[j], 0.f); v0[j] = a * a; v1[j] = b * b; }
                    u32x4 w; w.x = cvt_pk_bf16(v0[0], v0[1]); w.y = cvt_pk_bf16(v0[2], v0[3]); w.z = cvt_pk_bf16(v1[0], v1[1]); w.w = cvt_pk_bf16(v1[2], v1[3]);
                    *(u32x4*)(rowp + bj * HALF) = w; } }
    }
};
struct EpiGLU {
    static constexpr bool PERM = true, AFTER_DRAIN = false;
    bf16_t* U; const float* bias; const PG8_LAS float* tab;
    __device__ __forceinline__ void operator()(const f32x4 (&acc)[2][2][4][2], const Unit& u, int wr, int wc, int fr, int fq) const {
        const int row0 = u.pm * BM + wr * 64 + fr, col0 = u.pn * HALF + wc * 32 + 8 * fq;
        f32x4 b1[2], b2[2];
#pragma unroll
        for (int n = 0; n < 2; ++n) { b1[n] = *(const f32x4*)(bias + col0 + 4 * n); b2[n] = *(const f32x4*)(bias + 1024 + col0 + 4 * n); }
#pragma unroll
        for (int ai = 0; ai < 2; ++ai)
#pragma unroll
            for (int m = 0; m < 4; ++m) { bf16_t* rowp = U + (size_t)(row0 + ai * HALF + m * 16) * 1024 + col0; const float rs = tab[(u.pm & 7) * 256 + wr * 64 + fr + ai * HALF + m * 16];
                f32x4 o[2];
#pragma unroll
                for (int n = 0; n < 2; ++n) { const f32x4 a = acc[ai][0][m][n] * rs + b1[n], g = acc[ai][1][m][n] * rs + b2[n];
#pragma unroll
                    for (int j = 0; j < 4; ++j) o[n][j] = a[j] * __builtin_amdgcn_rcpf(1.f + __expf(-g[j])); }
                u32x4 w; w.x = cvt_pk_bf16(o[0][0], o[0][1]); w.y = cvt_pk_bf16(o[0][2], o[0][3]); w.z = cvt_pk_bf16(o[1][0], o[1][1]); w.w = cvt_pk_bf16(o[1][2], o[1][3]);
                *(u32x4*)rowp = w; }
    }
};

struct RmsStats {
    float* xbuf;
    unsigned* cnt;
    __device__ __forceinline__ void run(const f32x4 (&v)[2][2][4][2], const Unit& u, int wr, int wc, int fr, int fq, PG8_LAS unsigned char* lds, int wid, int lane) const {
        PG8_LAS float* P = (PG8_LAS float*)lds;
        PG8_LAS float* S = (PG8_LAS float*)(lds + 4096);
#pragma unroll
        for (int ai = 0; ai < 2; ++ai)
#pragma unroll
            for (int m = 0; m < 4; ++m) {
                float s = 0.f;
#pragma unroll
                for (int bj = 0; bj < 2; ++bj)
#pragma unroll
                    for (int n = 0; n < 2; ++n) { const f32x4 x = v[ai][bj][m][n]; s += (x[0] * x[0] + x[1] * x[1]) + (x[2] * x[2] + x[3] * x[3]); }
                s += __shfl_xor(s, 16); s += __shfl_xor(s, 32);
                if (fq == 0) P[(ai * HALF + wr * 64 + m * 16 + fr) * 4 + wc] = s;
            }
        asm volatile("s_waitcnt lgkmcnt(0)" ::: "memory"); __builtin_amdgcn_s_barrier(); asm volatile("" ::: "memory");
        const int row = wid * 32 + (lane & 31);
        if (lane < 32) { const f32x4 p = *(const PG8_LAS f32x4*)(P + row * 4); const float t = (p[0] + p[1]) + (p[2] + p[3]);
            __hip_atomic_store(xbuf + ((size_t)(u.pm * BM + row) * 4 + u.pn), t, __ATOMIC_RELAXED, __HIP_MEMORY_SCOPE_AGENT); }
        asm volatile("s_waitcnt vmcnt(0)" ::: "memory");
        if (lane == 0) __hip_atomic_fetch_add(cnt + 64 * u.pm, 1u, __ATOMIC_RELAXED, __HIP_MEMORY_SCOPE_AGENT);
        if (wid == 0) {
            unsigned sp = 0u;
            while ((unsigned)__builtin_amdgcn_readfirstlane(__hip_atomic_load(cnt + 64 * u.pm, __ATOMIC_RELAXED, __HIP_MEMORY_SCOPE_AGENT)) < 32u) { __builtin_amdgcn_s_sleep(2); if (++sp > (1u << 22)) break; }
        }
        asm volatile("s_waitcnt vmcnt(0) lgkmcnt(0)" ::: "memory"); __builtin_amdgcn_s_barrier(); asm volatile("" ::: "memory");
        if (lane < 32) { const float* slot = xbuf + (size_t)(u.pm * BM + row) * 4; float t = 0.f;
#pragma unroll
            for (int i = 0; i < 4; ++i) t += __hip_atomic_load(slot + i, __ATOMIC_RELAXED, __HIP_MEMORY_SCOPE_AGENT);
            S[row] = __builtin_amdgcn_rsqf(t * (1.0f / 1024.0f) + 1e-6f); }
        asm volatile("s_waitcnt lgkmcnt(0)" ::: "memory"); __builtin_amdgcn_s_barrier(); asm volatile("" ::: "memory");
    }
};
template <bool HAS_BIAS, bool HAS_PRE, bool XS_BF16, bool XD_BF16> struct EpiNorm {
    static constexpr bool PERM = false, AFTER_DRAIN = true;
    const void* xs; void* xd; float* ssq_out; const float* bias; const float* gpost; RmsStats st1;
    __device__ __forceinline__ void fused(f32x4 (&acc)[2][2][4][2], const Unit& u, int wr, int wc, int fr, int fq, PG8_LAS unsigned char* lds, int wid, int lane) const {
        typedef unsigned u32x2v __attribute__((ext_vector_type(2)));
        const PG8_LAS float* S = (const PG8_LAS float*)(lds + 4096);
        const int col0 = u.pn * BM + wc * 32 + 4 * fq;
        if (HAS_BIAS) {
#pragma unroll
            for (int bj = 0; bj < 2; ++bj)
#pragma unroll
                for (int n = 0; n < 2; ++n) { const f32x4 bv = *(const f32x4*)(bias + col0 + bj * HALF + n * 16);
#pragma unroll
                    for (int ai = 0; ai < 2; ++ai)
#pragma unroll
                        for (int m = 0; m < 4; ++m) acc[ai][bj][m][n] += bv; }
        }
        f32x4 gv[2][2];
#pragma unroll
        for (int bj = 0; bj < 2; ++bj)
#pragma unroll
            for (int n = 0; n < 2; ++n) gv[bj][n] = *(const f32x4*)(gpost + col0 + bj * HALF + n * 16);
        st1.run(acc, u, wr, wc, fr, fq, lds, wid, lane);
#pragma unroll
        for (int ai = 0; ai < 2; ++ai)
#pragma unroll
        for (int mp = 0; mp < 2; ++mp) {
            f32x4 xv[2][2][2];
#pragma unroll
            for (int mm = 0; mm < 2; ++mm) { const size_t off = (size_t)(u.pm * BM + ai * HALF + wr * 64 + (2 * mp + mm) * 16 + fr) * 1024 + col0;
#pragma unroll
                for (int bj = 0; bj < 2; ++bj)
#pragma unroll
                    for (int n = 0; n < 2; ++n) {
                        if (XS_BF16) { const u32x2v p = *(const u32x2v*)((const bf16_t*)xs + off + bj * HALF + n * 16);
                            xv[mm][bj][n] = (f32x4){__uint_as_float(p.x << 16), __uint_as_float(p.x & 0xffff0000u), __uint_as_float(p.y << 16), __uint_as_float(p.y & 0xffff0000u)}; }
                        else xv[mm][bj][n] = *(const f32x4*)((const float*)xs + off + bj * HALF + n * 16); } }
#pragma unroll
            for (int mm = 0; mm < 2; ++mm) asm volatile("" : "+v"(xv[mm][0][0]), "+v"(xv[mm][0][1]), "+v"(xv[mm][1][0]), "+v"(xv[mm][1][1]));
#pragma unroll
            for (int mm = 0; mm < 2; ++mm) { const int m = 2 * mp + mm; const int r = ai * HALF + wr * 64 + m * 16 + fr; const float rs = S[r]; const size_t off = (size_t)(u.pm * BM + r) * 1024 + col0;
#pragma unroll
                for (int bj = 0; bj < 2; ++bj)
#pragma unroll
                    for (int n = 0; n < 2; ++n) { f32x4 o = xv[mm][bj][n] + acc[ai][bj][m][n] * rs * gv[bj][n];
                        if (XD_BF16) { u32x2v w; w.x = cvt_pk_bf16(o[0], o[1]); w.y = cvt_pk_bf16(o[2], o[3]); *(u32x2v*)((bf16_t*)xd + off + bj * HALF + n * 16) = w;
                            o = (f32x4){__uint_as_float(w.x << 16), __uint_as_float(w.x & 0xffff0000u), __uint_as_float(w.y << 16), __uint_as_float(w.y & 0xffff0000u)}; }
                        else *(f32x4*)((float*)xd + off + bj * HALF + n * 16) = o;
                        acc[ai][bj][m][n] = o; } }
        }
        if (HAS_PRE) {
            PG8_LAS float* P = (PG8_LAS float*)lds;
            P += 2048;
#pragma unroll
            for (int ai = 0; ai < 2; ++ai)
#pragma unroll
                for (int m = 0; m < 4; ++m) {
                    float s = 0.f;
#pragma unroll
                    for (int bj = 0; bj < 2; ++bj)
#pragma unroll
                        for (int n = 0; n < 2; ++n) { const f32x4 x = acc[ai][bj][m][n]; s += (x[0] * x[0] + x[1] * x[1]) + (x[2] * x[2] + x[3] * x[3]); }
                    s += __shfl_xor(s, 16); s += __shfl_xor(s, 32);
                    if (fq == 0) P[(ai * HALF + wr * 64 + m * 16 + fr) * 4 + wc] = s;
                }
            asm volatile("s_waitcnt lgkmcnt(0)" ::: "memory"); __builtin_amdgcn_s_barrier(); asm volatile("" ::: "memory");
            if (lane < 32) { const int row = wid * 32 + lane; const f32x4 p = *(const PG8_LAS f32x4*)(P + row * 4);
                ssq_out[(size_t)(u.pm * BM + row) * 4 + u.pn] = (p[0] + p[1]) + (p[2] + p[3]); }
        }
    }
};
}
namespace pg8 {
template <class Epi, class Sched, bool ALIGN_EPI = false, bool SP2 = false>
__device__ __forceinline__ void gemm_phase(PG8_LAS unsigned char* lds, const Gemm g, const Sched& S, const Epi& E) {
    int tid = threadIdx.x; asm volatile("" : "+v"(tid)); const int wid = __builtin_amdgcn_readfirstlane(tid >> 6), lane = tid & 63, wr = wid >> 2, wc = wid & 3, fr = lane & 15, fq = lane >> 4;
    const int K = g.K, nt = K / BK;
    unsigned voffA[2], voffB[2];
#pragma unroll
    for (int i = 0; i < 2; ++i) { int R, C; stage_rc(tid * 16 + i * 8192, R, C); const int Rb = Epi::PERM ? ((R & ~31) + perm32(R & 31)) : R;
        voffA[i] = (unsigned)(R * K + C) * 2u; voffB[i] = (unsigned)(Rb * K + C) * 2u; }
    const size_t kstep = (size_t)(BK * 2);
    const size_t hstep = (size_t)HALF * K * 2;
    const size_t tstep = 2 * hstep;
    const unsigned ldsw = (unsigned)wid * 1024u;
    const int aoff = lds_byte(wr * 64 + fr, fq * 8), boff = lds_byte(wc * 32 + fr, fq * 8);
#define PG8_SA(b, h) (((b) * 2 + (h)) * HTB)
#define PG8_SB(b, h) ((4 + (b) * 2 + (h)) * HTB)
#define PG8_STAGE(bufoff, gbase, voff) do { _Pragma("unroll") for (int _i = 0; _i < 2; ++_i) \
        __builtin_amdgcn_global_load_lds((const unsigned*)((const char*)(gbase) + (voff)[_i]), (PG8_LAS unsigned*)(lds + (bufoff) + ldsw + _i * 8192), 16, 0, 0); } while (0)
#define PG8_LDA(dst, b, h) do { _Pragma("unroll") for (int m = 0; m < 4; ++m) _Pragma("unroll") for (int k = 0; k < 2; ++k) dst[m][k] = *(const PG8_LAS bf16x8*)(lds + PG8_SA(b, h) + aoff + m * 2048 + k * 1024); } while (0)
#define PG8_LDB(dst, b, h) do { _Pragma("unroll") for (int n = 0; n < 2; ++n) _Pragma("unroll") for (int k = 0; k < 2; ++k) dst[n][k] = *(const PG8_LAS bf16x8*)(lds + PG8_SB(b, h) + boff + n * 2048 + k * 1024); } while (0)
#define PG8_MMA(ai, bj, At, Bt) do { __builtin_amdgcn_s_setprio(1); _Pragma("unroll") for (int m = 0; m < 4; ++m) _Pragma("unroll") for (int n = 0; n < 2; ++n) _Pragma("unroll") for (int k = 0; k < 2; ++k) \
        acc[ai][bj][m][n] = __builtin_amdgcn_mfma_f32_16x16x32_bf16(Bt[n][k], At[m][k], acc[ai][bj][m][n], 0, 0, 0); __builtin_amdgcn_s_setprio(0); } while (0)
#define PG8_WAIT_V(n) asm volatile("s_waitcnt vmcnt(" #n ")" ::: "memory")
#define PG8_WAIT_L(n) asm volatile("s_waitcnt lgkmcnt(" #n ")" ::: "memory")
#define PG8_BAR __builtin_amdgcn_s_barrier()
#define PG8_SCHED __builtin_amdgcn_sched_barrier(0)
    Unit cur, nxt; int ui = 0;
    if (!S.next(0, cur)) return;
    f32x4 acc[2][2][4][2];
#pragma unroll
    for (int a = 0; a < 2; ++a)
#pragma unroll
        for (int b = 0; b < 2; ++b)
#pragma unroll
            for (int m = 0; m < 4; ++m)
#pragma unroll
                for (int n = 0; n < 2; ++n) acc[a][b][m][n] = (f32x4){0.f, 0.f, 0.f, 0.f};
    bf16x8 At[4][2], B0[2][2], B1[2][2];
    const char* cA = (const char*)g.A + (size_t)cur.pm * tstep; const char* cB = (const char*)g.Bt + (size_t)cur.pn * tstep;
    S.a_ready(cur);
    if constexpr (SP2) {
        PG8_STAGE(PG8_SB(0, 0), cB, voffB); PG8_STAGE(PG8_SB(0, 1), cB + hstep, voffB); PG8_STAGE(PG8_SA(0, 0), cA, voffA); PG8_STAGE(PG8_SA(0, 1), cA + hstep, voffA);
        if (wr == 1) PG8_BAR;
        PG8_WAIT_V(2); PG8_BAR;
        PG8_STAGE(PG8_SB(1, 0), cB + kstep, voffB); PG8_STAGE(PG8_SA(1, 0), cA + kstep, voffA); PG8_STAGE(PG8_SB(1, 1), cB + hstep + kstep, voffB);
        PG8_WAIT_V(6); PG8_BAR;
    } else {
        PG8_STAGE(PG8_SB(0, 0), cB, voffB); PG8_STAGE(PG8_SA(0, 0), cA, voffA); PG8_STAGE(PG8_SB(0, 1), cB + hstep, voffB); PG8_STAGE(PG8_SA(0, 1), cA + hstep, voffA);
        if (wr == 1) PG8_BAR;
        PG8_WAIT_V(4); PG8_BAR;
        PG8_STAGE(PG8_SB(1, 0), cB + kstep, voffB); PG8_STAGE(PG8_SA(1, 0), cA + kstep, voffA); PG8_STAGE(PG8_SB(1, 1), cB + hstep + kstep, voffB);
        PG8_WAIT_V(6); PG8_BAR;
    }
    for (;;) {
        const bool has_next = S.next(ui + 1, nxt);
        const char* nA = has_next ? (const char*)g.A + (size_t)nxt.pm * tstep : cA; const char* nB = has_next ? (const char*)g.Bt + (size_t)nxt.pn * tstep : cB;
        for (int t = 0; t < nt; t += 2) {
            const bool last = (t == nt - 2);
            const char* a1 = cA + (size_t)(t + 1) * kstep;
            const char* a2 = last ? nA : cA + (size_t)(t + 2) * kstep; const char* b2 = last ? nB : cB + (size_t)(t + 2) * kstep;
            const char* a3 = a2 + kstep; const char* b3 = b2 + kstep;
            if (last && has_next) S.a_ready(nxt);
            if constexpr (SP2) {
            PG8_LDB(B0, 0, 0); PG8_LDB(B1, 0, 1); PG8_SCHED; PG8_LDA(At, 0, 0); PG8_STAGE(PG8_SA(1, 1), a1 + hstep, voffA);
            PG8_WAIT_V(8); PG8_WAIT_L(0); PG8_BAR; PG8_MMA(0, 0, At, B0); PG8_MMA(0, 1, At, B1); PG8_BAR; PG8_SCHED;
            PG8_LDA(At, 0, 1); PG8_STAGE(PG8_SB(0, 0), b2, voffB); PG8_STAGE(PG8_SB(0, 1), b2 + hstep, voffB); PG8_STAGE(PG8_SA(0, 0), a2, voffA);
            PG8_WAIT_V(8); PG8_WAIT_L(0); PG8_BAR; PG8_MMA(1, 0, At, B0); PG8_MMA(1, 1, At, B1); PG8_BAR; PG8_SCHED;
            PG8_LDB(B0, 1, 0); PG8_LDB(B1, 1, 1); PG8_SCHED; PG8_LDA(At, 1, 0); PG8_STAGE(PG8_SA(0, 1), a2 + hstep, voffA);
            PG8_WAIT_V(8); PG8_WAIT_L(0); PG8_BAR; PG8_MMA(0, 0, At, B0); PG8_MMA(0, 1, At, B1); PG8_BAR; PG8_SCHED;
            PG8_LDA(At, 1, 1); PG8_STAGE(PG8_SB(1, 0), b3, voffB); PG8_STAGE(PG8_SB(1, 1), b3 + hstep, voffB); PG8_STAGE(PG8_SA(1, 0), a3, voffA);
            PG8_WAIT_V(8); PG8_WAIT_L(0); PG8_BAR; PG8_MMA(1, 0, At, B0); PG8_MMA(1, 1, At, B1); PG8_BAR; PG8_SCHED;
            } else {
            PG8_LDB(B0, 0, 0); PG8_SCHED; PG8_LDA(At, 0, 0); PG8_STAGE(PG8_SA(1, 1), a1 + hstep, voffA);
            PG8_WAIT_L(8); PG8_BAR; PG8_WAIT_L(0); PG8_MMA(0, 0, At, B0); PG8_BAR; PG8_SCHED;
            PG8_LDB(B1, 0, 1); PG8_STAGE(PG8_SB(0, 0), b2, voffB);
            PG8_BAR; PG8_WAIT_L(0); PG8_MMA(0, 1, At, B1); PG8_BAR;
            PG8_LDA(At, 0, 1); PG8_STAGE(PG8_SA(0, 0), a2, voffA);
            PG8_BAR; PG8_WAIT_L(0); PG8_MMA(1, 0, At, B0); PG8_BAR; PG8_SCHED;
            PG8_STAGE(PG8_SB(0, 1), b2 + hstep, voffB);
            PG8_WAIT_V(6); PG8_BAR; PG8_MMA(1, 1, At, B1); PG8_BAR;
            PG8_LDB(B0, 1, 0); PG8_SCHED; PG8_LDA(At, 1, 0); PG8_STAGE(PG8_SA(0, 1), a2 + hstep, voffA);
            PG8_WAIT_L(8); PG8_BAR; PG8_WAIT_L(0); PG8_MMA(0, 0, At, B0); PG8_BAR; PG8_SCHED;
            PG8_LDB(B1, 1, 1); PG8_STAGE(PG8_SB(1, 0), b3, voffB);
            PG8_BAR; PG8_WAIT_L(0); PG8_MMA(0, 1, At, B1); PG8_BAR;
            PG8_LDA(At, 1, 1); PG8_STAGE(PG8_SA(1, 0), a3, voffA);
            PG8_BAR; PG8_WAIT_L(0); PG8_MMA(1, 0, At, B0); PG8_BAR; PG8_SCHED;
            PG8_STAGE(PG8_SB(1, 1), b3 + hstep, voffB);
            PG8_WAIT_V(6); PG8_BAR; PG8_MMA(1, 1, At, B1); PG8_BAR;
            }
        }
        if constexpr (ALIGN_EPI) { if (wr == 0) PG8_BAR; }
        if constexpr (!Epi::AFTER_DRAIN) { E(acc, cur, wr, wc, fr, fq); S.done(cur); }
        if (!has_next) break;
#pragma unroll
        for (int a = 0; a < 2; ++a)
#pragma unroll
            for (int b = 0; b < 2; ++b)
#pragma unroll
                for (int m = 0; m < 4; ++m)
#pragma unroll
                    for (int n = 0; n < 2; ++n) acc[a][b][m][n] = (f32x4){0.f, 0.f, 0.f, 0.f};
        cur = nxt; cA = nA; cB = nB; ++ui;
        if constexpr (ALIGN_EPI) { if (wr == 1) PG8_BAR; }
    }
    PG8_WAIT_V(0);
    if constexpr (!ALIGN_EPI) { if (wr == 0) PG8_BAR; }
    PG8_BAR;
    if constexpr (Epi::AFTER_DRAIN) { E.fused(acc, cur, wr, wc, fr, fq, lds, wid, lane); S.done(cur); }
#undef PG8_SA
#undef PG8_SB
#undef PG8_STAGE
#undef PG8_LDA
#undef PG8_LDB
#undef PG8_MMA
#undef PG8_WAIT_V
#undef PG8_WAIT_L
#undef PG8_BAR
#undef PG8_SCHED
}
}
#include <hip/hip_cooperative_groups.h>
namespace cg = cooperative_groups;
#define LAS __attribute__((address_space(3)))
#define GAS __attribute__((address_space(1)))
typedef unsigned short bf16;
typedef float f32x4 __attribute__((ext_vector_type(4)));
typedef float f32x2 __attribute__((ext_vector_type(2)));
typedef short bf16x8 __attribute__((ext_vector_type(8)));
typedef unsigned u32x4 __attribute__((ext_vector_type(4)));
typedef unsigned u32x2 __attribute__((ext_vector_type(2)));

constexpr int T = 16384, D = 1024, DEPTH = 4, FF = 4096;
constexpr int ZLD = 4608, ZN = 4864, ABIN = 4624, MIXLD = 1536;
constexpr int ZSX = 0, ZSB = 512, ZSC = 1024, ZQ = 1536, ZK = 2048, ZV = 2560, ZG = 3584;
constexpr float EPS = 1e-6f;
constexpr int NWAVES = 8, NTHR = 512;
constexpr int LDS_BYTES = 147456;
constexpr size_t MiB = 1u << 20;
constexpr size_t WS_DEC = 256 * 1024;
constexpr size_t WS_BAR = 0;
constexpr size_t WS_EBL = 512 * 1024;
constexpr size_t WS_CNT = 16 * 1024;
constexpr size_t WS_X1 = 255 * MiB;
constexpr size_t WS_W = 1536 * 1024;
constexpr size_t WS_H = 30 * MiB;
constexpr size_t WS_BIG = 62 * MiB;
constexpr size_t WS_GK = 254 * MiB;
constexpr size_t WS_END = 255 * MiB + 256 * 1024;
constexpr size_t WO_MIX1 = 0;
constexpr size_t WO_MIX2_E = (size_t)ZN * D;
constexpr size_t WO_MIX2_O = (size_t)2048 * D;
constexpr size_t WO_W1 = (size_t)ZN * D + (size_t)D * MIXLD;
constexpr size_t WO_W2 = WO_W1 + (size_t)FF * D;
static_assert(WS_W + (WO_W2 + (size_t)FF * D) * 2 <= WS_H, "weights fit");

__device__ __forceinline__ int tid_l() { int t = threadIdx.x; asm volatile("" : "+v"(t)); return t; }
__device__ __forceinline__ float bf2f(unsigned b) { return __uint_as_float(b << 16); }
__device__ __forceinline__ unsigned pkbf(float lo, float hi) { return pg8::cvt_pk_bf16(lo, hi); }
template <int CTRL> __device__ __forceinline__ float dppf(float v) { return __builtin_bit_cast(float, __builtin_amdgcn_update_dpp(0, __builtin_bit_cast(int, v), CTRL, 0xf, 0xf, true)); }
__device__ __forceinline__ float row16_sum(float v) { v += dppf<0xB1>(v); v += dppf<0x4E>(v); v += dppf<0x141>(v); v += dppf<0x140>(v); return v; }
__device__ __forceinline__ float wave_sum(float v) {
    v = row16_sum(v);
    const int iv = __builtin_bit_cast(int, v);
    return (__builtin_bit_cast(float, __builtin_amdgcn_readlane(iv, 0)) + __builtin_bit_cast(float, __builtin_amdgcn_readlane(iv, 16))) + (__builtin_bit_cast(float, __builtin_amdgcn_readlane(iv, 32)) + __builtin_bit_cast(float, __builtin_amdgcn_readlane(iv, 48)));
}

template <int MODE, bool GAIN>
__device__ __forceinline__ void transpose_item(const float* W, int K, int N, bf16* WT, LAS float* scr, int item, int lane, const float* gain) {
    const int nblk = (N + 31) / 32, kb = item / nblk, nb = item % nblk, k0 = 64 * kb, n0 = 32 * nb;
    const bool ok = (n0 + (lane & 31)) < N;
    float tv[32];
#pragma unroll
    for (int i = 0; i < 32; ++i) { const int kk = 2 * i + (lane >> 5); tv[i] = ok ? W[(size_t)(k0 + kk) * N + n0 + (lane & 31)] : 0.f; }
#pragma unroll
    for (int i = 0; i < 32; ++i) { const int kk = 2 * i + (lane >> 5); scr[kk * 33 + (lane & 31)] = tv[i]; }
    asm volatile("s_waitcnt lgkmcnt(0)" ::: "memory");
    int d0 = n0;
    if (MODE == 1) { const int half = n0 >> 10, c0 = n0 & 1023; d0 = ((c0 >> 7) << 8) + (half << 7) + (c0 & 127); }
    const int c = lane & 7;
    f32x4 ga = (f32x4){1.f, 1.f, 1.f, 1.f}, gb = ga;
    if (GAIN) { ga = *(const f32x4*)(gain + k0 + 8 * c); gb = *(const f32x4*)(gain + k0 + 8 * c + 4); }
#pragma unroll
    for (int j = 0; j < 4; ++j) { const int n = (lane >> 3) + 8 * j; const LAS float* s = scr + (8 * c) * 33 + n;
        u32x4 o; o.x = pkbf(s[0 * 33] * ga.x, s[1 * 33] * ga.y); o.y = pkbf(s[2 * 33] * ga.z, s[3 * 33] * ga.w); o.z = pkbf(s[4 * 33] * gb.x, s[5 * 33] * gb.y); o.w = pkbf(s[6 * 33] * gb.z, s[7 * 33] * gb.w);
        *(u32x4*)(WT + (size_t)(d0 + n) * K + k0 + 8 * c) = o; }
    asm volatile("s_waitcnt lgkmcnt(0)" ::: "memory");
}

struct Args { const float* in[21]; float* out; unsigned char* ws; int ph_lo, ph_hi; };
__device__ __forceinline__ const float* inp(int i) { const __attribute__((address_space(4))) char* kp = (const __attribute__((address_space(4))) char*)__builtin_amdgcn_kernarg_segment_ptr(); asm volatile("" : "+s"(kp)); const float* p = *(const float* const __attribute__((address_space(4)))*)(kp + 8 * i); return (const float*)(const __attribute__((address_space(1))) float*)p; }

template <int PART>
__device__ __forceinline__ void convert_layer(unsigned char* wsp, int l, LAS unsigned char* lds, int gw, int NGW, int wave, int lane) {
    LAS float* scr = (LAS float*)(lds + wave * 8704);
    bf16* Wb_ = (bf16*)(wsp + WS_W);
    const int i2 = l >> 1;
    if (PART == 1) {
        const float* w1 = inp(19) + (size_t)l * D * FF; const float* w2 = inp(20) + (size_t)l * FF * D;
        constexpr int I_W1 = (D / 64) * (FF / 32), I_W2 = (FF / 64) * (D / 32);
        for (int it = gw; it < I_W1 + I_W2; it += NGW) {
            if (it < I_W1) transpose_item<0, true>(w1, D, FF, Wb_ + WO_W1, scr, it, lane, inp(3) + (size_t)l * D);
            else transpose_item<0, false>(w2, FF, D, Wb_ + WO_W2, scr, it - I_W1, lane, nullptr); }
    } else if ((l & 1) == 0) {
        const float* win = inp(5) + (size_t)i2 * D * ABIN; const float* wout = inp(10) + (size_t)i2 * MIXLD * D;
        constexpr int I_IN = (D / 64) * ((ABIN + 31) / 32), I_OUT = (MIXLD / 64) * (D / 32);
        for (int it = gw; it < I_IN + I_OUT; it += NGW) {
            if (it < I_IN) transpose_item<0, true>(win, D, ABIN, Wb_ + WO_MIX1, scr, it, lane, inp(1) + (size_t)l * D);
            else transpose_item<0, false>(wout, MIXLD, D, Wb_ + WO_MIX2_E, scr, it - I_IN, lane, nullptr); }
        u32x4* pz = (u32x4*)(Wb_ + WO_MIX1 + (size_t)4640 * D); const int nz = (ZN - 4640) * D / 8;
        for (int i = gw * 64 + lane; i < nz; i += NGW * 64) pz[i] = (u32x4){0u, 0u, 0u, 0u};
    } else {
        const float* pw1 = inp(11) + (size_t)i2 * D * 2048; const float* pw2 = inp(17) + (size_t)i2 * D * D;
        constexpr int I_P1 = (D / 64) * (2048 / 32), I_P2 = (D / 64) * (D / 32);
        for (int it = gw; it < I_P1 + I_P2; it += NGW) {
            if (it < I_P1) transpose_item<1, true>(pw1, D, 2048, Wb_ + WO_MIX1, scr, it, lane, inp(1) + (size_t)l * D);
            else transpose_item<0, false>(pw2, D, D, Wb_ + WO_MIX2_O, scr, it - I_P1, lane, nullptr); }
    }
}

__device__ __forceinline__ void prologue_rows(const float* xs, bf16* xb, float* ssx, int gw, int NGW, int lane) {
    for (int row = gw; row < T; row += 2 * NGW) {
        const int row2 = row + NGW;
        const f32x4* xa = (const f32x4*)(xs + (size_t)row * D) + lane; const f32x4* xc = (const f32x4*)(xs + (size_t)row2 * D) + lane;
        f32x4 va[4], vb[4];
#pragma unroll
        for (int j = 0; j < 4; ++j) { va[j] = xa[64 * j]; vb[j] = xc[64 * j]; }
        float sa = 0.f, sb = 0.f;
#pragma unroll
        for (int j = 0; j < 4; ++j) { sa += (va[j].x * va[j].x + va[j].y * va[j].y) + (va[j].z * va[j].z + va[j].w * va[j].w); sb += (vb[j].x * vb[j].x + vb[j].y * vb[j].y) + (vb[j].z * vb[j].z + vb[j].w * vb[j].w); }
        sa = wave_sum(sa); sb = wave_sum(sb);
        if (lane < 4) { ssx[(size_t)row * 4 + lane] = lane == 0 ? sa : 0.f; ssx[(size_t)row2 * 4 + lane] = lane == 0 ? sb : 0.f; }
        u32x2* ha = (u32x2*)(xb + (size_t)row * D) + lane; u32x2* hb = (u32x2*)(xb + (size_t)row2 * D) + lane;
#pragma unroll
        for (int j = 0; j < 4; ++j) { u32x2 wa, wb; wa.x = pkbf(va[j].x, va[j].y); wa.y = pkbf(va[j].z, va[j].w); wb.x = pkbf(vb[j].x, vb[j].y); wb.y = pkbf(vb[j].z, vb[j].w); ha[64 * j] = wa; hb[64 * j] = wb; }
    }
}

constexpr int G_QD = 0, G_KD = 17408, G_KLT = 34816, G_VT = 53248, G_P = 90112, G_SEG = 99328, G_EBL = 101376, G_SS = 101888, G_GT = 103936;
#define MFMA16(a, b, c) __builtin_amdgcn_mfma_f32_16x16x32_bf16(a, b, c, 0, 0, 0)
template <bool OUT>
__device__ __forceinline__ void gla_unit(int unit, bf16* z, const float* gklr, const float* wgk2, const float* bgk2, const float* normg, float* E, float* DEC, float* EBLG, bf16* mix, LAS unsigned char* lds) {
    const int tid = tid_l(), lane = tid & 63, w = __builtin_amdgcn_readfirstlane(tid >> 6), r = lane & 15, q = lane >> 4;
    const int g = unit >> 2, h = unit & 3;
    const int seg = w >> 1, k = (w & 1) * 64 + lane, hk = h * 128 + k;
    f32x4 S[8][2];
    GAS float* Eu = (GAS float*)E + (size_t)unit * 32768 + (size_t)w * 4096 + lane;
    if (OUT) {
#pragma unroll
        for (int mt = 0; mt < 8; ++mt)
#pragma unroll
            for (int nt = 0; nt < 2; ++nt)
#pragma unroll
                for (int i = 0; i < 4; ++i) S[mt][nt][i] = Eu[((mt * 2 + nt) * 4 + i) * 64];
    } else {
#pragma unroll
        for (int mt = 0; mt < 8; ++mt)
#pragma unroll
            for (int nt = 0; nt < 2; ++nt) S[mt][nt] = (f32x4){0.f, 0.f, 0.f, 0.f};
    }
    float bsum = 0.f;
    LAS float* SEG = (LAS float*)(lds + G_SEG); LAS float* EBL = (LAS float*)(lds + G_EBL); LAS float* SSQ = (LAS float*)(lds + G_SS);
    for (int ch = 0; ch < 4; ++ch) {
        const int t0 = g * 256 + ch * 64, cgl = g * 4 + ch;
        int tl = tid; asm volatile("" : "+v"(tl));
        if (!OUT) {
            u32x4 qr4[2], kr4[2];
#pragma unroll
            for (int i = 0; i < 2; ++i) { const int c = tl + 512 * i, row = c >> 4, c16 = c & 15; const GAS bf16* zr = (const GAS bf16*)z + (size_t)(t0 + row) * ZLD + h * 128 + c16 * 8;
                qr4[i] = *(const GAS u32x4*)(zr + ZQ); kr4[i] = *(const GAS u32x4*)(zr + ZK); }
            float w2r[16];
#pragma unroll
            for (int i = 0; i < 16; ++i) w2r[i] = ((const GAS float*)wgk2)[i * 512 + hk];
            const float bias = ((const GAS float*)bgk2)[hk];
            if (tid < 256) *(LAS f32x4*)(lds + G_KLT + tid * 16) = *(const GAS f32x4*)((const GAS float*)gklr + (size_t)t0 * 16 + tid * 4);
            asm volatile("" : "+v"(qr4[0]), "+v"(qr4[1]), "+v"(kr4[0]), "+v"(kr4[1]));
#pragma unroll
            for (int i = 0; i < 2; ++i) { const int c = tl + 512 * i, row = c >> 4, c16 = c & 15;
                *(LAS u32x4*)(lds + G_QD + row * 272 + c16 * 16) = qr4[i]; *(LAS u32x4*)(lds + G_KD + row * 272 + c16 * 16) = kr4[i]; }
            __syncthreads();
            float b[16]; float run = 0.f;
#pragma unroll
            for (int jj = 0; jj < 16; ++jj) {
                const LAS f32x4* gp = (const LAS f32x4*)(lds + G_KLT + (seg * 16 + jj) * 64);
                const f32x4 g0 = gp[0], g1 = gp[1], g2 = gp[2], g3 = gp[3];
                float gv = bias;
                gv += g0.x * w2r[0] + g0.y * w2r[1] + g0.z * w2r[2] + g0.w * w2r[3];
                gv += g1.x * w2r[4] + g1.y * w2r[5] + g1.z * w2r[6] + g1.w * w2r[7];
                gv += g2.x * w2r[8] + g2.y * w2r[9] + g2.z * w2r[10] + g2.w * w2r[11];
                gv += g3.x * w2r[12] + g3.y * w2r[13] + g3.z * w2r[14] + g3.w * w2r[15];
                const float ls = -(fmaxf(-gv, 0.f) + __logf(1.f + __expf(-fabsf(gv)))) * (1.f / 16.f);
                run += ls; b[jj] = run;
            }
            SEG[seg * 128 + k] = run;
            __syncthreads();
            float pre = 0.f, tot = 0.f;
#pragma unroll
            for (int s = 0; s < 4; ++s) { const float v = SEG[s * 128 + k]; tot += v; pre += (s < seg) ? v : 0.f; }
            if (seg == 0) { const float eb = __expf(tot); EBL[k] = eb; ((GAS float*)EBLG)[cgl * 512 + hk] = eb; bsum += tot; }
#pragma unroll
            for (int jj = 0; jj < 16; ++jj) {
                const int j = seg * 16 + jj; const float bb = b[jj] + pre;
                LAS bf16* qp = (LAS bf16*)(lds + G_QD + (j * 136 + k) * 2); LAS bf16* kp2 = (LAS bf16*)(lds + G_KD + (j * 136 + k) * 2);
                const float kv = bf2f(*kp2), qv = bf2f(*qp);
                *qp = (bf16)(pkbf(qv * 0.08838834764831845f * __expf(bb), 0.f) & 0xffffu);
                *kp2 = (bf16)(pkbf(kv * __expf(-bb), 0.f) & 0xffffu);
            }
        } else {
            u32x4 gtv[4], qv4[2], kv4[2];
#pragma unroll
            for (int i = 0; i < 4; ++i) { const int c = tl + 512 * i, row = c >> 5, c16 = c & 31; gtv[i] = *(const GAS u32x4*)((const GAS bf16*)z + (size_t)(t0 + row) * ZLD + ZG + h * 256 + c16 * 8); }
#pragma unroll
            for (int i = 0; i < 2; ++i) { const int c = tl + 512 * i, row = c >> 4, c16 = c & 15; const GAS bf16* zr = (const GAS bf16*)z + (size_t)(t0 + row) * ZLD + h * 128 + c16 * 8;
                qv4[i] = *(const GAS u32x4*)(zr + ZQ); kv4[i] = *(const GAS u32x4*)(zr + ZK); }
            const float eb = ((const GAS float*)EBLG)[cgl * 512 + hk];
            asm volatile("" : "+v"(gtv[0]), "+v"(gtv[1]), "+v"(gtv[2]), "+v"(gtv[3]), "+v"(qv4[0]), "+v"(qv4[1]), "+v"(kv4[0]), "+v"(kv4[1]));
#pragma unroll
            for (int i = 0; i < 4; ++i) { const int c = tl + 512 * i, row = c >> 5, c16 = c & 31; *(LAS u32x4*)(lds + G_GT + row * 528 + c16 * 16) = gtv[i]; }
#pragma unroll
            for (int i = 0; i < 2; ++i) { const int c = tl + 512 * i, row = c >> 4, c16 = c & 15;
                *(LAS u32x4*)(lds + G_QD + row * 272 + c16 * 16) = qv4[i]; *(LAS u32x4*)(lds + G_KD + row * 272 + c16 * 16) = kv4[i]; }
            if (seg == 0) EBL[k] = eb;
        }
        u32x4 vv4[4];
#pragma unroll
        for (int i = 0; i < 4; ++i) { const int c = tl + 512 * i, row = c >> 5, c16 = c & 31; vv4[i] = *(const GAS u32x4*)((const GAS bf16*)z + (size_t)(t0 + row) * ZLD + ZV + h * 256 + c16 * 8); }
        asm volatile("" : "+v"(vv4[0]), "+v"(vv4[1]), "+v"(vv4[2]), "+v"(vv4[3]));
#pragma unroll
        for (int i = 0; i < 4; ++i) { const int c = tl + 512 * i, row = c >> 5, c16 = c & 31; *(LAS u32x4*)(lds + G_VT + row * 544 + c16 * 16) = vv4[i]; }
        __syncthreads();
        if (!OUT) {
#pragma unroll
            for (int i = 0; i < 2; ++i) { const int c = tl + 512 * i, row = c >> 4, c16 = c & 15; GAS bf16* zr = (GAS bf16*)z + (size_t)(t0 + row) * ZLD + h * 128 + c16 * 8;
                *(GAS u32x4*)(zr + ZQ) = *(const LAS u32x4*)(lds + G_QD + row * 272 + c16 * 16); *(GAS u32x4*)(zr + ZK) = *(const LAS u32x4*)(lds + G_KD + row * 272 + c16 * 16); }
        }
        if (OUT) {
            const int jt = w >> 1;
#pragma unroll
            for (int ii = 0; ii < 2; ++ii) {
                const int it = (w & 1) * 2 + ii;
                f32x4 pa = (f32x4){0.f, 0.f, 0.f, 0.f};
                if (jt <= it) {
#pragma unroll
                    for (int s = 0; s < 4; ++s) {
                        const bf16x8 A = *(const LAS bf16x8*)(lds + G_KD + ((16 * jt + r) * 136 + 32 * s + 8 * q) * 2);
                        const bf16x8 B = *(const LAS bf16x8*)(lds + G_QD + ((16 * it + r) * 136 + 32 * s + 8 * q) * 2);
                        pa = MFMA16(A, B, pa);
                    }
                    const int i_ = 16 * it + r;
#pragma unroll
                    for (int e = 0; e < 4; ++e) { const int j_ = 16 * jt + 4 * q + e; if (j_ > i_) pa[e] = 0.f; }
                }
                u32x2 pw; pw.x = pkbf(pa[0], pa[1]); pw.y = pkbf(pa[2], pa[3]);
                *(LAS u32x2*)(lds + G_P + ((16 * it + r) * 72 + 16 * jt + 4 * q) * 2) = pw;
            }
            __syncthreads();
        }
        bf16x8 Bv[2][2];
#pragma unroll
        for (int s2 = 0; s2 < 2; ++s2)
#pragma unroll
            for (int nt = 0; nt < 2; ++nt) {
                typedef short s16x4 __attribute__((ext_vector_type(4)));
                LAS unsigned char* ta = lds + G_VT + (32 * s2 + 8 * q + ((lane & 15) >> 2)) * 544 + (32 * w + 16 * nt + 4 * (lane & 3)) * 2;
                const s16x4 lo = __builtin_amdgcn_ds_read_tr16_b64_v4i16((LAS s16x4*)ta), hi = __builtin_amdgcn_ds_read_tr16_b64_v4i16((LAS s16x4*)(ta + 4 * 544));
                Bv[s2][nt] = (bf16x8){lo[0], lo[1], lo[2], lo[3], hi[0], hi[1], hi[2], hi[3]};
            }
        f32x4 o[4][2];
        if (OUT) {
#pragma unroll
            for (int mt = 0; mt < 4; ++mt)
#pragma unroll
                for (int nt = 0; nt < 2; ++nt) o[mt][nt] = (f32x4){0.f, 0.f, 0.f, 0.f};
#pragma unroll
            for (int s = 0; s < 4; ++s) {
                bf16x8 Sb[2];
#pragma unroll
                for (int nt = 0; nt < 2; ++nt) {
                    u32x4 t; t.x = pkbf(S[2 * s][nt][0], S[2 * s][nt][1]); t.y = pkbf(S[2 * s][nt][2], S[2 * s][nt][3]);
                    t.z = pkbf(S[2 * s + 1][nt][0], S[2 * s + 1][nt][1]); t.w = pkbf(S[2 * s + 1][nt][2], S[2 * s + 1][nt][3]);
                    Sb[nt] = __builtin_bit_cast(bf16x8, t);
                }
                u32x2 alo[4], ahi[4];
#pragma unroll
                for (int mt = 0; mt < 4; ++mt) {
                    alo[mt] = *(const LAS u32x2*)(lds + G_QD + ((16 * mt + r) * 136 + 32 * s + 4 * q) * 2);
                    ahi[mt] = *(const LAS u32x2*)(lds + G_QD + ((16 * mt + r) * 136 + 32 * s + 16 + 4 * q) * 2); }
#pragma unroll
                for (int mt = 0; mt < 4; ++mt) {
                    const bf16x8 A = __builtin_bit_cast(bf16x8, (u32x4){alo[mt].x, alo[mt].y, ahi[mt].x, ahi[mt].y});
#pragma unroll
                    for (int nt = 0; nt < 2; ++nt) o[mt][nt] = MFMA16(A, Sb[nt], o[mt][nt]);
                }
            }
#pragma unroll
            for (int s2 = 0; s2 < 2; ++s2) {
                bf16x8 Ap[4];
#pragma unroll
                for (int mt = 0; mt < 4; ++mt) Ap[mt] = *(const LAS bf16x8*)(lds + G_P + ((16 * mt + r) * 72 + 32 * s2 + 8 * q) * 2);
#pragma unroll
                for (int mt = 0; mt < 4; ++mt)
#pragma unroll
                    for (int nt = 0; nt < 2; ++nt) o[mt][nt] = MFMA16(Ap[mt], Bv[s2][nt], o[mt][nt]);
            }
        }
#pragma unroll
        for (int mt = 0; mt < 8; ++mt) {
            bf16x8 Ak[2]; const f32x4 ebv = *(const LAS f32x4*)(lds + G_EBL + (16 * mt + 4 * q) * 4);
#pragma unroll
            for (int s2 = 0; s2 < 2; ++s2) { typedef short s16x4 __attribute__((ext_vector_type(4)));
                LAS unsigned char* ta = lds + G_KD + (32 * s2 + 8 * q + ((lane & 15) >> 2)) * 272 + (16 * mt + 4 * (lane & 3)) * 2;
                const s16x4 lo = __builtin_amdgcn_ds_read_tr16_b64_v4i16((LAS s16x4*)ta), hi = __builtin_amdgcn_ds_read_tr16_b64_v4i16((LAS s16x4*)(ta + 4 * 272));
                Ak[s2] = (bf16x8){lo[0], lo[1], lo[2], lo[3], hi[0], hi[1], hi[2], hi[3]}; }
#pragma unroll
            for (int s2 = 0; s2 < 2; ++s2)
#pragma unroll
                for (int nt = 0; nt < 2; ++nt) S[mt][nt] = MFMA16(Ak[s2], Bv[s2][nt], S[mt][nt]);
#pragma unroll
            for (int nt = 0; nt < 2; ++nt) S[mt][nt] = S[mt][nt] * ebv;
        }
        if (OUT) {
#pragma unroll
            for (int mt = 0; mt < 4; ++mt)
#pragma unroll
                for (int e = 0; e < 4; ++e) {
                    float s = o[mt][0][e] * o[mt][0][e] + o[mt][1][e] * o[mt][1][e];
                    s = row16_sum(s);
                    if (r == 0) SSQ[(16 * mt + 4 * q + e) * 8 + w] = s;
                }
            __syncthreads();
            const float ng0 = ((const GAS float*)normg)[32 * w + r], ng1 = ((const GAS float*)normg)[32 * w + 16 + r];
#pragma unroll
            for (int mt = 0; mt < 4; ++mt)
#pragma unroll
                for (int e = 0; e < 4; ++e) {
                    const int i_ = 16 * mt + 4 * q + e;
                    const f32x4 sa = *(const LAS f32x4*)(lds + G_SS + i_ * 32), sb = *(const LAS f32x4*)(lds + G_SS + i_ * 32 + 16);
                    const float tot2 = ((sa.x + sa.y) + (sa.z + sa.w)) + ((sb.x + sb.y) + (sb.z + sb.w));
                    const float rs = __builtin_amdgcn_rsqf(tot2 * (1.f / 256.f) + EPS);
                    LAS bf16* gp = (LAS bf16*)(lds + G_GT + i_ * 528 + (32 * w + r) * 2);
                    const float ga = bf2f(gp[0]), gb = bf2f(gp[16]);
                    const float va = o[mt][0][e] * rs * ng0 * ga * __builtin_amdgcn_rcpf(1.f + __expf(-ga));
                    const float vb = o[mt][1][e] * rs * ng1 * gb * __builtin_amdgcn_rcpf(1.f + __expf(-gb));
                    const unsigned pv = pkbf(va, vb);
                    gp[0] = (bf16)(pv & 0xffffu); gp[16] = (bf16)(pv >> 16);
                }
            __syncthreads();
#pragma unroll
            for (int i = 0; i < 4; ++i) { const int c = tl + 512 * i, row = c >> 5, c16 = c & 31;
                *(GAS u32x4*)((GAS bf16*)mix + (size_t)(t0 + row) * MIXLD + 512 + h * 256 + c16 * 8) = *(const LAS u32x4*)(lds + G_GT + row * 528 + c16 * 16); }
        }
        __syncthreads();
    }
    if (!OUT) {
#pragma unroll
        for (int mt = 0; mt < 8; ++mt)
#pragma unroll
            for (int nt = 0; nt < 2; ++nt)
#pragma unroll
                for (int i = 0; i < 4; ++i) Eu[((mt * 2 + nt) * 4 + i) * 64] = S[mt][nt][i];
        if (seg == 0) DEC[unit * 128 + k] = __expf(bsum);
    }
}

__device__ __forceinline__ void shortconv(const bf16* z, const float* wsc, bf16* mix, int gtid, int gthreads) {
    for (int idx = gtid; idx < (T / 8) * 256; idx += gthreads) {
        const int tb = (idx >> 8) * 8, c = (idx & 255) * 2;
        unsigned x2[10], c2[10], b2[8];
#pragma unroll
        for (int r = 0; r < 10; ++r) { const int tt = tb - 2 + r, tc = tt < 0 ? 0 : tt; const bf16* zr = z + (size_t)tc * ZLD + c; x2[r] = *(const unsigned*)(zr + ZSX); c2[r] = *(const unsigned*)(zr + ZSC); }
#pragma unroll
        for (int o = 0; o < 8; ++o) b2[o] = *(const unsigned*)(z + (size_t)(tb + o) * ZLD + ZSB + c);
        f32x2 wj[3];
#pragma unroll
        for (int j = 0; j < 3; ++j) wj[j] = *(const f32x2*)(wsc + j * 512 + c);
        float m0[10], m1[10];
#pragma unroll
        for (int r = 0; r < 10; ++r) { const bool ok = (tb - 2 + r) >= 0; m0[r] = ok ? bf2f(x2[r] & 0xffffu) * bf2f(c2[r] & 0xffffu) : 0.f; m1[r] = ok ? bf2f(x2[r] >> 16) * bf2f(c2[r] >> 16) : 0.f; }
#pragma unroll
        for (int o = 0; o < 8; ++o) {
            const float a0 = wj[0].x * m0[o] + wj[1].x * m0[o + 1] + wj[2].x * m0[o + 2], a1 = wj[0].y * m1[o] + wj[1].y * m1[o + 1] + wj[2].y * m1[o + 2];
            *(unsigned*)(mix + (size_t)(tb + o) * MIXLD + c) = pkbf(bf2f(b2[o] & 0xffffu) * a0, bf2f(b2[o] >> 16) * a1);
        }
    }
}

__device__ __forceinline__ void gla_scan(float* E, const float* DEC, int gtid, int gthreads) {
    for (int e = gtid; e < 4 * 32768; e += gthreads) {
        const int h = e >> 15, rem = e & 32767, rr = (rem >> 6) & 63, ln = rem & 63;
        const int k = 16 * (rr >> 3) + 4 * (ln >> 4) + (rr & 3);
        float* p = E + (size_t)h * 32768 + rem; const float* dp = DEC + h * 128 + k;
        float s = 0.f;
#pragma unroll 1
        for (int gb = 0; gb < 64; gb += 16) {
            float tv[16], dv[16];
#pragma unroll
            for (int i = 0; i < 16; ++i) { tv[i] = p[(size_t)(gb + i) * 4 * 32768]; dv[i] = dp[(gb + i) * 512]; }
#pragma unroll
            for (int i = 0; i < 16; ++i) { p[(size_t)(gb + i) * 4 * 32768] = s; s = dv[i] * s + tv[i]; }
        }
    }
}

__device__ __forceinline__ void conv_phase(const bf16* u, const float* wdw, const float* bdw, const float* lng, const float* lnb, bf16* dout, LAS unsigned char* lds, int G, int bid) {
    const int tid = tid_l(), lane = tid & 63, w = tid >> 6;
    LAS unsigned* UL = (LAS unsigned*)lds;
    LAS f32x2* RED = (LAS f32x2*)(lds + 126976);
    LAS f32x2* STAT = (LAS f32x2*)(lds + 126976 + 2048);
    f32x2 wv[31];
#pragma unroll
    for (int j = 0; j < 31; ++j) wv[j] = *(const f32x2*)(wdw + j * 1024 + 2 * tid);
    const f32x2 bd = *(const f32x2*)(bdw + 2 * tid), lg = *(const f32x2*)(lng + 2 * tid), lb = *(const f32x2*)(lnb + 2 * tid);
    for (int tile = bid; tile < T / 32; tile += G) {
        const int t0 = tile * 32;
#pragma unroll 1
        for (int hb = 0; hb < 2; ++hb) {
            u32x4 sv[8];
#pragma unroll
            for (int it = 0; it < 8; ++it) { const int i = tid + (hb * 8 + it) * NTHR; int rr = i >> 7; rr = rr > 61 ? 61 : rr; const int cc = i & 127, t = t0 - 30 + rr, tc = t < 0 ? 0 : t;
                sv[it] = *(const u32x4*)(u + (size_t)tc * D + cc * 8); if (t < 0) sv[it] = (u32x4){0u, 0u, 0u, 0u}; }
#pragma unroll
            for (int it = 0; it < 8; ++it) { const int i = tid + (hb * 8 + it) * NTHR, rr = i >> 7, cc = i & 127; if (i < 62 * 128) *(LAS u32x4*)(lds + rr * 2048 + cc * 16) = sv[it]; }
        }
        __syncthreads();
#pragma unroll 1
        for (int sub = 0; sub < 2; ++sub) {
            f32x2 dv[16];
#pragma unroll
            for (int tt = 0; tt < 16; ++tt) dv[tt] = bd;
            const LAS unsigned* ULs = UL + sub * 16 * 512 + tid;
#pragma unroll
            for (int rb = 0; rb < 48; rb += 8) {
                unsigned ub[8];
#pragma unroll
                for (int i = 0; i < 8; ++i) ub[i] = (rb + i < 46) ? ULs[(rb + i) * 512] : 0u;
                asm volatile("" : "+v"(ub[0]), "+v"(ub[1]), "+v"(ub[2]), "+v"(ub[3]), "+v"(ub[4]), "+v"(ub[5]), "+v"(ub[6]), "+v"(ub[7]));
#pragma unroll
                for (int i = 0; i < 8; ++i) { const int rr = rb + i; if (rr < 46) { const f32x2 u2 = (f32x2){bf2f(ub[i] & 0xffffu), bf2f(ub[i] >> 16)};
#pragma unroll
                    for (int tt = 0; tt < 16; ++tt) { if (rr - tt >= 0 && rr - tt <= 30) dv[tt] = __builtin_elementwise_fma(wv[rr - tt], u2, dv[tt]); } } }
            }
#pragma unroll
            for (int tt = 0; tt < 16; ++tt) {
                float s1 = dv[tt].x + dv[tt].y, s2 = dv[tt].x * dv[tt].x + dv[tt].y * dv[tt].y;
                s1 = wave_sum(s1); s2 = wave_sum(s2);
                if (lane == 0) RED[tt * 8 + w] = (f32x2){s1, s2};
            }
            __syncthreads();
            if (tid < 16) { float s1 = 0.f, s2 = 0.f;
#pragma unroll
                for (int i = 0; i < 8; ++i) { const f32x2 t = RED[tid * 8 + i]; s1 += t.x; s2 += t.y; }
                const float mean = s1 * (1.f / D); const float var = fmaxf(s2 * (1.f / D) - mean * mean, 0.f);
                STAT[tid] = (f32x2){mean, __builtin_amdgcn_rsqf(var + EPS)}; }
            __syncthreads();
#pragma unroll
            for (int tt = 0; tt < 16; ++tt) {
                const f32x2 st = STAT[tt];
                const float a = (dv[tt].x - st.x) * st.y * lg.x + lb.x, b = (dv[tt].y - st.x) * st.y * lg.y + lb.y;
                const float sa = a * __builtin_amdgcn_rcpf(1.f + __expf(-a)), sb = b * __builtin_amdgcn_rcpf(1.f + __expf(-b));
                *(unsigned*)(dout + (size_t)(t0 + sub * 16 + tt) * D + 2 * tid) = pkbf(sa, sb);
            }
        }
        __syncthreads();
    }
}

#define XB_TMO      128
#define XB_XCNT(j)  (256  + 64 * (j))
#define XB_XSUB(j)  (1280 + 64 * (j))
#define XB_XGEN(j)  (2304 + 64 * (j))
#define XB_TOP      3328
#define XB_TOPGEN   3392
#define XCD_BAR_WORDS 3456
#define XB_SPIN_CAP (1u << 18)

__device__ __forceinline__ unsigned xb_ld(unsigned* p)              { return __hip_atomic_load(p, __ATOMIC_RELAXED, __HIP_MEMORY_SCOPE_AGENT); }
__device__ __forceinline__ unsigned xb_add(unsigned* p, unsigned v) { return __hip_atomic_fetch_add(p, v, __ATOMIC_RELAXED, __HIP_MEMORY_SCOPE_AGENT); }
__device__ __forceinline__ unsigned xb_xcc_id() { return (unsigned)__builtin_amdgcn_s_getreg((3 << 11) | 20) & 0xFu; }
#define XB_SPIN(cond, bar) do { unsigned _sp = 0; while (cond) { __builtin_amdgcn_s_sleep(1); \
    if ((++_sp & 255u) == 0u) { if (xb_ld(&(bar)[XB_TMO])) break; if (_sp > XB_SPIN_CAP) { atomicAdd(&(bar)[XB_TMO], 1u); break; } } } } while (0)

struct XcdBarrier {
    unsigned* bar; unsigned x;
    volatile LAS unsigned* st;
};

__device__ __forceinline__ XcdBarrier xcd_barrier_post(unsigned* bar, volatile LAS unsigned* st) {
    XcdBarrier b; b.bar = bar; b.x = xb_xcc_id(); b.st = st;
    if (threadIdx.x == 0) (void)xb_add(&bar[XB_XCNT(b.x)], 1u);
    return b;
}
__device__ __forceinline__ void xcd_barrier_complete(unsigned* bar, unsigned x, unsigned& nloc, unsigned& nx) {
    const unsigned G = gridDim.x * gridDim.y * gridDim.z;
    unsigned sum, cnt, mine, sp = 0u;
    for (;;) {
        sum = 0u; cnt = 0u; mine = 0u;
#pragma unroll
        for (unsigned j = 0; j < 16; ++j) { const unsigned c = xb_ld(&bar[XB_XCNT(j)]); sum += c; cnt += (c > 0u) ? 1u : 0u; mine = (j == x) ? c : mine; }
        if (sum == G) break;
        __builtin_amdgcn_s_sleep(1);
        if ((++sp & 255u) == 0u) { if (xb_ld(&bar[XB_TMO])) break; if (sp > XB_SPIN_CAP) { atomicAdd(&bar[XB_TMO], 1u); break; } }
    }
    nloc = mine > 0u ? mine : 1u; nx = cnt > 0u ? cnt : 1u;
}

__device__ __forceinline__ void xcd_barrier(const XcdBarrier& b) {
    asm volatile("s_waitcnt vmcnt(0)" ::: "memory");
    __syncthreads();
    if (threadIdx.x == 0) {
        unsigned* bar = b.bar; asm volatile("" : "+s"(bar));
        unsigned bx = (unsigned)__builtin_amdgcn_readfirstlane((int)b.x); asm volatile("" : "+s"(bx));
        __builtin_amdgcn_s_waitcnt(0);
        unsigned nloc = b.st[0], nx = b.st[1];
        if (nloc == 0u) { xcd_barrier_complete(bar, bx, nloc, nx); b.st[0] = nloc; b.st[1] = nx; }
        const unsigned old = xb_add(&bar[XB_XSUB(bx)], 1u);
        const unsigned gen = old / nloc;
        if (old + 1u == (gen + 1u) * nloc) {
            __builtin_amdgcn_fence(__ATOMIC_RELEASE, "agent");
            asm volatile("s_waitcnt vmcnt(0)" ::: "memory");
            const unsigned og = xb_add(&bar[XB_TOP], 1u);
            const unsigned tg = og / nx;
            if (og + 1u == (tg + 1u) * nx) xb_add(&bar[XB_TOPGEN], 1u);
            else XB_SPIN(xb_ld(&bar[XB_TOPGEN]) == tg, bar);
            __builtin_amdgcn_fence(__ATOMIC_ACQUIRE, "agent");
            xb_add(&bar[XB_XGEN(bx)], 1u);
            asm volatile("s_waitcnt vmcnt(0)" ::: "memory");
        } else {
            XB_SPIN(xb_ld(&bar[XB_XGEN(bx)]) == gen, bar);
            __builtin_amdgcn_fence(__ATOMIC_ACQUIRE, "agent");
            asm volatile("s_waitcnt vmcnt(0)" ::: "memory");
        }
    }
    __syncthreads();
}

__global__ void __launch_bounds__(NTHR, 2) trunk_fwd(Args a) {
    extern __shared__ __attribute__((aligned(16))) unsigned char lds_raw[];
    LAS unsigned char* lds = (LAS unsigned char*)lds_raw;
    cg::grid_group grid = cg::this_grid();
    { volatile LAS unsigned* st0 = (volatile LAS unsigned*)(lds + LDS_BYTES - 16); if (threadIdx.x < 4) st0[threadIdx.x] = 0u; }
    __syncthreads();
    const XcdBarrier xbar = xcd_barrier_post((unsigned*)(a.ws + WS_BAR), (volatile LAS unsigned*)(lds + LDS_BYTES - 16));
    const int G0 = gridDim.x;
    if (a.ph_lo == 0x7fffffff) grid.sync();
#define IDS int bid = blockIdx.x; asm volatile("" : "+s"(bid)); const int tid = tid_l(), lane = tid & 63, wave = __builtin_amdgcn_readfirstlane(tid >> 6), gw = bid * NWAVES + wave, gtid = bid * NTHR + tid; (void)lane; (void)gw; (void)gtid;
    unsigned char* ws = a.ws; float* const xout = a.out;
#define Wb ((bf16*)(wsl + WS_W))
#define Eb ((float*)(wsl + WS_H))
#define DEC ((float*)(wsl + WS_DEC))
#define GK ((float*)(wsl + WS_GK))
#define EBLG ((float*)(wsl + WS_EBL))
#define big (wsl + WS_BIG)
#define Z ((bf16*)big)
#define MIX ((bf16*)(big + 144 * MiB))
#define U ((bf16*)big)
#define Dd ((bf16*)(big + 32 * MiB))
#define Ab ((bf16*)big)
#define ymlp ((float*)(big + 128 * MiB))
#define XB ((bf16*)xout)
#define XB2 ((bf16*)(big + 128 * MiB))
#define ymix ((float*)(big + ((l & 1) ? 64 * MiB : 0)))
#ifndef WGM_G1
#define WGM_G1 4
#endif
#ifndef WGM_G5
#define WGM_G5 4
#endif
#ifndef WGM_G3
#define WGM_G3 4
#endif
#ifndef PH_LO
#define PH_LO 0
#endif
#ifndef PH_HI
#define PH_HI 25
#endif
    constexpr int lo = PH_LO, hi = PH_HI;
#ifndef PROBE_MASK
#define PROBE_MASK 0u
#endif
#ifndef PROBE_MUL
#define PROBE_MUL 1
#endif
    unsigned long long pr_prev = PROBE_MASK ? __builtin_amdgcn_s_memrealtime() : 0ull, pr_acc = 0ull;
#define PR_STAMP() do { if (PROBE_MASK) { const unsigned long long t_ = __builtin_amdgcn_s_memrealtime(); if ((PROBE_MASK >> ph) & 1u) pr_acc += t_ - pr_prev; pr_prev = t_; } } while (0)
    int ph = 0;
#define PH_BEGIN if (ph >= lo && ph < hi) { IDS size_t wzo = 0; asm volatile("" : "+s"(wzo)); unsigned char* wsl = ws + wzo; int G = G0; asm volatile("" : "+s"(G)); const int NGW = G * NWAVES, gthreads = G * NTHR; (void)NGW; (void)gthreads;
#define PH_END   if (ph + 1 < hi) xcd_barrier(xbar); } PR_STAMP(); ++ph;

#define STATS(bank) pg8::RmsStats{(float*)(wsl + WS_X1), (unsigned*)(wsl + WS_CNT) + (size_t)(bank) * 4096}
#define SSX(i) ((float*)(wsl + WS_H))
#define RSTD_TAB_OFF 131072
#define FILL_RSTD_TAB(ssx_) do { LAS float* tab_ = (LAS float*)(lds + RSTD_TAB_OFF); const int rb_ = (bid & 7) * 2048; \
        for (int i_ = tid; i_ < 2048; i_ += NTHR) tab_[i_] = pg8::row_rstd((ssx_), rb_ + i_); __syncthreads(); } while (0)
    PH_BEGIN
        convert_layer<0>(wsl, 0, lds, gw, NGW, wave, lane);
        prologue_rows(inp(0), XB, SSX(0), gw, NGW, lane);
    PH_END

    for (int l = 0; l < DEPTH; ++l) {
        const int i2 = l >> 1;
        const bool first = (l == 0);
        if ((l & 1) == 0) {
            PH_BEGIN
                if (bid >= 192) { convert_layer<1>(wsl, l, lds, (bid - 192) * NWAVES + wave, 64 * NWAVES, wave, lane); __syncthreads(); }
                pg8::Gemm g{XB, Wb + WO_MIX1, T, ZN, D}; pg8::StaticOrder S; S.init(T, ZN, G, bid, WGM_G1);
                FILL_RSTD_TAB(SSX(2 * l));
                pg8::EpiZ E{Z, GK, (const LAS float*)(lds + RSTD_TAB_OFF)};
                pg8::gemm_phase<pg8::EpiZ, pg8::StaticOrder, true, true>(lds, g, S, E);
            PH_END
            PH_BEGIN
                for (int un = bid; un < 256; un += G)
                    gla_unit<false>(un, Z, GK, inp(6) + (size_t)i2 * 16 * 512, inp(7) + (size_t)i2 * 512, inp(9) + (size_t)i2 * 256, Eb, DEC, EBLG, MIX, lds);
                shortconv(Z, inp(8) + (size_t)i2 * 3 * 512, MIX, gtid, gthreads);
            PH_END
            PH_BEGIN
                gla_scan(Eb, DEC, gtid, gthreads);
            PH_END
            PH_BEGIN
                for (int un = bid; un < 256; un += G)
                    gla_unit<true>(un, Z, GK, inp(6) + (size_t)i2 * 16 * 512, inp(7) + (size_t)i2 * 512, inp(9) + (size_t)i2 * 256, Eb, DEC, EBLG, MIX, lds);
            PH_END
            PH_BEGIN
                pg8::Gemm g{MIX, Wb + WO_MIX2_E, T, D, MIXLD}; pg8::StaticOrder S; S.init(T, D, G, bid);
                if (first) { pg8::EpiNorm<false, true, false, true> E{inp(0), XB, SSX(2 * l + 1), nullptr, inp(2) + (size_t)l * D, STATS(2 * l)};
                    pg8::gemm_phase<pg8::EpiNorm<false, true, false, true>, pg8::StaticOrder, false, true>(lds, g, S, E); }
                else { pg8::EpiNorm<false, true, true, true> E{XB, XB, SSX(2 * l + 1), nullptr, inp(2) + (size_t)l * D, STATS(2 * l)};
                    pg8::gemm_phase<pg8::EpiNorm<false, true, true, true>, pg8::StaticOrder, false, true>(lds, g, S, E); }
            PH_END
        } else {
            PH_BEGIN
                pg8::Gemm g{XB, Wb + WO_MIX1, T, 2048, D}; pg8::StaticOrder S; S.init(T, 2048, G, bid, WGM_G5);
                FILL_RSTD_TAB(SSX(2 * l));
                pg8::EpiGLU E{U, inp(12) + (size_t)i2 * 2048, (const LAS float*)(lds + RSTD_TAB_OFF)};
                pg8::gemm_phase<pg8::EpiGLU, pg8::StaticOrder, true, true>(lds, g, S, E);
            PH_END
            PH_BEGIN
                convert_layer<1>(wsl, l, lds, gw, NGW, wave, lane);
                __syncthreads();
                conv_phase(U, inp(13) + (size_t)i2 * 31 * D, inp(14) + (size_t)i2 * D, inp(15) + (size_t)i2 * D, inp(16) + (size_t)i2 * D, Dd, lds, G, bid);
            PH_END
            PH_BEGIN
                pg8::Gemm g{Dd, Wb + WO_MIX2_O, T, D, D}; pg8::StaticOrder S; S.init(T, D, G, bid);
                pg8::EpiNorm<true, true, true, true> E{XB, (l + 1 < DEPTH) ? (void*)XB : (void*)XB2, SSX(2 * l + 1), inp(18) + (size_t)i2 * D, inp(2) + (size_t)l * D, STATS(2 * l)};
                pg8::gemm_phase<pg8::EpiNorm<true, true, true, true>, pg8::StaticOrder, false, true>(lds, g, S, E);
            PH_END
        }
        PH_BEGIN
            if (l + 1 < DEPTH) { convert_layer<0>(wsl, l + 1, lds, gw, NGW, wave, lane); __syncthreads(); }
            pg8::Gemm g{(l + 1 < DEPTH) ? XB : XB2, Wb + WO_W1, T, FF, D}; pg8::StaticOrder S; S.init(T, FF, G, bid, WGM_G3);
            FILL_RSTD_TAB(SSX(2 * l + 1));
            pg8::EpiRelu2 E{Ab, FF, (const LAS float*)(lds + RSTD_TAB_OFF)};
            pg8::gemm_phase<pg8::EpiRelu2, pg8::StaticOrder, true, true>(lds, g, S, E);
        PH_END
        PH_BEGIN
            pg8::Gemm g{Ab, Wb + WO_W2, T, D, FF}; pg8::StaticOrder S; S.init(T, D, G, bid);
            if (l + 1 < DEPTH) { pg8::EpiNorm<false, true, true, true> E{XB, XB, SSX(2 * l + 2), nullptr, inp(4) + (size_t)l * D, STATS(2 * l + 1)};
                pg8::gemm_phase<pg8::EpiNorm<false, true, true, true>, pg8::StaticOrder, false, true>(lds, g, S, E); }
            else { pg8::EpiNorm<false, false, true, false> E{XB2, xout, nullptr, nullptr, inp(4) + (size_t)l * D, STATS(2 * l + 1)};
                pg8::gemm_phase<pg8::EpiNorm<false, false, true, false>, pg8::StaticOrder, false, true>(lds, g, S, E); }
        PH_END
    }
    if (PROBE_MASK) { if (blockIdx.x == 0) { const unsigned long long t_end = __builtin_amdgcn_s_memrealtime(); while (__builtin_amdgcn_s_memrealtime() - t_end < pr_acc * PROBE_MUL) __builtin_amdgcn_s_sleep(8); } }
}

extern "C" void kernel_launch(void* const* d_in, const int* in_sizes, int n_in, void* d_out, int out_size, void* d_ws, size_t ws_size, hipStream_t stream) {
    static int grid = 0;
    if (grid == 0) {
        if (n_in != 21 || out_size != T * D || ws_size < WS_END) { fprintf(stderr, "kernel_launch: unexpected shapes (n_in %d out %d ws %zu)\n", n_in, out_size, ws_size); grid = -1; return; }
        int dev = 0, cus = 0, per_cu = 0;
        hipGetDevice(&dev); hipDeviceGetAttribute(&cus, hipDeviceAttributeMultiprocessorCount, dev);
        if (hipFuncSetAttribute((const void*)trunk_fwd, hipFuncAttributeMaxDynamicSharedMemorySize, LDS_BYTES) != hipSuccess) { fprintf(stderr, "kernel_launch: hipFuncSetAttribute failed\n"); grid = -1; return; }
        if (hipOccupancyMaxActiveBlocksPerMultiprocessor(&per_cu, (const void*)trunk_fwd, NTHR, LDS_BYTES) != hipSuccess || per_cu < 1) { fprintf(stderr, "kernel_launch: occupancy query failed (%d)\n", per_cu); (void)hipGetLastError(); per_cu = 1; }
        grid = cus * per_cu; if (grid > 256) grid = 256;
        if (grid != 256) { fprintf(stderr, "kernel_launch: this kernel needs exactly 256 co-resident workgroups (got %d)\n", grid); grid = -1; return; }
    }
    if (grid < 0) return;
    Args a{};
    for (int i = 0; i < 21; ++i) a.in[i] = (const float*)d_in[i];
    a.out = (float*)d_out; a.ws = (unsigned char*)d_ws; a.ph_lo = 0; a.ph_hi = 25;
    if (hipMemsetAsync(d_ws, 0, 144u * 1024u, stream) != hipSuccess) { fprintf(stderr, "kernel_launch: memset failed\n"); return; }
    void* args[] = {&a};
    hipError_t e = hipLaunchCooperativeKernel((const void*)trunk_fwd, dim3(grid), dim3(NTHR), args, LDS_BYTES, stream);
    if (e != hipSuccess) fprintf(stderr, "cooperative launch failed: %s (grid %d)\n", hipGetErrorString(e), grid);
}
```

```cpp
#include <hip/hip_runtime.h>
#include <cstdio>
#include <cstdint>
namespace pg8 {
#define PG8_LAS __attribute__((address_space(3)))
typedef unsigned short bf16_t;
typedef short bf16x8 __attribute__((ext_vector_type(8)));
typedef float f32x4 __attribute__((ext_vector_type(4)));
typedef unsigned u32x4 __attribute__((ext_vector_type(4)));
constexpr int BM = 256, BK = 64, HALF = 128, HTB = HALF * BK * 2  , STAGE_BYTES = 8 * HTB, NXCD = 8, WGM = 4;

__host__ __device__ __forceinline__ int lds_byte(int r, int c) { const int st = (r >> 4) * 2 + (c >> 5), rr = r & 15, cc = c & 31, ob = rr * 64 + cc * 2; return st * 1024 + (ob ^ (((ob >> 9) & 1) << 5)); }
__host__ __device__ __forceinline__ void stage_rc(int b, int& R, int& C) { const int st = b / 1024, sb = b % 1024, swz = sb ^ (((sb >> 9) & 1) << 5); R = (st >> 1) * 16 + swz / 64; C = (st & 1) * 32 + (swz % 64) / 2; }
__host__ __device__ __forceinline__ int perm32(int rho) { const int n = rho >> 4, i = rho & 15; return 8 * (i >> 2) + 4 * n + (i & 3); }

struct Unit { int pm, pn; };
struct Gemm { const bf16_t* A; const bf16_t* Bt; int M, N, K; };

struct StaticOrder {
    int nM, nN, nwg, G, c, wgm;
    __host__ __device__ void init(int M, int N, int G_, int c_, int wgm_ = WGM) { nM = M / BM; nN = N / BM; nwg = nM * nN; G = G_; c = c_; wgm = wgm_; }
    __host__ __device__ bool next(int i, Unit& u) const {
        const long L = (long)i * G + c; if (L >= nwg) return false;
        int wgid = (int)L; { const int q = nwg / NXCD, r = nwg % NXCD, xcd = wgid % NXCD, off = wgid / NXCD; wgid = (xcd < r ? xcd * (q + 1) : r * (q + 1) + (xcd - r) * q) + off; }
        const int nig = wgm * nN, gid = wgid / nig, fm = gid * wgm, gsz = (nM - fm) < wgm ? (nM - fm) : wgm;
        u.pm = fm + ((wgid % nig) % gsz); u.pn = (wgid % nig) / gsz; return true;
    }
    __device__ __forceinline__ void a_ready(const Unit&) const {}
    __device__ __forceinline__ void done(const Unit&) const {}
};
__device__ __forceinline__ unsigned cvt_pk_bf16(float lo, float hi) { unsigned r; asm volatile("v_cvt_pk_bf16_f32 %0, %1, %2" : "=v"(r) : "v"(lo), "v"(hi)); return r; }
typedef float f32x2 __attribute__((ext_vector_type(2)));
}
namespace pg8 {
__device__ __forceinline__ float row_rstd(const float* ssp, int row) {
    const f32x4 a = *(const f32x4*)(ssp + (size_t)row * 4);
    return __builtin_amdgcn_rsqf(((a[0] + a[1]) + (a[2] + a[3])) * (1.0f / 1024.0f) + 1e-6f);
}
struct EpiZ {
    static constexpr bool PERM = true, AFTER_DRAIN = false;
    bf16_t* Z; float* GK; const PG8_LAS float* tab;
    __device__ __forceinline__ void operator()(const f32x4 (&acc)[2][2][4][2], const Unit& u, int wr, int wc, int fr, int fq) const {
        const int row0 = u.pm * BM + wr * 64 + fr;
        float rsv[2][4];
#pragma unroll
        for (int ai = 0; ai < 2; ++ai)
#pragma unroll
            for (int m = 0; m < 4; ++m) rsv[ai][m] = tab[(u.pm & 7) * 256 + wr * 64 + fr + ai * HALF + m * 16];
        if (u.pn < 18) {
            const int col0 = u.pn * BM + wc * 32 + 8 * fq;
#pragma unroll
            for (int ai = 0; ai < 2; ++ai)
#pragma unroll
                for (int m = 0; m < 4; ++m) { bf16_t* rowp = Z + (size_t)(row0 + ai * HALF + m * 16) * 4608 + col0;
#pragma unroll
                    for (int bj = 0; bj < 2; ++bj) { const f32x4 v0 = acc[ai][bj][m][0] * rsv[ai][m], v1 = acc[ai][bj][m][1] * rsv[ai][m];
                        u32x4 w; w.x = cvt_pk_bf16(v0[0], v0[1]); w.y = cvt_pk_bf16(v0[2], v0[3]); w.z = cvt_pk_bf16(v1[0], v1[1]); w.w = cvt_pk_bf16(v1[2], v1[3]);
                        *(u32x4*)(rowp + bj * HALF) = w; } }
        } else if (wc == 0 && fq < 2) {
#pragma unroll
            for (int ai = 0; ai < 2; ++ai)
#pragma unroll
                for (int m = 0; m < 4; ++m) { float* rp = GK + (size_t)(row0 + ai * HALF + m * 16) * 16 + 8 * fq;
                    *(f32x4*)rp = acc[ai][0][m][0] * rsv[ai][m]; *(f32x4*)(rp + 4) = acc[ai][0][m][1] * rsv[ai][m]; }
        }
    }
};
template <bool HAS_BIAS> struct EpiF32 {
    static constexpr bool PERM = false, AFTER_DRAIN = false;
    float* C; int ldc; const float* bias;
    __device__ __forceinline__ void operator()(const f32x4 (&acc)[2][2][4][2], const Unit& u, int wr, int wc, int fr, int fq) const {
        const int row0 = u.pm * BM + wr * 64 + fr, col0 = u.pn * BM + wc * 32 + 4 * fq;
        f32x4 bv[2][2];
#pragma unroll
        for (int bj = 0; bj < 2; ++bj)
#pragma unroll
            for (int n = 0; n < 2; ++n) bv[bj][n] = HAS_BIAS ? *(const f32x4*)(bias + col0 + bj * HALF + n * 16) : (f32x4){0.f, 0.f, 0.f, 0.f};
#pragma unroll
        for (int ai = 0; ai < 2; ++ai)
#pragma unroll
            for (int m = 0; m < 4; ++m) { float* rowp = C + (size_t)(row0 + ai * HALF + m * 16) * ldc + col0;
#pragma unroll
                for (int bj = 0; bj < 2; ++bj)
#pragma unroll
                    for (int n = 0; n < 2; ++n) *(f32x4*)(rowp + bj * HALF + n * 16) = acc[ai][bj][m][n] + bv[bj][n]; }
    }
};
struct EpiRelu2 {
    static constexpr bool PERM = true, AFTER_DRAIN = false;
    bf16_t* O; int ldc; const PG8_LAS float* tab;
    __device__ __forceinline__ void operator()(const f32x4 (&acc)[2][2][4][2], const Unit& u, int wr, int wc, int fr, int fq) const {
        const int row0 = u.pm * BM + wr * 64 + fr, col0 = u.pn * BM + wc * 32 + 8 * fq;
#pragma unroll
        for (int ai = 0; ai < 2; ++ai)
#pragma unroll
            for (int m = 0; m < 4; ++m) { bf16_t* rowp = O + (size_t)(row0 + ai * HALF + m * 16) * ldc + col0; const float rs = tab[(u.pm & 7) * 256 + wr * 64 + fr + ai * HALF + m * 16];
#pragma unroll
                for (int bj = 0; bj < 2; ++bj) { f32x4 v0 = acc[ai][bj][m][0] * rs, v1 = acc[ai][bj][m][1] * rs;
#pragma unroll
                    for (int j = 0; j < 4; ++j) { const float a = fmaxf(v0[j], 0.f), b = fmaxf(v1[j], 0.f); v0[j] = a * a; v1[j] = b * b; }
                    u32x4 w; w.x = cvt_pk_bf16(v0[0], v0[1]); w.y = cvt_pk_bf16(v0[2], v0[3]); w.z = cvt_pk_bf16(v1[0], v1[1]); w.w = cvt_pk_bf16(v1[2], v1[3]);
                    *(u32x4*)(rowp + bj * HALF) = w; } }
    }
};
struct EpiGLU {
    static constexpr bool PERM = true, AFTER_DRAIN = false;
    bf16_t* U; const float* bias; const PG8_LAS float* tab;
    __device__ __forceinline__ void operator()(const f32x4 (&acc)[2][2][4][2], const Unit& u, int wr, int wc, int fr, int fq) const {
        const int row0 = u.pm * BM + wr * 64 + fr, col0 = u.pn * HALF + wc * 32 + 8 * fq;
        f32x4 b1[2], b2[2];
#pragma unroll
        for (int n = 0; n < 2; ++n) { b1[n] = *(const f32x4*)(bias + col0 + 4 * n); b2[n] = *(const f32x4*)(bias + 1024 + col0 + 4 * n); }
#pragma unroll
        for (int ai = 0; ai < 2; ++ai)
#pragma unroll
            for (int m = 0; m < 4; ++m) { bf16_t* rowp = U + (size_t)(row0 + ai * HALF + m * 16) * 1024 + col0; const float rs = tab[(u.pm & 7) * 256 + wr * 64 + fr + ai * HALF + m * 16];
                f32x4 o[2];
#pragma unroll
                for (int n = 0; n < 2; ++n) { const f32x4 a = acc[ai][0][m][n] * rs + b1[n], g = acc[ai][1][m][n] * rs + b2[n];
#pragma unroll
                    for (int j = 0; j < 4; ++j) o[n][j] = a[j] * __builtin_amdgcn_rcpf(1.f + __expf(-g[j])); }
                u32x4 w; w.x = cvt_pk_bf16(o[0][0], o[0][1]); w.y = cvt_pk_bf16(o[0][2], o[0][3]); w.z = cvt_pk_bf16(o[1][0], o[1][1]); w.w = cvt_pk_bf16(o[1][2], o[1][3]);
                *(u32x4*)rowp = w; }
    }
};

struct RmsStats {
    float* xbuf;
    unsigned* cnt;
    __device__ __forceinline__ void run(const f32x4 (&v)[2][2][4][2], const Unit& u, int wr, int wc, int fr, int fq, PG8_LAS unsigned char* lds, int wid, int lane) const {
        PG8_LAS float* P = (PG8_LAS float*)lds;
        PG8_LAS float* S = (PG8_LAS float*)(lds + 4096);
#pragma unroll
        for (int ai = 0; ai < 2; ++ai)
#pragma unroll
            for (int m = 0; m < 4; ++m) {
                float s = 0.f;
#pragma unroll
                for (int bj = 0; bj < 2; ++bj)
#pragma unroll
                    for (int n = 0; n < 2; ++n) { const f32x4 x = v[ai][bj][m][n]; s += (x[0] * x[0] + x[1] * x[1]) + (x[2] * x[2] + x[3] * x[3]); }
                s += __shfl_xor(s, 16); s += __shfl_xor(s, 32);
                if (fq == 0) P[(ai * HALF + wr * 64 + m * 16 + fr) * 4 + wc] = s;
            }
        asm volatile("s_waitcnt lgkmcnt(0)" ::: "memory"); __builtin_amdgcn_s_barrier(); asm volatile("" ::: "memory");
        const int row = wid * 32 + (lane & 31);
        if (lane < 32) { const f32x4 p = *(const PG8_LAS f32x4*)(P + row * 4); const float t = (p[0] + p[1]) + (p[2] + p[3]);
            __hip_atomic_store(xbuf + ((size_t)(u.pm * BM + row) * 4 + u.pn), t, __ATOMIC_RELAXED, __HIP_MEMORY_SCOPE_AGENT); }
        asm volatile("s_waitcnt vmcnt(0)" ::: "memory");
        if (lane == 0) __hip_atomic_fetch_add(cnt + 64 * u.pm, 1u, __ATOMIC_RELAXED, __HIP_MEMORY_SCOPE_AGENT);
        if (wid == 0) {
            unsigned sp = 0u;
            while ((unsigned)__builtin_amdgcn_readfirstlane(__hip_atomic_load(cnt + 64 * u.pm, __ATOMIC_RELAXED, __HIP_MEMORY_SCOPE_AGENT)) < 32u) { __builtin_amdgcn_s_sleep(2); if (++sp > (1u << 22)) break; }
        }
        asm volatile("s_waitcnt vmcnt(0) lgkmcnt(0)" ::: "memory"); __builtin_amdgcn_s_barrier(); asm volatile("" ::: "memory");
        if (lane < 32) { const float* slot = xbuf + (size_t)(u.pm * BM + row) * 4; float t = 0.f;
#pragma unroll
            for (int i = 0; i < 4; ++i) t += __hip_atomic_load(slot + i, __ATOMIC_RELAXED, __HIP_MEMORY_SCOPE_AGENT);
            S[row] = __builtin_amdgcn_rsqf(t * (1.0f / 1024.0f) + 1e-6f); }
        asm volatile("s_waitcnt lgkmcnt(0)" ::: "memory"); __builtin_amdgcn_s_barrier(); asm volatile("" ::: "memory");
    }
};
template <bool HAS_BIAS, bool HAS_PRE, bool XS_BF16, bool XD_BF16> struct EpiNorm {
    static constexpr bool PERM = false, AFTER_DRAIN = true;
    const void* xs; void* xd; float* ssq_out; const float* bias; const float* gpost; RmsStats st1;
    __device__ __forceinline__ void fused(f32x4 (&acc)[2][2][4][2], const Unit& u, int wr, int wc, int fr, int fq, PG8_LAS unsigned char* lds, int wid, int lane) const {
        typedef unsigned u32x2v __attribute__((ext_vector_type(2)));
        const PG8_LAS float* S = (const PG8_LAS float*)(lds + 4096);
        const int col0 = u.pn * BM + wc * 32 + 4 * fq;
        if (HAS_BIAS) {
#pragma unroll
            for (int bj = 0; bj < 2; ++bj)
#pragma unroll
                for (int n = 0; n < 2; ++n) { const f32x4 bv = *(const f32x4*)(bias + col0 + bj * HALF + n * 16);
#pragma unroll
                    for (int ai = 0; ai < 2; ++ai)
#pragma unroll
                        for (int m = 0; m < 4; ++m) acc[ai][bj][m][n] += bv; }
        }
        f32x4 gv[2][2];
#pragma unroll
        for (int bj = 0; bj < 2; ++bj)
#pragma unroll
            for (int n = 0; n < 2; ++n) gv[bj][n] = *(const f32x4*)(gpost + col0 + bj * HALF + n * 16);
        st1.run(acc, u, wr, wc, fr, fq, lds, wid, lane);
#pragma unroll
        for (int ai = 0; ai < 2; ++ai) {
            f32x4 xv[4][2][2];
#pragma unroll
            for (int mm = 0; mm < 4; ++mm) { const size_t off = (size_t)(u.pm * BM + ai * HALF + wr * 64 + mm * 16 + fr) * 1024 + col0;
#pragma unroll
                for (int bj = 0; bj < 2; ++bj)
#pragma unroll
                    for (int n = 0; n < 2; ++n) {
                        if (XS_BF16) { const u32x2v p = *(const u32x2v*)((const bf16_t*)xs + off + bj * HALF + n * 16);
                            xv[mm][bj][n] = (f32x4){__uint_as_float(p.x << 16), __uint_as_float(p.x & 0xffff0000u), __uint_as_float(p.y << 16), __uint_as_float(p.y & 0xffff0000u)}; }
                        else xv[mm][bj][n] = *(const f32x4*)((const float*)xs + off + bj * HALF + n * 16); } }
#pragma unroll
            for (int mm = 0; mm < 4; ++mm) asm volatile("" : "+v"(xv[mm][0][0]), "+v"(xv[mm][0][1]), "+v"(xv[mm][1][0]), "+v"(xv[mm][1][1]));
#pragma unroll
            for (int m = 0; m < 4; ++m) { const int r = ai * HALF + wr * 64 + m * 16 + fr; const float rs = S[r]; const size_t off = (size_t)(u.pm * BM + r) * 1024 + col0;
#pragma unroll
                for (int bj = 0; bj < 2; ++bj)
#pragma unroll
                    for (int n = 0; n < 2; ++n) { f32x4 o = xv[m][bj][n] + acc[ai][bj][m][n] * rs * gv[bj][n];
                        if (XD_BF16) { u32x2v w; w.x = cvt_pk_bf16(o[0], o[1]); w.y = cvt_pk_bf16(o[2], o[3]); *(u32x2v*)((bf16_t*)xd + off + bj * HALF + n * 16) = w;
                            o = (f32x4){__uint_as_float(w.x << 16), __uint_as_float(w.x & 0xffff0000u), __uint_as_float(w.y << 16), __uint_as_float(w.y & 0xffff0000u)}; }
                        else *(f32x4*)((float*)xd + off + bj * HALF + n * 16) = o;
                        acc[ai][bj][m][n] = o; } }
        }
        if (HAS_PRE) {
            PG8_LAS float* P = (PG8_LAS float*)lds;
            P += 2048;
#pragma unroll
            for (int ai = 0; ai < 2; ++ai)
#pragma unroll
                for (int m = 0; m < 4; ++m) {
                    float s = 0.f;
#pragma unroll
                    for (int bj = 0; bj < 2; ++bj)
#pragma unroll
                        for (int n = 0; n < 2; ++n) { const f32x4 x = acc[ai][bj][m][n]; s += (x[0] * x[0] + x[1] * x[1]) + (x[2] * x[2] + x[3] * x[3]); }
                    s += __shfl_xor(s, 16); s += __shfl_xor(s, 32);
                    if (fq == 0) P[(ai * HALF + wr * 64 + m * 16 + fr) * 4 + wc] = s;
                }
            asm volatile("s_waitcnt lgkmcnt(0)" ::: "memory"); __builtin_amdgcn_s_barrier(); asm volatile("" ::: "memory");
            if (lane < 32) { const int row = wid * 32 + lane; const f32x4 p = *(const PG8_LAS f32x4*)(P + row * 4);
                ssq_out[(size_t)(u.pm * BM + row) * 4 + u.pn] = (p[0] + p[1]) + (p[2] + p[3]); }
        }
    }
};
}
namespace pg8 {
template <class Epi, class Sched, bool ALIGN_EPI = false, bool SP2 = false>
__device__ __forceinline__ void gemm_phase(PG8_LAS unsigned char* lds, const Gemm g, const Sched& S, const Epi& E) {
    int tid = threadIdx.x; asm volatile("" : "+v"(tid)); const int wid = __builtin_amdgcn_readfirstlane(tid >> 6), lane = tid & 63, wr = wid >> 2, wc = wid & 3, fr = lane & 15, fq = lane >> 4;
    const int K = g.K, nt = K / BK;
    unsigned voffA[2], voffB[2];
#pragma unroll
    for (int i = 0; i < 2; ++i) { int R, C; stage_rc(tid * 16 + i * 8192, R, C); const int Rb = Epi::PERM ? ((R & ~31) + perm32(R & 31)) : R;
        voffA[i] = (unsigned)(R * K + C) * 2u; voffB[i] = (unsigned)(Rb * K + C) * 2u; }
    const size_t kstep = (size_t)(BK * 2);
    const size_t hstep = (size_t)HALF * K * 2;
    const size_t tstep = 2 * hstep;
    const unsigned ldsw = (unsigned)wid * 1024u;
    const int aoff = lds_byte(wr * 64 + fr, fq * 8), boff = lds_byte(wc * 32 + fr, fq * 8);
#define PG8_SA(b, h) (((b) * 2 + (h)) * HTB)
#define PG8_SB(b, h) ((4 + (b) * 2 + (h)) * HTB)
#define PG8_STAGE(bufoff, gbase, voff) do { _Pragma("unroll") for (int _i = 0; _i < 2; ++_i) \
        __builtin_amdgcn_global_load_lds((const unsigned*)((const char*)(gbase) + (voff)[_i]), (PG8_LAS unsigned*)(lds + (bufoff) + ldsw + _i * 8192), 16, 0, 0); } while (0)
#define PG8_LDA(dst, b, h) do { _Pragma("unroll") for (int m = 0; m < 4; ++m) _Pragma("unroll") for (int k = 0; k < 2; ++k) dst[m][k] = *(const PG8_LAS bf16x8*)(lds + PG8_SA(b, h) + aoff + m * 2048 + k * 1024); } while (0)
#define PG8_LDB(dst, b, h) do { _Pragma("unroll") for (int n = 0; n < 2; ++n) _Pragma("unroll") for (int k = 0; k < 2; ++k) dst[n][k] = *(const PG8_LAS bf16x8*)(lds + PG8_SB(b, h) + boff + n * 2048 + k * 1024); } while (0)
#define PG8_MMA(ai, bj, At, Bt) do { __builtin_amdgcn_s_setprio(1); _Pragma("unroll") for (int m = 0; m < 4; ++m) _Pragma("unroll") for (int n = 0; n < 2; ++n) _Pragma("unroll") for (int k = 0; k < 2; ++k) \
        acc[ai][bj][m][n] = __builtin_amdgcn_mfma_f32_16x16x32_bf16(Bt[n][k], At[m][k], acc[ai][bj][m][n], 0, 0, 0); __builtin_amdgcn_s_setprio(0); } while (0)
#define PG8_WAIT_V(n) asm volatile("s_waitcnt vmcnt(" #n ")" ::: "memory")
#define PG8_WAIT_L(n) asm volatile("s_waitcnt lgkmcnt(" #n ")" ::: "memory")
#define PG8_BAR __builtin_amdgcn_s_barrier()
#define PG8_SCHED __builtin_amdgcn_sched_barrier(0)
    Unit cur, nxt; int ui = 0;
    if (!S.next(0, cur)) return;
    f32x4 acc[2][2][4][2];
#pragma unroll
    for (int a = 0; a < 2; ++a)
#pragma unroll
        for (int b = 0; b < 2; ++b)
#pragma unroll
            for (int m = 0; m < 4; ++m)
#pragma unroll
                for (int n = 0; n < 2; ++n) acc[a][b][m][n] = (f32x4){0.f, 0.f, 0.f, 0.f};
    bf16x8 At[4][2], B0[2][2], B1[2][2];
    const char* cA = (const char*)g.A + (size_t)cur.pm * tstep; const char* cB = (const char*)g.Bt + (size_t)cur.pn * tstep;
    S.a_ready(cur);
    if constexpr (SP2) {
        PG8_STAGE(PG8_SB(0, 0), cB, voffB); PG8_STAGE(PG8_SB(0, 1), cB + hstep, voffB); PG8_STAGE(PG8_SA(0, 0), cA, voffA); PG8_STAGE(PG8_SA(0, 1), cA + hstep, voffA);
        if (wr == 1) PG8_BAR;
        PG8_WAIT_V(2); PG8_BAR;
        PG8_STAGE(PG8_SB(1, 0), cB + kstep, voffB); PG8_STAGE(PG8_SA(1, 0), cA + kstep, voffA); PG8_STAGE(PG8_SB(1, 1), cB + hstep + kstep, voffB);
        PG8_WAIT_V(6); PG8_BAR;
    } else {
        PG8_STAGE(PG8_SB(0, 0), cB, voffB); PG8_STAGE(PG8_SA(0, 0), cA, voffA); PG8_STAGE(PG8_SB(0, 1), cB + hstep, voffB); PG8_STAGE(PG8_SA(0, 1), cA + hstep, voffA);
        if (wr == 1) PG8_BAR;
        PG8_WAIT_V(4); PG8_BAR;
        PG8_STAGE(PG8_SB(1, 0), cB + kstep, voffB); PG8_STAGE(PG8_SA(1, 0), cA + kstep, voffA); PG8_STAGE(PG8_SB(1, 1), cB + hstep + kstep, voffB);
        PG8_WAIT_V(6); PG8_BAR;
    }
    for (;;) {
        const bool has_next = S.next(ui + 1, nxt);
        const char* nA = has_next ? (const char*)g.A + (size_t)nxt.pm * tstep : cA; const char* nB = has_next ? (const char*)g.Bt + (size_t)nxt.pn * tstep : cB;
        for (int t = 0; t < nt; t += 2) {
            const bool last = (t == nt - 2);
            const char* a1 = cA + (size_t)(t + 1) * kstep;
            const char* a2 = last ? nA : cA + (size_t)(t + 2) * kstep; const char* b2 = last ? nB : cB + (size_t)(t + 2) * kstep;
            const char* a3 = a2 + kstep; const char* b3 = b2 + kstep;
            if (last && has_next) S.a_ready(nxt);
            if constexpr (SP2) {
            PG8_LDB(B0, 0, 0); PG8_LDB(B1, 0, 1); PG8_SCHED; PG8_LDA(At, 0, 0); PG8_STAGE(PG8_SA(1, 1), a1 + hstep, voffA);
            PG8_WAIT_V(8); PG8_WAIT_L(0); PG8_BAR; PG8_MMA(0, 0, At, B0); PG8_MMA(0, 1, At, B1); PG8_BAR; PG8_SCHED;
            PG8_LDA(At, 0, 1); PG8_STAGE(PG8_SB(0, 0), b2, voffB); PG8_STAGE(PG8_SB(0, 1), b2 + hstep, voffB); PG8_STAGE(PG8_SA(0, 0), a2, voffA);
            PG8_WAIT_V(8); PG8_WAIT_L(0); PG8_BAR; PG8_MMA(1, 0, At, B0); PG8_MMA(1, 1, At, B1); PG8_BAR; PG8_SCHED;
            PG8_LDB(B0, 1, 0); PG8_LDB(B1, 1, 1); PG8_SCHED; PG8_LDA(At, 1, 0); PG8_STAGE(PG8_SA(0, 1), a2 + hstep, voffA);
            PG8_WAIT_V(8); PG8_WAIT_L(0); PG8_BAR; PG8_MMA(0, 0, At, B0); PG8_MMA(0, 1, At, B1); PG8_BAR; PG8_SCHED;
            PG8_LDA(At, 1, 1); PG8_STAGE(PG8_SB(1, 0), b3, voffB); PG8_STAGE(PG8_SB(1, 1), b3 + hstep, voffB); PG8_STAGE(PG8_SA(1, 0), a3, voffA);
            PG8_WAIT_V(8); PG8_WAIT_L(0); PG8_BAR; PG8_MMA(1, 0, At, B0); PG8_MMA(1, 1, At, B1); PG8_BAR; PG8_SCHED;
            } else {
            PG8_LDB(B0, 0, 0); PG8_SCHED; PG8_LDA(At, 0, 0); PG8_STAGE(PG8_SA(1, 1), a1 + hstep, voffA);
            PG8_WAIT_L(8); PG8_BAR; PG8_WAIT_L(0); PG8_MMA(0, 0, At, B0); PG8_BAR; PG8_SCHED;
            PG8_LDB(B1, 0, 1); PG8_STAGE(PG8_SB(0, 0), b2, voffB);
            PG8_BAR; PG8_WAIT_L(0); PG8_MMA(0, 1, At, B1); PG8_BAR;
            PG8_LDA(At, 0, 1); PG8_STAGE(PG8_SA(0, 0), a2, voffA);
            PG8_BAR; PG8_WAIT_L(0); PG8_MMA(1, 0, At, B0); PG8_BAR; PG8_SCHED;
            PG8_STAGE(PG8_SB(0, 1), b2 + hstep, voffB);
            PG8_WAIT_V(6); PG8_BAR; PG8_MMA(1, 1, At, B1); PG8_BAR;
            PG8_LDB(B0, 1, 0); PG8_SCHED; PG8_LDA(At, 1, 0); PG8_STAGE(PG8_SA(0, 1), a2 + hstep, voffA);
            PG8_WAIT_L(8); PG8_BAR; PG8_WAIT_L(0); PG8_MMA(0, 0, At, B0); PG8_BAR; PG8_SCHED;
            PG8_LDB(B1, 1, 1); PG8_STAGE(PG8_SB(1, 0), b3, voffB);
            PG8_BAR; PG8_WAIT_L(0); PG8_MMA(0, 1, At, B1); PG8_BAR;
            PG8_LDA(At, 1, 1); PG8_STAGE(PG8_SA(1, 0), a3, voffA);
            PG8_BAR; PG8_WAIT_L(0); PG8_MMA(1, 0, At, B0); PG8_BAR; PG8_SCHED;
            PG8_STAGE(PG8_SB(1, 1), b3 + hstep, voffB);
            PG8_WAIT_V(6); PG8_BAR; PG8_MMA(1, 1, At, B1); PG8_BAR;
            }
        }
        if constexpr (ALIGN_EPI) { if (wr == 0) PG8_BAR; }
        if constexpr (!Epi::AFTER_DRAIN) { E(acc, cur, wr, wc, fr, fq); S.done(cur); }
        if (!has_next) break;
#pragma unroll
        for (int a = 0; a < 2; ++a)
#pragma unroll
            for (int b = 0; b < 2; ++b)
#pragma unroll
                for (int m = 0; m < 4; ++m)
#pragma unroll
                    for (int n = 0; n < 2; ++n) acc[a][b][m][n] = (f32x4){0.f, 0.f, 0.f, 0.f};
        cur = nxt; cA = nA; cB = nB; ++ui;
        if constexpr (ALIGN_EPI) { if (wr == 1) PG8_BAR; }
    }
    PG8_WAIT_V(0);
    if constexpr (!ALIGN_EPI) { if (wr == 0) PG8_BAR; }
    PG8_BAR;
    if constexpr (Epi::AFTER_DRAIN) { E.fused(acc, cur, wr, wc, fr, fq, lds, wid, lane); S.done(cur); }
#undef PG8_SA
#undef PG8_SB
#undef PG8_STAGE
#undef PG8_LDA
#undef PG8_LDB
#undef PG8_MMA
#undef PG8_WAIT_V
#undef PG8_WAIT_L
#undef PG8_BAR
#undef PG8_SCHED
}
}
#include <hip/hip_cooperative_groups.h>
namespace cg = cooperative_groups;
#define LAS __attribute__((address_space(3)))
#define GAS __attribute__((address_space(1)))
typedef unsigned short bf16;
typedef float f32x4 __attribute__((ext_vector_type(4)));
typedef float f32x2 __attribute__((ext_vector_type(2)));
typedef short bf16x8 __attribute__((ext_vector_type(8)));
typedef unsigned u32x4 __attribute__((ext_vector_type(4)));
typedef unsigned u32x2 __attribute__((ext_vector_type(2)));

constexpr int T = 16384, D = 1024, DEPTH = 4, FF = 4096;
constexpr int ZLD = 4608, ZN = 4864, ABIN = 4624, MIXLD = 1536;
constexpr int ZSX = 0, ZSB = 512, ZSC = 1024, ZQ = 1536, ZK = 2048, ZV = 2560, ZG = 3584;
constexpr float EPS = 1e-6f;
constexpr int NWAVES = 8, NTHR = 512;
constexpr int LDS_BYTES = 147456;
constexpr size_t MiB = 1u << 20;
constexpr size_t WS_DEC = 256 * 1024;
constexpr size_t WS_BAR = 0;
constexpr size_t WS_EBL = 512 * 1024;
constexpr size_t WS_CNT = 16 * 1024;
constexpr size_t WS_X1 = 255 * MiB;
constexpr size_t WS_W = 1536 * 1024;
constexpr size_t WS_H = 30 * MiB;
constexpr size_t WS_BIG = 62 * MiB;
constexpr size_t WS_GK = 254 * MiB;
constexpr size_t WS_END = 255 * MiB + 256 * 1024;
constexpr size_t WO_MIX1 = 0;
constexpr size_t WO_MIX2_E = (size_t)ZN * D;
constexpr size_t WO_MIX2_O = (size_t)2048 * D;
constexpr size_t WO_W1 = (size_t)ZN * D + (size_t)D * MIXLD;
constexpr size_t WO_W2 = WO_W1 + (size_t)FF * D;
static_assert(WS_W + (WO_W2 + (size_t)FF * D) * 2 <= WS_H, "weights fit");

__device__ __forceinline__ int tid_l() { int t = threadIdx.x; asm volatile("" : "+v"(t)); return t; }
__device__ __forceinline__ float bf2f(unsigned b) { return __uint_as_float(b << 16); }
__device__ __forceinline__ unsigned pkbf(float lo, float hi) { return pg8::cvt_pk_bf16(lo, hi); }
template <int CTRL> __device__ __forceinline__ float dppf(float v) { return __builtin_bit_cast(float, __builtin_amdgcn_update_dpp(0, __builtin_bit_cast(int, v), CTRL, 0xf, 0xf, true)); }
__device__ __forceinline__ float row16_sum(float v) { v += dppf<0xB1>(v); v += dppf<0x4E>(v); v += dppf<0x141>(v); v += dppf<0x140>(v); return v; }
__device__ __forceinline__ float wave_sum(float v) {
    v = row16_sum(v);
    const int iv = __builtin_bit_cast(int, v);
    return (__builtin_bit_cast(float, __builtin_amdgcn_readlane(iv, 0)) + __builtin_bit_cast(float, __builtin_amdgcn_readlane(iv, 16))) + (__builtin_bit_cast(float, __builtin_amdgcn_readlane(iv, 32)) + __builtin_bit_cast(float, __builtin_amdgcn_readlane(iv, 48)));
}

template <int MODE, bool GAIN>
__device__ __forceinline__ void transpose_item(const float* W, int K, int N, bf16* WT, LAS float* scr, int item, int lane, const float* gain) {
    const int nblk = (N + 31) / 32, kb = item / nblk, nb = item % nblk, k0 = 64 * kb, n0 = 32 * nb;
    const bool ok = (n0 + (lane & 31)) < N;
    float tv[32];
#pragma unroll
    for (int i = 0; i < 32; ++i) { const int kk = 2 * i + (lane >> 5); tv[i] = ok ? W[(size_t)(k0 + kk) * N + n0 + (lane & 31)] : 0.f; }
#pragma unroll
    for (int i = 0; i < 32; ++i) { const int kk = 2 * i + (lane >> 5); scr[kk * 33 + (lane & 31)] = tv[i]; }
    asm volatile("s_waitcnt lgkmcnt(0)" ::: "memory");
    int d0 = n0;
    if (MODE == 1) { const int half = n0 >> 10, c0 = n0 & 1023; d0 = ((c0 >> 7) << 8) + (half << 7) + (c0 & 127); }
    const int c = lane & 7;
    f32x4 ga = (f32x4){1.f, 1.f, 1.f, 1.f}, gb = ga;
    if (GAIN) { ga = *(const f32x4*)(gain + k0 + 8 * c); gb = *(const f32x4*)(gain + k0 + 8 * c + 4); }
#pragma unroll
    for (int j = 0; j < 4; ++j) { const int n = (lane >> 3) + 8 * j; const LAS float* s = scr + (8 * c) * 33 + n;
        u32x4 o; o.x = pkbf(s[0 * 33] * ga.x, s[1 * 33] * ga.y); o.y = pkbf(s[2 * 33] * ga.z, s[3 * 33] * ga.w); o.z = pkbf(s[4 * 33] * gb.x, s[5 * 33] * gb.y); o.w = pkbf(s[6 * 33] * gb.z, s[7 * 33] * gb.w);
        *(u32x4*)(WT + (size_t)(d0 + n) * K + k0 + 8 * c) = o; }
    asm volatile("s_waitcnt lgkmcnt(0)" ::: "memory");
}

struct Args { const float* in[21]; float* out; unsigned char* ws; int ph_lo, ph_hi; };
__device__ __forceinline__ const float* inp(int i) { const __attribute__((address_space(4))) char* kp = (const __attribute__((address_space(4))) char*)__builtin_amdgcn_kernarg_segment_ptr(); asm volatile("" : "+s"(kp)); const float* p = *(const float* const __attribute__((address_space(4)))*)(kp + 8 * i); return (const float*)(const __attribute__((address_space(1))) float*)p; }

template <int PART>
__device__ __forceinline__ void convert_layer(unsigned char* wsp, int l, LAS unsigned char* lds, int gw, int NGW, int wave, int lane) {
    LAS float* scr = (LAS float*)(lds + wave * 8704);
    bf16* Wb_ = (bf16*)(wsp + WS_W);
    const int i2 = l >> 1;
    if (PART == 1) {
        const float* w1 = inp(19) + (size_t)l * D * FF; const float* w2 = inp(20) + (size_t)l * FF * D;
        constexpr int I_W1 = (D / 64) * (FF / 32), I_W2 = (FF / 64) * (D / 32);
        for (int it = gw; it < I_W1 + I_W2; it += NGW) {
            if (it < I_W1) transpose_item<0, true>(w1, D, FF, Wb_ + WO_W1, scr, it, lane, inp(3) + (size_t)l * D);
            else transpose_item<0, false>(w2, FF, D, Wb_ + WO_W2, scr, it - I_W1, lane, nullptr); }
    } else if ((l & 1) == 0) {
        const float* win = inp(5) + (size_t)i2 * D * ABIN; const float* wout = inp(10) + (size_t)i2 * MIXLD * D;
        constexpr int I_IN = (D / 64) * ((ABIN + 31) / 32), I_OUT = (MIXLD / 64) * (D / 32);
        for (int it = gw; it < I_IN + I_OUT; it += NGW) {
            if (it < I_IN) transpose_item<0, true>(win, D, ABIN, Wb_ + WO_MIX1, scr, it, lane, inp(1) + (size_t)l * D);
            else transpose_item<0, false>(wout, MIXLD, D, Wb_ + WO_MIX2_E, scr, it - I_IN, lane, nullptr); }
        u32x4* pz = (u32x4*)(Wb_ + WO_MIX1 + (size_t)4640 * D); const int nz = (ZN - 4640) * D / 8;
        for (int i = gw * 64 + lane; i < nz; i += NGW * 64) pz[i] = (u32x4){0u, 0u, 0u, 0u};
    } else {
        const float* pw1 = inp(11) + (size_t)i2 * D * 2048; const float* pw2 = inp(17) + (size_t)i2 * D * D;
        constexpr int I_P1 = (D / 64) * (2048 / 32), I_P2 = (D / 64) * (D / 32);
        for (int it = gw; it < I_P1 + I_P2; it += NGW) {
            if (it < I_P1) transpose_item<1, true>(pw1, D, 2048, Wb_ + WO_MIX1, scr, it, lane, inp(1) + (size_t)l * D);
            else transpose_item<0, false>(pw2, D, D, Wb_ + WO_MIX2_O, scr, it - I_P1, lane, nullptr); }
    }
}

__device__ __forceinline__ void prologue_rows(const float* xs, bf16* xb, float* ssx, int gw, int NGW, int lane) {
    for (int row = gw; row < T; row += 2 * NGW) {
        const int row2 = row + NGW;
        const f32x4* xa = (const f32x4*)(xs + (size_t)row * D) + lane; const f32x4* xc = (const f32x4*)(xs + (size_t)row2 * D) + lane;
        f32x4 va[4], vb[4];
#pragma unroll
        for (int j = 0; j < 4; ++j) { va[j] = xa[64 * j]; vb[j] = xc[64 * j]; }
        float sa = 0.f, sb = 0.f;
#pragma unroll
        for (int j = 0; j < 4; ++j) { sa += (va[j].x * va[j].x + va[j].y * va[j].y) + (va[j].z * va[j].z + va[j].w * va[j].w); sb += (vb[j].x * vb[j].x + vb[j].y * vb[j].y) + (vb[j].z * vb[j].z + vb[j].w * vb[j].w); }
        sa = wave_sum(sa); sb = wave_sum(sb);
        if (lane < 4) { ssx[(size_t)row * 4 + lane] = lane == 0 ? sa : 0.f; ssx[(size_t)row2 * 4 + lane] = lane == 0 ? sb : 0.f; }
        u32x2* ha = (u32x2*)(xb + (size_t)row * D) + lane; u32x2* hb = (u32x2*)(xb + (size_t)row2 * D) + lane;
#pragma unroll
        for (int j = 0; j < 4; ++j) { u32x2 wa, wb; wa.x = pkbf(va[j].x, va[j].y); wa.y = pkbf(va[j].z, va[j].w); wb.x = pkbf(vb[j].x, vb[j].y); wb.y = pkbf(vb[j].z, vb[j].w); ha[64 * j] = wa; hb[64 * j] = wb; }
    }
}

constexpr int G_QD = 0, G_KD = 17408, G_KLT = 34816, G_VT = 53248, G_P = 90112, G_SEG = 99328, G_EBL = 101376, G_SS = 101888, G_GT = 103936;
#define MFMA16(a, b, c) __builtin_amdgcn_mfma_f32_16x16x32_bf16(a, b, c, 0, 0, 0)
template <bool OUT>
__device__ __forceinline__ void gla_unit(int unit, bf16* z, const float* gklr, const float* wgk2, const float* bgk2, const float* normg, float* E, float* DEC, float* EBLG, bf16* mix, LAS unsigned char* lds) {
    const int tid = tid_l(), lane = tid & 63, w = __builtin_amdgcn_readfirstlane(tid >> 6), r = lane & 15, q = lane >> 4;
    const int g = unit >> 2, h = unit & 3;
    const int seg = w >> 1, k = (w & 1) * 64 + lane, hk = h * 128 + k;
    f32x4 S[8][2];
    GAS float* Eu = (GAS float*)E + (size_t)unit * 32768 + (size_t)w * 4096 + lane;
    if (OUT) {
#pragma unroll
        for (int mt = 0; mt < 8; ++mt)
#pragma unroll
            for (int nt = 0; nt < 2; ++nt)
#pragma unroll
                for (int i = 0; i < 4; ++i) S[mt][nt][i] = Eu[((mt * 2 + nt) * 4 + i) * 64];
    } else {
#pragma unroll
        for (int mt = 0; mt < 8; ++mt)
#pragma unroll
            for (int nt = 0; nt < 2; ++nt) S[mt][nt] = (f32x4){0.f, 0.f, 0.f, 0.f};
    }
    float bsum = 0.f;
    LAS float* SEG = (LAS float*)(lds + G_SEG); LAS float* EBL = (LAS float*)(lds + G_EBL); LAS float* SSQ = (LAS float*)(lds + G_SS);
    for (int ch = 0; ch < 4; ++ch) {
        const int t0 = g * 256 + ch * 64, cgl = g * 4 + ch;
        int tl = tid; asm volatile("" : "+v"(tl));
        if (!OUT) {
            u32x4 qr4[2], kr4[2];
#pragma unroll
            for (int i = 0; i < 2; ++i) { const int c = tl + 512 * i, row = c >> 4, c16 = c & 15; const GAS bf16* zr = (const GAS bf16*)z + (size_t)(t0 + row) * ZLD + h * 128 + c16 * 8;
                qr4[i] = *(const GAS u32x4*)(zr + ZQ); kr4[i] = *(const GAS u32x4*)(zr + ZK); }
            float w2r[16];
#pragma unroll
            for (int i = 0; i < 16; ++i) w2r[i] = ((const GAS float*)wgk2)[i * 512 + hk];
            const float bias = ((const GAS float*)bgk2)[hk];
            if (tid < 256) *(LAS f32x4*)(lds + G_KLT + tid * 16) = *(const GAS f32x4*)((const GAS float*)gklr + (size_t)t0 * 16 + tid * 4);
            asm volatile("" : "+v"(qr4[0]), "+v"(qr4[1]), "+v"(kr4[0]), "+v"(kr4[1]));
#pragma unroll
            for (int i = 0; i < 2; ++i) { const int c = tl + 512 * i, row = c >> 4, c16 = c & 15;
                *(LAS u32x4*)(lds + G_QD + row * 272 + c16 * 16) = qr4[i]; *(LAS u32x4*)(lds + G_KD + row * 272 + c16 * 16) = kr4[i]; }
            __syncthreads();
            float b[16]; float run = 0.f;
#pragma unroll
            for (int jj = 0; jj < 16; ++jj) {
                const LAS f32x4* gp = (const LAS f32x4*)(lds + G_KLT + (seg * 16 + jj) * 64);
                const f32x4 g0 = gp[0], g1 = gp[1], g2 = gp[2], g3 = gp[3];
                float gv = bias;
                gv += g0.x * w2r[0] + g0.y * w2r[1] + g0.z * w2r[2] + g0.w * w2r[3];
                gv += g1.x * w2r[4] + g1.y * w2r[5] + g1.z * w2r[6] + g1.w * w2r[7];
                gv += g2.x * w2r[8] + g2.y * w2r[9] + g2.z * w2r[10] + g2.w * w2r[11];
                gv += g3.x * w2r[12] + g3.y * w2r[13] + g3.z * w2r[14] + g3.w * w2r[15];
                const float ls = -(fmaxf(-gv, 0.f) + __logf(1.f + __expf(-fabsf(gv)))) * (1.f / 16.f);
                run += ls; b[jj] = run;
            }
            SEG[seg * 128 + k] = run;
            __syncthreads();
            float pre = 0.f, tot = 0.f;
#pragma unroll
            for (int s = 0; s < 4; ++s) { const float v = SEG[s * 128 + k]; tot += v; pre += (s < seg) ? v : 0.f; }
            if (seg == 0) { const float eb = __expf(tot); EBL[k] = eb; ((GAS float*)EBLG)[cgl * 512 + hk] = eb; bsum += tot; }
#pragma unroll
            for (int jj = 0; jj < 16; ++jj) {
                const int j = seg * 16 + jj; const float bb = b[jj] + pre;
                LAS bf16* qp = (LAS bf16*)(lds + G_QD + (j * 136 + k) * 2); LAS bf16* kp2 = (LAS bf16*)(lds + G_KD + (j * 136 + k) * 2);
                const float kv = bf2f(*kp2), qv = bf2f(*qp);
                *qp = (bf16)(pkbf(qv * 0.08838834764831845f * __expf(bb), 0.f) & 0xffffu);
                *kp2 = (bf16)(pkbf(kv * __expf(-bb), 0.f) & 0xffffu);
            }
        } else {
            u32x4 gtv[4], qv4[2], kv4[2];
#pragma unroll
            for (int i = 0; i < 4; ++i) { const int c = tl + 512 * i, row = c >> 5, c16 = c & 31; gtv[i] = *(const GAS u32x4*)((const GAS bf16*)z + (size_t)(t0 + row) * ZLD + ZG + h * 256 + c16 * 8); }
#pragma unroll
            for (int i = 0; i < 2; ++i) { const int c = tl + 512 * i, row = c >> 4, c16 = c & 15; const GAS bf16* zr = (const GAS bf16*)z + (size_t)(t0 + row) * ZLD + h * 128 + c16 * 8;
                qv4[i] = *(const GAS u32x4*)(zr + ZQ); kv4[i] = *(const GAS u32x4*)(zr + ZK); }
            const float eb = ((const GAS float*)EBLG)[cgl * 512 + hk];
            asm volatile("" : "+v"(gtv[0]), "+v"(gtv[1]), "+v"(gtv[2]), "+v"(gtv[3]), "+v"(qv4[0]), "+v"(qv4[1]), "+v"(kv4[0]), "+v"(kv4[1]));
#pragma unroll
            for (int i = 0; i < 4; ++i) { const int c = tl + 512 * i, row = c >> 5, c16 = c & 31; *(LAS u32x4*)(lds + G_GT + row * 528 + c16 * 16) = gtv[i]; }
#pragma unroll
            for (int i = 0; i < 2; ++i) { const int c = tl + 512 * i, row = c >> 4, c16 = c & 15;
                *(LAS u32x4*)(lds + G_QD + row * 272 + c16 * 16) = qv4[i]; *(LAS u32x4*)(lds + G_KD + row * 272 + c16 * 16) = kv4[i]; }
            if (seg == 0) EBL[k] = eb;
        }
        u32x4 vv4[4];
#pragma unroll
        for (int i = 0; i < 4; ++i) { const int c = tl + 512 * i, row = c >> 5, c16 = c & 31; vv4[i] = *(const GAS u32x4*)((const GAS bf16*)z + (size_t)(t0 + row) * ZLD + ZV + h * 256 + c16 * 8); }
        asm volatile("" : "+v"(vv4[0]), "+v"(vv4[1]), "+v"(vv4[2]), "+v"(vv4[3]));
#pragma unroll
        for (int i = 0; i < 4; ++i) { const int c = tl + 512 * i, row = c >> 5, c16 = c & 31; *(LAS u32x4*)(lds + G_VT + row * 544 + c16 * 16) = vv4[i]; }
        __syncthreads();
        if (!OUT) {
#pragma unroll
            for (int i = 0; i < 2; ++i) { const int c = tl + 512 * i, row = c >> 4, c16 = c & 15; GAS bf16* zr = (GAS bf16*)z + (size_t)(t0 + row) * ZLD + h * 128 + c16 * 8;
                *(GAS u32x4*)(zr + ZQ) = *(const LAS u32x4*)(lds + G_QD + row * 272 + c16 * 16); *(GAS u32x4*)(zr + ZK) = *(const LAS u32x4*)(lds + G_KD + row * 272 + c16 * 16); }
        }
        if (OUT) {
            const int jt = w >> 1;
#pragma unroll
            for (int ii = 0; ii < 2; ++ii) {
                const int it = (w & 1) * 2 + ii;
                f32x4 pa = (f32x4){0.f, 0.f, 0.f, 0.f};
                if (jt <= it) {
#pragma unroll
                    for (int s = 0; s < 4; ++s) {
                        const bf16x8 A = *(const LAS bf16x8*)(lds + G_KD + ((16 * jt + r) * 136 + 32 * s + 8 * q) * 2);
                        const bf16x8 B = *(const LAS bf16x8*)(lds + G_QD + ((16 * it + r) * 136 + 32 * s + 8 * q) * 2);
                        pa = MFMA16(A, B, pa);
                    }
                    const int i_ = 16 * it + r;
#pragma unroll
                    for (int e = 0; e < 4; ++e) { const int j_ = 16 * jt + 4 * q + e; if (j_ > i_) pa[e] = 0.f; }
                }
                u32x2 pw; pw.x = pkbf(pa[0], pa[1]); pw.y = pkbf(pa[2], pa[3]);
                *(LAS u32x2*)(lds + G_P + ((16 * it + r) * 72 + 16 * jt + 4 * q) * 2) = pw;
            }
            __syncthreads();
        }
        bf16x8 Bv[2][2];
#pragma unroll
        for (int s2 = 0; s2 < 2; ++s2)
#pragma unroll
            for (int nt = 0; nt < 2; ++nt) {
                typedef short s16x4 __attribute__((ext_vector_type(4)));
                LAS unsigned char* ta = lds + G_VT + (32 * s2 + 8 * q + ((lane & 15) >> 2)) * 544 + (32 * w + 16 * nt + 4 * (lane & 3)) * 2;
                const s16x4 lo = __builtin_amdgcn_ds_read_tr16_b64_v4i16((LAS s16x4*)ta), hi = __builtin_amdgcn_ds_read_tr16_b64_v4i16((LAS s16x4*)(ta + 4 * 544));
                Bv[s2][nt] = (bf16x8){lo[0], lo[1], lo[2], lo[3], hi[0], hi[1], hi[2], hi[3]};
            }
        f32x4 o[4][2];
        if (OUT) {
#pragma unroll
            for (int mt = 0; mt < 4; ++mt)
#pragma unroll
                for (int nt = 0; nt < 2; ++nt) o[mt][nt] = (f32x4){0.f, 0.f, 0.f, 0.f};
#pragma unroll
            for (int s = 0; s < 4; ++s) {
                bf16x8 Sb[2];
#pragma unroll
                for (int nt = 0; nt < 2; ++nt) {
                    u32x4 t; t.x = pkbf(S[2 * s][nt][0], S[2 * s][nt][1]); t.y = pkbf(S[2 * s][nt][2], S[2 * s][nt][3]);
                    t.z = pkbf(S[2 * s + 1][nt][0], S[2 * s + 1][nt][1]); t.w = pkbf(S[2 * s + 1][nt][2], S[2 * s + 1][nt][3]);
                    Sb[nt] = __builtin_bit_cast(bf16x8, t);
                }
                u32x2 alo[4], ahi[4];
#pragma unroll
                for (int mt = 0; mt < 4; ++mt) {
                    alo[mt] = *(const LAS u32x2*)(lds + G_QD + ((16 * mt + r) * 136 + 32 * s + 4 * q) * 2);
                    ahi[mt] = *(const LAS u32x2*)(lds + G_QD + ((16 * mt + r) * 136 + 32 * s + 16 + 4 * q) * 2); }
#pragma unroll
                for (int mt = 0; mt < 4; ++mt) {
                    const bf16x8 A = __builtin_bit_cast(bf16x8, (u32x4){alo[mt].x, alo[mt].y, ahi[mt].x, ahi[mt].y});
#pragma unroll
                    for (int nt = 0; nt < 2; ++nt) o[mt][nt] = MFMA16(A, Sb[nt], o[mt][nt]);
                }
            }
#pragma unroll
            for (int s2 = 0; s2 < 2; ++s2) {
                bf16x8 Ap[4];
#pragma unroll
                for (int mt = 0; mt < 4; ++mt) Ap[mt] = *(const LAS bf16x8*)(lds + G_P + ((16 * mt + r) * 72 + 32 * s2 + 8 * q) * 2);
#pragma unroll
                for (int mt = 0; mt < 4; ++mt)
#pragma unroll
                    for (int nt = 0; nt < 2; ++nt) o[mt][nt] = MFMA16(Ap[mt], Bv[s2][nt], o[mt][nt]);
            }
        }
#pragma unroll
        for (int mt = 0; mt < 8; ++mt) {
            bf16x8 Ak[2]; const f32x4 ebv = *(const LAS f32x4*)(lds + G_EBL + (16 * mt + 4 * q) * 4);
#pragma unroll
            for (int s2 = 0; s2 < 2; ++s2) { typedef short s16x4 __attribute__((ext_vector_type(4)));
                LAS unsigned char* ta = lds + G_KD + (32 * s2 + 8 * q + ((lane & 15) >> 2)) * 272 + (16 * mt + 4 * (lane & 3)) * 2;
                const s16x4 lo = __builtin_amdgcn_ds_read_tr16_b64_v4i16((LAS s16x4*)ta), hi = __builtin_amdgcn_ds_read_tr16_b64_v4i16((LAS s16x4*)(ta + 4 * 272));
                Ak[s2] = (bf16x8){lo[0], lo[1], lo[2], lo[3], hi[0], hi[1], hi[2], hi[3]}; }
#pragma unroll
            for (int s2 = 0; s2 < 2; ++s2)
#pragma unroll
                for (int nt = 0; nt < 2; ++nt) S[mt][nt] = MFMA16(Ak[s2], Bv[s2][nt], S[mt][nt]);
#pragma unroll
            for (int nt = 0; nt < 2; ++nt) S[mt][nt] = S[mt][nt] * ebv;
        }
        if (OUT) {
#pragma unroll
            for (int mt = 0; mt < 4; ++mt)
#pragma unroll
                for (int e = 0; e < 4; ++e) {
                    float s = o[mt][0][e] * o[mt][0][e] + o[mt][1][e] * o[mt][1][e];
                    s = row16_sum(s);
                    if (r == 0) SSQ[(16 * mt + 4 * q + e) * 8 + w] = s;
                }
            __syncthreads();
            const float ng0 = ((const GAS float*)normg)[32 * w + r], ng1 = ((const GAS float*)normg)[32 * w + 16 + r];
#pragma unroll
            for (int mt = 0; mt < 4; ++mt)
#pragma unroll
                for (int e = 0; e < 4; ++e) {
                    const int i_ = 16 * mt + 4 * q + e;
                    const f32x4 sa = *(const LAS f32x4*)(lds + G_SS + i_ * 32), sb = *(const LAS f32x4*)(lds + G_SS + i_ * 32 + 16);
                    const float tot2 = ((sa.x + sa.y) + (sa.z + sa.w)) + ((sb.x + sb.y) + (sb.z + sb.w));
                    const float rs = __builtin_amdgcn_rsqf(tot2 * (1.f / 256.f) + EPS);
                    LAS bf16* gp = (LAS bf16*)(lds + G_GT + i_ * 528 + (32 * w + r) * 2);
                    const float ga = bf2f(gp[0]), gb = bf2f(gp[16]);
                    const float va = o[mt][0][e] * rs * ng0 * ga * __builtin_amdgcn_rcpf(1.f + __expf(-ga));
                    const float vb = o[mt][1][e] * rs * ng1 * gb * __builtin_amdgcn_rcpf(1.f + __expf(-gb));
                    const unsigned pv = pkbf(va, vb);
                    gp[0] = (bf16)(pv & 0xffffu); gp[16] = (bf16)(pv >> 16);
                }
            __syncthreads();
#pragma unroll
            for (int i = 0; i < 4; ++i) { const int c = tl + 512 * i, row = c >> 5, c16 = c & 31;
                *(GAS u32x4*)((GAS bf16*)mix + (size_t)(t0 + row) * MIXLD + 512 + h * 256 + c16 * 8) = *(const LAS u32x4*)(lds + G_GT + row * 528 + c16 * 16); }
        }
        __syncthreads();
    }
    if (!OUT) {
#pragma unroll
        for (int mt = 0; mt < 8; ++mt)
#pragma unroll
            for (int nt = 0; nt < 2; ++nt)
#pragma unroll
                for (int i = 0; i < 4; ++i) Eu[((mt * 2 + nt) * 4 + i) * 64] = S[mt][nt][i];
        if (seg == 0) DEC[unit * 128 + k] = __expf(bsum);
    }
}

__device__ __forceinline__ void shortconv(const bf16* z, const float* wsc, bf16* mix, int gtid, int gthreads) {
    for (int idx = gtid; idx < (T / 8) * 256; idx += gthreads) {
        const int tb = (idx >> 8) * 8, c = (idx & 255) * 2;
        unsigned x2[10], c2[10], b2[8];
#pragma unroll
        for (int r = 0; r < 10; ++r) { const int tt = tb - 2 + r, tc = tt < 0 ? 0 : tt; const bf16* zr = z + (size_t)tc * ZLD + c; x2[r] = *(const unsigned*)(zr + ZSX); c2[r] = *(const unsigned*)(zr + ZSC); }
#pragma unroll
        for (int o = 0; o < 8; ++o) b2[o] = *(const unsigned*)(z + (size_t)(tb + o) * ZLD + ZSB + c);
        f32x2 wj[3];
#pragma unroll
        for (int j = 0; j < 3; ++j) wj[j] = *(const f32x2*)(wsc + j * 512 + c);
        float m0[10], m1[10];
#pragma unroll
        for (int r = 0; r < 10; ++r) { const bool ok = (tb - 2 + r) >= 0; m0[r] = ok ? bf2f(x2[r] & 0xffffu) * bf2f(c2[r] & 0xffffu) : 0.f; m1[r] = ok ? bf2f(x2[r] >> 16) * bf2f(c2[r] >> 16) : 0.f; }
#pragma unroll
        for (int o = 0; o < 8; ++o) {
            const float a0 = wj[0].x * m0[o] + wj[1].x * m0[o + 1] + wj[2].x * m0[o + 2], a1 = wj[0].y * m1[o] + wj[1].y * m1[o + 1] + wj[2].y * m1[o + 2];
            *(unsigned*)(mix + (size_t)(tb + o) * MIXLD + c) = pkbf(bf2f(b2[o] & 0xffffu) * a0, bf2f(b2[o] >> 16) * a1);
        }
    }
}

__device__ __forceinline__ void gla_scan(float* E, const float* DEC, int gtid, int gthreads) {
    for (int e = gtid; e < 4 * 32768; e += gthreads) {
        const int h = e >> 15, rem = e & 32767, rr = (rem >> 6) & 63, ln = rem & 63;
        const int k = 16 * (rr >> 3) + 4 * (ln >> 4) + (rr & 3);
        float* p = E + (size_t)h * 32768 + rem; const float* dp = DEC + h * 128 + k;
        float s = 0.f;
#pragma unroll 1
        for (int gb = 0; gb < 64; gb += 16) {
            float tv[16], dv[16];
#pragma unroll
            for (int i = 0; i < 16; ++i) { tv[i] = p[(size_t)(gb + i) * 4 * 32768]; dv[i] = dp[(gb + i) * 512]; }
#pragma unroll
            for (int i = 0; i < 16; ++i) { p[(size_t)(gb + i) * 4 * 32768] = s; s = dv[i] * s + tv[i]; }
        }
    }
}

__device__ __forceinline__ void conv_phase(const bf16* u, const float* wdw, const float* bdw, const float* lng, const float* lnb, bf16* dout, LAS unsigned char* lds, int G, int bid) {
    const int tid = tid_l(), lane = tid & 63, w = tid >> 6;
    LAS unsigned* UL = (LAS unsigned*)lds;
    LAS f32x2* RED = (LAS f32x2*)(lds + 126976);
    LAS f32x2* STAT = (LAS f32x2*)(lds + 126976 + 2048);
    f32x2 wv[31];
#pragma unroll
    for (int j = 0; j < 31; ++j) wv[j] = *(const f32x2*)(wdw + j * 1024 + 2 * tid);
    const f32x2 bd = *(const f32x2*)(bdw + 2 * tid), lg = *(const f32x2*)(lng + 2 * tid), lb = *(const f32x2*)(lnb + 2 * tid);
    for (int tile = bid; tile < T / 32; tile += G) {
        const int t0 = tile * 32;
#pragma unroll 1
        for (int hb = 0; hb < 2; ++hb) {
            u32x4 sv[8];
#pragma unroll
            for (int it = 0; it < 8; ++it) { const int i = tid + (hb * 8 + it) * NTHR; int rr = i >> 7; rr = rr > 61 ? 61 : rr; const int cc = i & 127, t = t0 - 30 + rr, tc = t < 0 ? 0 : t;
                sv[it] = *(const u32x4*)(u + (size_t)tc * D + cc * 8); if (t < 0) sv[it] = (u32x4){0u, 0u, 0u, 0u}; }
#pragma unroll
            for (int it = 0; it < 8; ++it) { const int i = tid + (hb * 8 + it) * NTHR, rr = i >> 7, cc = i & 127; if (i < 62 * 128) *(LAS u32x4*)(lds + rr * 2048 + cc * 16) = sv[it]; }
        }
        __syncthreads();
#pragma unroll 1
        for (int sub = 0; sub < 2; ++sub) {
            f32x2 dv[16];
#pragma unroll
            for (int tt = 0; tt < 16; ++tt) dv[tt] = bd;
            const LAS unsigned* ULs = UL + sub * 16 * 512 + tid;
#pragma unroll
            for (int rb = 0; rb < 48; rb += 8) {
                unsigned ub[8];
#pragma unroll
                for (int i = 0; i < 8; ++i) ub[i] = (rb + i < 46) ? ULs[(rb + i) * 512] : 0u;
                asm volatile("" : "+v"(ub[0]), "+v"(ub[1]), "+v"(ub[2]), "+v"(ub[3]), "+v"(ub[4]), "+v"(ub[5]), "+v"(ub[6]), "+v"(ub[7]));
#pragma unroll
                for (int i = 0; i < 8; ++i) { const int rr = rb + i; if (rr < 46) { const f32x2 u2 = (f32x2){bf2f(ub[i] & 0xffffu), bf2f(ub[i] >> 16)};
#pragma unroll
                    for (int tt = 0; tt < 16; ++tt) { if (rr - tt >= 0 && rr - tt <= 30) dv[tt] = __builtin_elementwise_fma(wv[rr - tt], u2, dv[tt]); } } }
            }
#pragma unroll
            for (int tt = 0; tt < 16; ++tt) {
                float s1 = dv[tt].x + dv[tt].y, s2 = dv[tt].x * dv[tt].x + dv[tt].y * dv[tt].y;
                s1 = wave_sum(s1); s2 = wave_sum(s2);
                if (lane == 0) RED[tt * 8 + w] = (f32x2){s1, s2};
            }
            __syncthreads();
            if (tid < 16) { float s1 = 0.f, s2 = 0.f;
#pragma unroll
                for (int i = 0; i < 8; ++i) { const f32x2 t = RED[tid * 8 + i]; s1 += t.x; s2 += t.y; }
                const float mean = s1 * (1.f / D); const float var = fmaxf(s2 * (1.f / D) - mean * mean, 0.f);
                STAT[tid] = (f32x2){mean, __builtin_amdgcn_rsqf(var + EPS)}; }
            __syncthreads();
#pragma unroll
            for (int tt = 0; tt < 16; ++tt) {
                const f32x2 st = STAT[tt];
                const float a = (dv[tt].x - st.x) * st.y * lg.x + lb.x, b = (dv[tt].y - st.x) * st.y * lg.y + lb.y;
                const float sa = a * __builtin_amdgcn_rcpf(1.f + __expf(-a)), sb = b * __builtin_amdgcn_rcpf(1.f + __expf(-b));
                *(unsigned*)(dout + (size_t)(t0 + sub * 16 + tt) * D + 2 * tid) = pkbf(sa, sb);
            }
        }
        __syncthreads();
    }
}

#define XB_TMO      128
#define XB_XCNT(j)  (256  + 64 * (j))
#define XB_XSUB(j)  (1280 + 64 * (j))
#define XB_XGEN(j)  (2304 + 64 * (j))
#define XB_TOP      3328
#define XB_TOPGEN   3392
#define XCD_BAR_WORDS 3456
#define XB_SPIN_CAP (1u << 18)

__device__ __forceinline__ unsigned xb_ld(unsigned* p)              { return __hip_atomic_load(p, __ATOMIC_RELAXED, __HIP_MEMORY_SCOPE_AGENT); }
__device__ __forceinline__ unsigned xb_add(unsigned* p, unsigned v) { return __hip_atomic_fetch_add(p, v, __ATOMIC_RELAXED, __HIP_MEMORY_SCOPE_AGENT); }
__device__ __forceinline__ unsigned xb_xcc_id() { return (unsigned)__builtin_amdgcn_s_getreg((3 << 11) | 20) & 0xFu; }
#define XB_SPIN(cond, bar) do { unsigned _sp = 0; while (cond) { __builtin_amdgcn_s_sleep(1); \
    if ((++_sp & 255u) == 0u) { if (xb_ld(&(bar)[XB_TMO])) break; if (_sp > XB_SPIN_CAP) { atomicAdd(&(bar)[XB_TMO], 1u); break; } } } } while (0)

struct XcdBarrier {
    unsigned* bar; unsigned x;
    volatile LAS unsigned* st;
};

__device__ __forceinline__ XcdBarrier xcd_barrier_post(unsigned* bar, volatile LAS unsigned* st) {
    XcdBarrier b; b.bar = bar; b.x = xb_xcc_id(); b.st = st;
    if (threadIdx.x == 0) (void)xb_add(&bar[XB_XCNT(b.x)], 1u);
    return b;
}
__device__ __forceinline__ void xcd_barrier_complete(unsigned* bar, unsigned x, unsigned& nloc, unsigned& nx) {
    const unsigned G = gridDim.x * gridDim.y * gridDim.z;
    unsigned sum, cnt, mine, sp = 0u;
    for (;;) {
        sum = 0u; cnt = 0u; mine = 0u;
#pragma unroll
        for (unsigned j = 0; j < 16; ++j) { const unsigned c = xb_ld(&bar[XB_XCNT(j)]); sum += c; cnt += (c > 0u) ? 1u : 0u; mine = (j == x) ? c : mine; }
        if (sum == G) break;
        __builtin_amdgcn_s_sleep(1);
        if ((++sp & 255u) == 0u) { if (xb_ld(&bar[XB_TMO])) break; if (sp > XB_SPIN_CAP) { atomicAdd(&bar[XB_TMO], 1u); break; } }
    }
    nloc = mine > 0u ? mine : 1u; nx = cnt > 0u ? cnt : 1u;
}

__device__ __forceinline__ void xcd_barrier(const XcdBarrier& b) {
    asm volatile("s_waitcnt vmcnt(0)" ::: "memory");
    __syncthreads();
    if (threadIdx.x == 0) {
        unsigned* bar = b.bar; asm volatile("" : "+s"(bar));
        unsigned bx = (unsigned)__builtin_amdgcn_readfirstlane((int)b.x); asm volatile("" : "+s"(bx));
        __builtin_amdgcn_s_waitcnt(0);
        unsigned nloc = b.st[0], nx = b.st[1];
        if (nloc == 0u) { xcd_barrier_complete(bar, bx, nloc, nx); b.st[0] = nloc; b.st[1] = nx; }
        const unsigned old = xb_add(&bar[XB_XSUB(bx)], 1u);
        const unsigned gen = old / nloc;
        if (old + 1u == (gen + 1u) * nloc) {
            __builtin_amdgcn_fence(__ATOMIC_RELEASE, "agent");
            asm volatile("s_waitcnt vmcnt(0)" ::: "memory");
            const unsigned og = xb_add(&bar[XB_TOP], 1u);
            const unsigned tg = og / nx;
            if (og + 1u == (tg + 1u) * nx) xb_add(&bar[XB_TOPGEN], 1u);
            else XB_SPIN(xb_ld(&bar[XB_TOPGEN]) == tg, bar);
            __builtin_amdgcn_fence(__ATOMIC_ACQUIRE, "agent");
            xb_add(&bar[XB_XGEN(bx)], 1u);
            asm volatile("s_waitcnt vmcnt(0)" ::: "memory");
        } else {
            XB_SPIN(xb_ld(&bar[XB_XGEN(bx)]) == gen, bar);
            __builtin_amdgcn_fence(__ATOMIC_ACQUIRE, "agent");
            asm volatile("s_waitcnt vmcnt(0)" ::: "memory");
        }
    }
    __syncthreads();
}

__global__ void __launch_bounds__(NTHR, 2) trunk_fwd(Args a) {
    extern __shared__ __attribute__((aligned(16))) unsigned char lds_raw[];
    LAS unsigned char* lds = (LAS unsigned char*)lds_raw;
    cg::grid_group grid = cg::this_grid();
    { volatile LAS unsigned* st0 = (volatile LAS unsigned*)(lds + LDS_BYTES - 16); if (threadIdx.x < 4) st0[threadIdx.x] = 0u; }
    __syncthreads();
    const XcdBarrier xbar = xcd_barrier_post((unsigned*)(a.ws + WS_BAR), (volatile LAS unsigned*)(lds + LDS_BYTES - 16));
    const int G0 = gridDim.x;
    if (a.ph_lo == 0x7fffffff) grid.sync();
#define IDS int bid = blockIdx.x; asm volatile("" : "+s"(bid)); const int tid = tid_l(), lane = tid & 63, wave = __builtin_amdgcn_readfirstlane(tid >> 6), gw = bid * NWAVES + wave, gtid = bid * NTHR + tid; (void)lane; (void)gw; (void)gtid;
    unsigned char* ws = a.ws; float* const xout = a.out;
#define Wb ((bf16*)(wsl + WS_W))
#define Eb ((float*)(wsl + WS_H))
#define DEC ((float*)(wsl + WS_DEC))
#define GK ((float*)(wsl + WS_GK))
#define EBLG ((float*)(wsl + WS_EBL))
#define big (wsl + WS_BIG)
#define Z ((bf16*)big)
#define MIX ((bf16*)(big + 144 * MiB))
#define U ((bf16*)big)
#define Dd ((bf16*)(big + 32 * MiB))
#define Ab ((bf16*)big)
#define ymlp ((float*)(big + 128 * MiB))
#define XB ((bf16*)xout)
#define XB2 ((bf16*)(big + 128 * MiB))
#define ymix ((float*)(big + ((l & 1) ? 64 * MiB : 0)))
#ifndef WGM_G1
#define WGM_G1 4
#endif
#ifndef WGM_G5
#define WGM_G5 4
#endif
#ifndef WGM_G3
#define WGM_G3 4
#endif
#ifndef PH_LO
#define PH_LO 0
#endif
#ifndef PH_HI
#define PH_HI 25
#endif
    constexpr int lo = PH_LO, hi = PH_HI;
#ifndef PROBE_MASK
#define PROBE_MASK 0u
#endif
#ifndef PROBE_MUL
#define PROBE_MUL 1
#endif
    unsigned long long pr_prev = PROBE_MASK ? __builtin_amdgcn_s_memrealtime() : 0ull, pr_acc = 0ull;
#define PR_STAMP() do { if (PROBE_MASK) { const unsigned long long t_ = __builtin_amdgcn_s_memrealtime(); if ((PROBE_MASK >> ph) & 1u) pr_acc += t_ - pr_prev; pr_prev = t_; } } while (0)
    int ph = 0;
#define PH_BEGIN if (ph >= lo && ph < hi) { IDS size_t wzo = 0; asm volatile("" : "+s"(wzo)); unsigned char* wsl = ws + wzo; int G = G0; asm volatile("" : "+s"(G)); const int NGW = G * NWAVES, gthreads = G * NTHR; (void)NGW; (void)gthreads;
#define PH_END   if (ph + 1 < hi) xcd_barrier(xbar); } PR_STAMP(); ++ph;

#define STATS(bank) pg8::RmsStats{(float*)(wsl + WS_X1), (unsigned*)(wsl + WS_CNT) + (size_t)(bank) * 4096}
#define SSX(i) ((float*)(wsl + WS_H))
#define RSTD_TAB_OFF 131072
#define FILL_RSTD_TAB(ssx_) do { LAS float* tab_ = (LAS float*)(lds + RSTD_TAB_OFF); const int rb_ = (bid & 7) * 2048; \
        for (int i_ = tid; i_ < 2048; i_ += NTHR) tab_[i_] = pg8::row_rstd((ssx_), rb_ + i_); __syncthreads(); } while (0)
    PH_BEGIN
        convert_layer<0>(wsl, 0, lds, gw, NGW, wave, lane);
        prologue_rows(inp(0), XB, SSX(0), gw, NGW, lane);
    PH_END

    for (int l = 0; l < DEPTH; ++l) {
        const int i2 = l >> 1;
        const bool first = (l == 0);
        if ((l & 1) == 0) {
            PH_BEGIN
                if (bid >= 192) { convert_layer<1>(wsl, l, lds, (bid - 192) * NWAVES + wave, 64 * NWAVES, wave, lane); __syncthreads(); }
                pg8::Gemm g{XB, Wb + WO_MIX1, T, ZN, D}; pg8::StaticOrder S; S.init(T, ZN, G, bid, WGM_G1);
                FILL_RSTD_TAB(SSX(2 * l));
                pg8::EpiZ E{Z, GK, (const LAS float*)(lds + RSTD_TAB_OFF)};
                pg8::gemm_phase<pg8::EpiZ, pg8::StaticOrder, true, true>(lds, g, S, E);
            PH_END
            PH_BEGIN
                for (int un = bid; un < 256; un += G)
                    gla_unit<false>(un, Z, GK, inp(6) + (size_t)i2 * 16 * 512, inp(7) + (size_t)i2 * 512, inp(9) + (size_t)i2 * 256, Eb, DEC, EBLG, MIX, lds);
                shortconv(Z, inp(8) + (size_t)i2 * 3 * 512, MIX, gtid, gthreads);
            PH_END
            PH_BEGIN
                gla_scan(Eb, DEC, gtid, gthreads);
            PH_END
            PH_BEGIN
                for (int un = bid; un < 256; un += G)
                    gla_unit<true>(un, Z, GK, inp(6) + (size_t)i2 * 16 * 512, inp(7) + (size_t)i2 * 512, inp(9) + (size_t)i2 * 256, Eb, DEC, EBLG, MIX, lds);
            PH_END
            PH_BEGIN
                pg8::Gemm g{MIX, Wb + WO_MIX2_E, T, D, MIXLD}; pg8::StaticOrder S; S.init(T, D, G, bid);
                if (first) { pg8::EpiNorm<false, true, false, true> E{inp(0), XB, SSX(2 * l + 1), nullptr, inp(2) + (size_t)l * D, STATS(2 * l)};
                    pg8::gemm_phase<pg8::EpiNorm<false, true, false, true>, pg8::StaticOrder, false, true>(lds, g, S, E); }
                else { pg8::EpiNorm<false, true, true, true> E{XB, XB, SSX(2 * l + 1), nullptr, inp(2) + (size_t)l * D, STATS(2 * l)};
                    pg8::gemm_phase<pg8::EpiNorm<false, true, true, true>, pg8::StaticOrder, false, true>(lds, g, S, E); }
            PH_END
        } else {
            PH_BEGIN
                pg8::Gemm g{XB, Wb + WO_MIX1, T, 2048, D}; pg8::StaticOrder S; S.init(T, 2048, G, bid, WGM_G5);
                FILL_RSTD_TAB(SSX(2 * l));
                pg8::EpiGLU E{U, inp(12) + (size_t)i2 * 2048, (const LAS float*)(lds + RSTD_TAB_OFF)};
                pg8::gemm_phase<pg8::EpiGLU, pg8::StaticOrder, true, true>(lds, g, S, E);
            PH_END
            PH_BEGIN
                convert_layer<1>(wsl, l, lds, gw, NGW, wave, lane);
                __syncthreads();
                conv_phase(U, inp(13) + (size_t)i2 * 31 * D, inp(14) + (size_t)i2 * D, inp(15) + (size_t)i2 * D, inp(16) + (size_t)i2 * D, Dd, lds, G, bid);
            PH_END
            PH_BEGIN
                pg8::Gemm g{Dd, Wb + WO_MIX2_O, T, D, D}; pg8::StaticOrder S; S.init(T, D, G, bid);
                pg8::EpiNorm<true, true, true, true> E{XB, (l + 1 < DEPTH) ? (void*)XB : (void*)XB2, SSX(2 * l + 1), inp(18) + (size_t)i2 * D, inp(2) + (size_t)l * D, STATS(2 * l)};
                pg8::gemm_phase<pg8::EpiNorm<true, true, true, true>, pg8::StaticOrder, false, true>(lds, g, S, E);
            PH_END
        }
        PH_BEGIN
            if (l + 1 < DEPTH) { convert_layer<0>(wsl, l + 1, lds, gw, NGW, wave, lane); __syncthreads(); }
            pg8::Gemm g{(l + 1 < DEPTH) ? XB : XB2, Wb + WO_W1, T, FF, D}; pg8::StaticOrder S; S.init(T, FF, G, bid, WGM_G3);
            FILL_RSTD_TAB(SSX(2 * l + 1));
            pg8::EpiRelu2 E{Ab, FF, (const LAS float*)(lds + RSTD_TAB_OFF)};
            pg8::gemm_phase<pg8::EpiRelu2, pg8::StaticOrder, true, true>(lds, g, S, E);
        PH_END
        PH_BEGIN
            pg8::Gemm g{Ab, Wb + WO_W2, T, D, FF}; pg8::StaticOrder S; S.init(T, D, G, bid);
            if (l + 1 < DEPTH) { pg8::EpiNorm<false, true, true, true> E{XB, XB, SSX(2 * l + 2), nullptr, inp(4) + (size_t)l * D, STATS(2 * l + 1)};
                pg8::gemm_phase<pg8::EpiNorm<false, true, true, true>, pg8::StaticOrder, false, true>(lds, g, S, E); }
            else { pg8::EpiNorm<false, false, true, false> E{XB2, xout, nullptr, nullptr, inp(4) + (size_t)l * D, STATS(2 * l + 1)};
                pg8::gemm_phase<pg8::EpiNorm<false, false, true, false>, pg8::StaticOrder, false, true>(lds, g, S, E); }
        PH_END
    }
    if (PROBE_MASK) { if (blockIdx.x == 0) { const unsigned long long t_end = __builtin_amdgcn_s_memrealtime(); while (__builtin_amdgcn_s_memrealtime() - t_end < pr_acc * PROBE_MUL) __builtin_amdgcn_s_sleep(8); } }
}

extern "C" void kernel_launch(void* const* d_in, const int* in_sizes, int n_in, void* d_out, int out_size, void* d_ws, size_t ws_size, hipStream_t stream) {
    static int grid = 0;
    if (grid == 0) {
        if (n_in != 21 || out_size != T * D || ws_size < WS_END) { fprintf(stderr, "kernel_launch: unexpected shapes (n_in %d out %d ws %zu)\n", n_in, out_size, ws_size); grid = -1; return; }
        int dev = 0, cus = 0, per_cu = 0;
        hipGetDevice(&dev); hipDeviceGetAttribute(&cus, hipDeviceAttributeMultiprocessorCount, dev);
        if (hipFuncSetAttribute((const void*)trunk_fwd, hipFuncAttributeMaxDynamicSharedMemorySize, LDS_BYTES) != hipSuccess) { fprintf(stderr, "kernel_launch: hipFuncSetAttribute failed\n"); grid = -1; return; }
        if (hipOccupancyMaxActiveBlocksPerMultiprocessor(&per_cu, (const void*)trunk_fwd, NTHR, LDS_BYTES) != hipSuccess || per_cu < 1) { fprintf(stderr, "kernel_launch: occupancy query failed (%d)\n", per_cu); (void)hipGetLastError(); per_cu = 1; }
        grid = cus * per_cu; if (grid > 256) grid = 256;
        if (grid != 256) { fprintf(stderr, "kernel_launch: this kernel needs exactly 256 co-resident workgroups (got %d)\n", grid); grid = -1; return; }
    }
    if (grid < 0) return;
    Args a{};
    for (int i = 0; i < 21; ++i) a.in[i] = (const float*)d_in[i];
    a.out = (float*)d_out; a.ws = (unsigned char*)d_ws; a.ph_lo = 0; a.ph_hi = 25;
    if (hipMemsetAsync(d_ws, 0, 144u * 1024u, stream) != hipSuccess) { fprintf(stderr, "kernel_launch: memset failed\n"); return; }
    void* args[] = {&a};
    hipError_t e = hipLaunchCooperativeKernel((const void*)trunk_fwd, dim3(grid), dim3(NTHR), args, LDS_BYTES, stream);
    if (e != hipSuccess) fprintf(stderr, "cooperative launch failed: %s (grid %d)\n", hipGetErrorString(e), grid);
}
```
